# Optimizing an MI355X kernel written in HIP

```python
import math
import jax, jax.numpy as jnp
from jax import lax
import numpy as np

D_MODEL = 2048
BATCH = 1
SEQ = 8192
DEPTH = 1

N_ATTN_HEADS = 8
ATTN_HEAD_DIM = 128
ATTN_WIDTH = N_ATTN_HEADS * ATTN_HEAD_DIM
N_IDX_HEADS = 16
IDX_HEAD_DIM = 64
TOPK_MAX = 256
Q_BLOCK = 128

GMLP_CHUNK = 128
GMLP_GROUPS = 8
GMLP_GROUP_DIM = 128
GMLP_WIDTH = GMLP_GROUPS * GMLP_GROUP_DIM

N_REL_BUCKETS = 32
REL_MAX_DISTANCE = 128

PEER_HEADS = 8
PEER_N_KEYS = 128
PEER_N_EXPERTS = PEER_N_KEYS * PEER_N_KEYS
PEER_QUERY_DIM = 256
PEER_HALF = PEER_QUERY_DIM // 2
PEER_TOPK = 16
PEER_TOKEN_BLOCK = 128

PLE_DIM = 256

LN_EPS = 1e-5
DEEPNORM_ALPHA = (2.0 * DEPTH) ** 0.25
DEEPNORM_BETA = (8.0 * DEPTH) ** -0.25

IN_SPLITS = (ATTN_WIDTH, ATTN_WIDTH, ATTN_WIDTH, N_IDX_HEADS * IDX_HEAD_DIM, IDX_HEAD_DIM,
             N_IDX_HEADS, GMLP_WIDTH, GMLP_WIDTH, D_MODEL, D_MODEL)
IN_WIDTH = sum(IN_SPLITS)
IN_OFFSETS = tuple(int(o) for o in np.cumsum(IN_SPLITS)[:-1])

kernel_name = 'hybrid_dsa_gmlp_peer_deepnorm'


def layer_norm(x, g, b):
    xf = x.astype(jnp.float32)
    mu = jnp.mean(xf, axis=-1, keepdims=True)
    var = jnp.mean(jnp.square(xf - mu), axis=-1, keepdims=True)
    y = (xf - mu) * lax.rsqrt(var + LN_EPS)
    return (y * g.astype(jnp.float32) + b.astype(jnp.float32)).astype(x.dtype)


def rel_bucket(dist):
    n = jnp.maximum(dist, 0)
    max_exact = N_REL_BUCKETS // 2
    nf = jnp.maximum(n, 1).astype(jnp.float32)
    large = max_exact + (jnp.log(nf / max_exact) / math.log(REL_MAX_DISTANCE / max_exact)
                         * (N_REL_BUCKETS - max_exact)).astype(jnp.int32)
    large = jnp.minimum(large, N_REL_BUCKETS - 1)
    return jnp.where(n < max_exact, n, large)


def dsa_attention(q, k, v, q_idx, k_idx, w_idx, positions, rel_bias):
    B, S = positions.shape
    top_k = min(TOPK_MAX, S // 4)
    n_blk = S // Q_BLOCK
    f32 = jnp.float32

    def to_blocks(a):
        return jnp.moveaxis(a.reshape((B, n_blk, Q_BLOCK) + a.shape[2:]), 1, 0)

    k_idx_f = k_idx.astype(f32)
    gather = jax.vmap(lambda a, i: a[i])

    def block(args):
        qb, qib, wb, pb = args
        dots = jnp.einsum('bqhd,bsd->bqhs', qib.astype(f32), k_idx_f) * (IDX_HEAD_DIM ** -0.5)
        idx_score = jnp.einsum('bqh,bqhs->bqs', wb.astype(f32) * (N_IDX_HEADS ** -0.5),
                               jax.nn.relu(dots))
        causal = positions[:, None, :] <= pb[:, :, None]
        idx_score = jnp.where(causal, idx_score, -jnp.inf)
        _, sel = lax.top_k(idx_score, top_k)
        kg = gather(k, sel)
        vg = gather(v, sel)
        kpos = gather(positions, sel)
        dist = pb[:, :, None] - kpos
        bias = jnp.moveaxis(rel_bias[rel_bucket(dist)], -1, 2)
        logits = (jnp.einsum('bqhd,bqkhd->bqhk', qb, kg).astype(f32) * (ATTN_HEAD_DIM ** -0.5)
                  + bias.astype(f32))
        logits = jnp.where((dist >= 0)[:, :, None, :], logits, -jnp.inf)
        probs = jax.nn.softmax(logits, axis=-1).astype(v.dtype)
        return jnp.einsum('bqhk,bqkhd->bqhd', probs, vg)

    out = lax.map(block, (to_blocks(q), to_blocks(q_idx), to_blocks(w_idx), to_blocks(positions)))
    return jnp.moveaxis(out, 0, 1).reshape(B, S, ATTN_WIDTH)


def chunked_sgu(u, v, w_s, b_s, ln_g, ln_b):
    B, S, _ = u.shape
    u = jax.nn.gelu(u)
    v = layer_norm(jax.nn.gelu(v), ln_g, ln_b)
    n_chunk = S // GMLP_CHUNK
    vc = v.reshape(B, n_chunk, GMLP_CHUNK, GMLP_GROUPS, GMLP_GROUP_DIM)
    mask = jnp.tril(jnp.ones((GMLP_CHUNK, GMLP_CHUNK), dtype=bool))
    w = jnp.where(mask[None], w_s, jnp.zeros_like(w_s))
    mixed = jnp.einsum('gts,bnsgc->bntgc', w, vc) + b_s.T[None, None, :, :, None]
    return u * mixed.reshape(B, S, GMLP_WIDTH)


def peer_ffn(x, w_q, sub_keys, expert_u, expert_v):
    B, S, D = x.shape
    xt = x.reshape(B * S, D)
    q = (xt @ w_q).reshape(B * S, PEER_HEADS, 2, PEER_HALF).astype(jnp.float32)
    scores = jnp.einsum('nhpd,hpkd->nhpk', q, sub_keys.astype(jnp.float32))
    half_s, half_i = lax.top_k(scores, PEER_TOPK)
    cand = half_s[:, :, 0, :, None] + half_s[:, :, 1, None, :]
    cand = cand.reshape(B * S, PEER_HEADS, PEER_TOPK * PEER_TOPK)
    best_s, best_c = lax.top_k(cand, PEER_TOPK)
    i1 = jnp.take_along_axis(half_i[:, :, 0], best_c // PEER_TOPK, axis=-1)
    i2 = jnp.take_along_axis(half_i[:, :, 1], best_c % PEER_TOPK, axis=-1)
    experts = i1 * PEER_N_KEYS + i2
    gates = jax.nn.softmax(best_s, axis=-1).astype(x.dtype)
    n_blk = (B * S) // PEER_TOKEN_BLOCK

    def block(args):
        xb, eb, gb = args
        act = jax.nn.gelu(jnp.einsum('td,thkd->thk', xb, expert_u[eb]))
        return jnp.einsum('thk,thkd->td', gb * act, expert_v[eb])

    out = lax.map(block, (xt.reshape(n_blk, PEER_TOKEN_BLOCK, D),
                          experts.reshape(n_blk, PEER_TOKEN_BLOCK, PEER_HEADS, PEER_TOPK),
                          gates.reshape(n_blk, PEER_TOKEN_BLOCK, PEER_HEADS, PEER_TOPK)))
    return out.reshape(B, S, D)


def setup_inputs(seed: int = 0) -> dict:
    key = jax.random.key(seed)
    ks = jax.random.split(key, 32)
    f32 = jnp.float32
    nrm = lambda k, shape, s: jax.random.normal(k, shape, f32) * s
    L, D = DEPTH, D_MODEL
    return {
        'x': nrm(ks[0], (BATCH, SEQ, D), 1.0),
        'p': nrm(ks[1], (DEPTH, BATCH, SEQ, PLE_DIM), 1.0),
        'positions': jnp.broadcast_to(jnp.arange(SEQ, dtype=jnp.int32), (BATCH, SEQ)),
        'ln_emb_g': 1.0 + nrm(ks[2], (D,), 0.01),
        'ln_emb_b': nrm(ks[3], (D,), 0.01),
        'rel_bias': nrm(ks[4], (N_REL_BUCKETS, N_ATTN_HEADS), 0.5),
        'w_in': nrm(ks[5], (L, D, IN_WIDTH), D ** -0.5),
        'gmlp_ln_g': 1.0 + nrm(ks[6], (L, GMLP_WIDTH), 0.01),
        'gmlp_ln_b': nrm(ks[7], (L, GMLP_WIDTH), 0.01),
        'gmlp_w_s': nrm(ks[8], (L, GMLP_GROUPS, GMLP_CHUNK, GMLP_CHUNK), 0.5 * GMLP_CHUNK ** -0.5),
        'gmlp_b_s': 1.0 + nrm(ks[9], (L, GMLP_GROUPS, GMLP_CHUNK), 0.01),
        'w_br_attn': nrm(ks[10], (L, ATTN_WIDTH, D), DEEPNORM_BETA * ATTN_WIDTH ** -0.5),
        'w_br_gmlp': nrm(ks[11], (L, GMLP_WIDTH, D), DEEPNORM_BETA * GMLP_WIDTH ** -0.5),
        'w_mix_out': nrm(ks[12], (L, D, D), DEEPNORM_BETA * D ** -0.5),
        'ln1_g': 1.0 + nrm(ks[13], (L, D), 0.01),
        'ln1_b': nrm(ks[14], (L, D), 0.01),
        'peer_w_q': nrm(ks[15], (L, D, PEER_HEADS * PEER_QUERY_DIM), D ** -0.5),
        'peer_sub_keys': nrm(ks[16], (L, PEER_HEADS, 2, PEER_N_KEYS, PEER_HALF), PEER_HALF ** -0.5),
        'peer_u': nrm(ks[17], (L, PEER_N_EXPERTS, D), D ** -0.5),
        'peer_v': nrm(ks[18], (L, PEER_N_EXPERTS, D), DEEPNORM_BETA * PEER_HEADS ** -0.5),
        'ple_w_proj': nrm(ks[19], (L, PLE_DIM, D), DEEPNORM_BETA * PLE_DIM ** -0.5),
        'ple_w_gate': nrm(ks[20], (L, D, D), D ** -0.5),
        'ln2_g': 1.0 + nrm(ks[21], (L, D), 0.01),
        'ln2_b': nrm(ks[22], (L, D), 0.01),
    }


def reference(x, p, positions, ln_emb_g, ln_emb_b, rel_bias, w_in, gmlp_ln_g, gmlp_ln_b,
              gmlp_w_s, gmlp_b_s, w_br_attn, w_br_gmlp, w_mix_out, ln1_g, ln1_b, peer_w_q,
              peer_sub_keys, peer_u, peer_v, ple_w_proj, ple_w_gate, ln2_g, ln2_b):
    B, S, _ = x.shape
    h = layer_norm(x, ln_emb_g, ln_emb_b)
    for i in range(DEPTH):
        z = h @ w_in[i]
        q, k, v, qi, ki, wi, gu, gv, ga, gg = jnp.split(z, IN_OFFSETS, axis=-1)
        attn = dsa_attention(q.reshape(B, S, N_ATTN_HEADS, ATTN_HEAD_DIM),
                             k.reshape(B, S, N_ATTN_HEADS, ATTN_HEAD_DIM),
                             v.reshape(B, S, N_ATTN_HEADS, ATTN_HEAD_DIM),
                             qi.reshape(B, S, N_IDX_HEADS, IDX_HEAD_DIM),
                             ki, wi, positions, rel_bias)
        gm = chunked_sgu(gu, gv, gmlp_w_s[i], gmlp_b_s[i], gmlp_ln_g[i], gmlp_ln_b[i])
        merged = (jax.nn.sigmoid(ga) * (attn @ w_br_attn[i])
                  + jax.nn.sigmoid(gg) * (gm @ w_br_gmlp[i]))
        h = layer_norm(DEEPNORM_ALPHA * h + merged @ w_mix_out[i], ln1_g[i], ln1_b[i])
        r = DEEPNORM_ALPHA * h + peer_ffn(h, peer_w_q[i], peer_sub_keys[i], peer_u[i], peer_v[i])
        ple = jax.nn.sigmoid(r @ ple_w_gate[i]) * (p[i] @ ple_w_proj[i])
        h = layer_norm(r + ple, ln2_g[i], ln2_b[i])
    return h
```

```cpp
#include <hip/hip_runtime.h>
#include <hip/hip_cooperative_groups.h>
#include <cstdio>
#include <cstdint>
namespace cg = cooperative_groups;
#ifndef MK_COOP
#define MK_COOP 1
#endif
namespace pg8 {
#define PG8_LAS __attribute__((address_space(3)))
typedef unsigned short bf16_t;
typedef short bf16x8 __attribute__((ext_vector_type(8)));
typedef float f32x4 __attribute__((ext_vector_type(4)));
typedef unsigned u32x4 __attribute__((ext_vector_type(4)));
constexpr int BM = 256, BK = 64, HALF = 128, HTB = HALF * BK * 2  , STAGE_BYTES = 8 * HTB, NXCD = 8, WGM = 8;

__host__ __device__ __forceinline__ int lds_byte(int r, int c) { const int st = (r >> 4) * 2 + (c >> 5), rr = r & 15, cc = c & 31, ob = rr * 64 + cc * 2; return st * 1024 + (ob ^ (((ob >> 9) & 1) << 5)); }
__host__ __device__ __forceinline__ void stage_rc(int b, int& R, int& C) { const int st = b / 1024, sb = b % 1024, swz = sb ^ (((sb >> 9) & 1) << 5); R = (st >> 1) * 16 + swz / 64; C = (st & 1) * 32 + (swz % 64) / 2; }
__host__ __device__ __forceinline__ int perm32(int rho) { const int n = rho >> 4, i = rho & 15; return 8 * (i >> 2) + 4 * n + (i & 3); }

struct Unit { int pm, pn; };
struct Gemm { const bf16_t* A; const bf16_t* Bt; int M, N, K; };

struct StaticOrder {
    int nM, nN, nwg, G, c;
    __host__ __device__ void init(int M, int N, int G_, int c_) { nM = M / BM; nN = N / BM; nwg = nM * nN; G = G_; c = c_; }
    __host__ __device__ bool next(int i, Unit& u) const {
        const long L = (long)i * G + c; if (L >= nwg) return false;
        int wgid = (int)L; { const int q = nwg / NXCD, r = nwg % NXCD, xcd = wgid % NXCD, off = wgid / NXCD; wgid = (xcd < r ? xcd * (q + 1) : r * (q + 1) + (xcd - r) * q) + off; }
        const int nig = WGM * nN, gid = wgid / nig, fm = gid * WGM, gsz = (nM - fm) < WGM ? (nM - fm) : WGM;
        u.pm = fm + ((wgid % nig) % gsz); u.pn = (wgid % nig) / gsz; return true;
    }
    __device__ __forceinline__ void a_ready(const Unit&) const {}
    __device__ __forceinline__ void done(const Unit&) const {}
};

__device__ __forceinline__ unsigned cvt_pk_bf16(float lo, float hi) { unsigned r; asm volatile("v_cvt_pk_bf16_f32 %0, %1, %2" : "=v"(r) : "v"(lo), "v"(hi)); return r; }
typedef float f32x2 __attribute__((ext_vector_type(2)));
__device__ __forceinline__ f32x2 gelu_pk(f32x2 v) {
    const f32x2 av = __builtin_elementwise_abs(v), d = av * 0.2316418882f + 1.0f;
    f32x2 t; t.x = __builtin_amdgcn_rcpf(d.x); t.y = __builtin_amdgcn_rcpf(d.y);
    f32x2 q = t * 0.5307027145f + (-0.7265760135f); q = q * t + 0.7107068705f; q = q * t + (-0.142248368f); q = q * t + 0.127414796f; q = q * t;
    const f32x2 s = (v * v) * (-0.72134752044f);
    f32x2 e; e.x = __builtin_amdgcn_exp2f(s.x); e.y = __builtin_amdgcn_exp2f(s.y);
    const f32x2 m = v * (q * e), r = v - m;
    f32x2 o; o.x = v.x < 0.f ? m.x : r.x; o.y = v.y < 0.f ? m.y : r.y; return o;
}

template <int ACT  > struct EpiBf16 {
    static constexpr bool PERM = true, AFTER_DRAIN = false; static_assert(ACT == 0 || ACT == 1, "EpiBf16: ACT is 0 (none) or 1 (gelu_pk)");
    bf16_t* O; int ldc; const float* bias; int split_cols; size_t split_stride; float scale0;
    __device__ __forceinline__ void operator()(const f32x4 (&acc)[2][2][4][2], const Unit& u, int wr, int wc, int fr, int fq) const {
        const int row0 = u.pm * BM + wr * 64 + fr; int colt = u.pn * BM; bf16_t* base = O;
        float sc = 1.f; if (split_cols) { const int t = colt / split_cols; base += (size_t)t * split_stride; colt -= t * split_cols; if (t == 0) sc = scale0; }
        const int col0 = colt + wc * 32 + 8 * fq, bcol0 = u.pn * BM + wc * 32 + 8 * fq;
        f32x4 bv[2][2];
#pragma unroll
        for (int bj = 0; bj < 2; ++bj)
#pragma unroll
            for (int n = 0; n < 2; ++n) bv[bj][n] = bias ? *(const f32x4*)(bias + bcol0 + bj * HALF + 4 * n) : (f32x4){0.f, 0.f, 0.f, 0.f};
#pragma unroll
        for (int ai = 0; ai < 2; ++ai)
#pragma unroll
            for (int m = 0; m < 4; ++m) { bf16_t* rowp = base + (size_t)(row0 + ai * HALF + m * 16) * ldc + col0;
#pragma unroll
                for (int bj = 0; bj < 2; ++bj) { f32x4 v0 = acc[ai][bj][m][0] + bv[bj][0], v1 = acc[ai][bj][m][1] + bv[bj][1];
                    if (ACT == 1) { f32x2 a = gelu_pk((f32x2){v0[0], v0[1]}), b = gelu_pk((f32x2){v0[2], v0[3]}), c = gelu_pk((f32x2){v1[0], v1[1]}), d = gelu_pk((f32x2){v1[2], v1[3]});
                        v0 = (f32x4){a.x, a.y, b.x, b.y}; v1 = (f32x4){c.x, c.y, d.x, d.y}; }
                    v0 = v0 * sc; v1 = v1 * sc; u32x4 w; w.x = cvt_pk_bf16(v0[0], v0[1]); w.y = cvt_pk_bf16(v0[2], v0[3]); w.z = cvt_pk_bf16(v1[0], v1[1]); w.w = cvt_pk_bf16(v1[2], v1[3]);
                    *(u32x4*)(rowp + bj * HALF) = w; } }
    }
};
template <class Epi, class Sched, bool ALIGN_EPI = false, bool SP2 = false>
__device__ __forceinline__ void gemm_phase(PG8_LAS unsigned char* lds, const Gemm g, const Sched& S, const Epi& E) {
    const int tid = threadIdx.x, wid = __builtin_amdgcn_readfirstlane(tid >> 6), lane = tid & 63, wr = wid >> 2, wc = wid & 3, fr = lane & 15, fq = lane >> 4;
    const int K = g.K, nt = K / BK;
    unsigned voffA[2], voffB[2];
#pragma unroll
    for (int i = 0; i < 2; ++i) { int R, C; stage_rc(tid * 16 + i * 8192, R, C); const int Rb = Epi::PERM ? ((R & ~31) + perm32(R & 31)) : R;
        voffA[i] = (unsigned)(R * K + C) * 2u; voffB[i] = (unsigned)(Rb * K + C) * 2u; }
    const size_t kstep = (size_t)(BK * 2);
    const size_t hstep = (size_t)HALF * K * 2;
    const size_t tstep = 2 * hstep;
    const unsigned ldsw = (unsigned)wid * 1024u;
    const int aoff = lds_byte(wr * 64 + fr, fq * 8), boff = lds_byte(wc * 32 + fr, fq * 8);
#define PG8_SA(b, h) (((b) * 2 + (h)) * HTB)
#define PG8_SB(b, h) ((4 + (b) * 2 + (h)) * HTB)
#define PG8_STAGE(bufoff, gbase, voff) do { _Pragma("unroll") for (int _i = 0; _i < 2; ++_i) \
        __builtin_amdgcn_global_load_lds((const unsigned*)((const char*)(gbase) + (voff)[_i]), (PG8_LAS unsigned*)(lds + (bufoff) + ldsw + _i * 8192), 16, 0, 0); } while (0)
#define PG8_LDA(dst, b, h) do { _Pragma("unroll") for (int m = 0; m < 4; ++m) _Pragma("unroll") for (int k = 0; k < 2; ++k) dst[m][k] = *(const PG8_LAS bf16x8*)(lds + PG8_SA(b, h) + aoff + m * 2048 + k * 1024); } while (0)
#define PG8_LDB(dst, b, h) do { _Pragma("unroll") for (int n = 0; n < 2; ++n) _Pragma("unroll") for (int k = 0; k < 2; ++k) dst[n][k] = *(const PG8_LAS bf16x8*)(lds + PG8_SB(b, h) + boff + n * 2048 + k * 1024); } while (0)
#define PG8_MMA(ai, bj, At, Bt) do { __builtin_amdgcn_s_setprio(1); _Pragma("unroll") for (int m = 0; m < 4; ++m) _Pragma("unroll") for (int n = 0; n < 2; ++n) _Pragma("unroll") for (int k = 0; k < 2; ++k) \
        acc[ai][bj][m][n] = __builtin_amdgcn_mfma_f32_16x16x32_bf16(Bt[n][k], At[m][k], acc[ai][bj][m][n], 0, 0, 0); __builtin_amdgcn_s_setprio(0); } while (0)
#define PG8_WAIT_V(n) asm volatile("s_waitcnt vmcnt(" #n ")" ::: "memory")
#define PG8_WAIT_L(n) asm volatile("s_waitcnt lgkmcnt(" #n ")" ::: "memory")
#define PG8_BAR __builtin_amdgcn_s_barrier()
#define PG8_SCHED __builtin_amdgcn_sched_barrier(0)
    Unit cur, nxt; int ui = 0;
    if (!S.next(0, cur)) return;
    f32x4 acc[2][2][4][2];
#pragma unroll
    for (int a = 0; a < 2; ++a)
#pragma unroll
        for (int b = 0; b < 2; ++b)
#pragma unroll
            for (int m = 0; m < 4; ++m)
#pragma unroll
                for (int n = 0; n < 2; ++n) acc[a][b][m][n] = (f32x4){0.f, 0.f, 0.f, 0.f};
    bf16x8 At[4][2], B0[2][2], B1[2][2];
    const char* cA = (const char*)g.A + (size_t)cur.pm * tstep; const char* cB = (const char*)g.Bt + (size_t)cur.pn * tstep;
    S.a_ready(cur);
    if constexpr (SP2) {
        PG8_STAGE(PG8_SB(0, 0), cB, voffB); PG8_STAGE(PG8_SB(0, 1), cB + hstep, voffB); PG8_STAGE(PG8_SA(0, 0), cA, voffA); PG8_STAGE(PG8_SA(0, 1), cA + hstep, voffA);
        if (wr == 1) PG8_BAR;
        PG8_WAIT_V(2); PG8_BAR;
        PG8_STAGE(PG8_SB(1, 0), cB + kstep, voffB); PG8_STAGE(PG8_SA(1, 0), cA + kstep, voffA); PG8_STAGE(PG8_SB(1, 1), cB + hstep + kstep, voffB);
        PG8_WAIT_V(6); PG8_BAR;
    } else {
        PG8_STAGE(PG8_SB(0, 0), cB, voffB); PG8_STAGE(PG8_SA(0, 0), cA, voffA); PG8_STAGE(PG8_SB(0, 1), cB + hstep, voffB); PG8_STAGE(PG8_SA(0, 1), cA + hstep, voffA);
        if (wr == 1) PG8_BAR;
        PG8_WAIT_V(4); PG8_BAR;
        PG8_STAGE(PG8_SB(1, 0), cB + kstep, voffB); PG8_STAGE(PG8_SA(1, 0), cA + kstep, voffA); PG8_STAGE(PG8_SB(1, 1), cB + hstep + kstep, voffB);
        PG8_WAIT_V(6); PG8_BAR;
    }
    for (;;) {
        const bool has_next = S.next(ui + 1, nxt);
        const char* nA = has_next ? (const char*)g.A + (size_t)nxt.pm * tstep : cA; const char* nB = has_next ? (const char*)g.Bt + (size_t)nxt.pn * tstep : cB;
        for (int t = 0; t < nt; t += 2) {
            const bool last = (t == nt - 2);
            const char* a1 = cA + (size_t)(t + 1) * kstep;
            const char* a2 = last ? nA : cA + (size_t)(t + 2) * kstep; const char* b2 = last ? nB : cB + (size_t)(t + 2) * kstep;
            const char* a3 = a2 + kstep; const char* b3 = b2 + kstep;
            if (last && has_next) S.a_ready(nxt);
            if constexpr (SP2) {
            PG8_LDB(B0, 0, 0); PG8_LDB(B1, 0, 1); PG8_SCHED; PG8_LDA(At, 0, 0); PG8_STAGE(PG8_SA(1, 1), a1 + hstep, voffA);
            PG8_WAIT_V(8); PG8_WAIT_L(0); PG8_BAR; PG8_MMA(0, 0, At, B0); PG8_MMA(0, 1, At, B1); PG8_BAR; PG8_SCHED;
            PG8_LDA(At, 0, 1); PG8_STAGE(PG8_SB(0, 0), b2, voffB); PG8_STAGE(PG8_SB(0, 1), b2 + hstep, voffB); PG8_STAGE(PG8_SA(0, 0), a2, voffA);
            PG8_WAIT_V(8); PG8_WAIT_L(0); PG8_BAR; PG8_MMA(1, 0, At, B0); PG8_MMA(1, 1, At, B1); PG8_BAR; PG8_SCHED;
            PG8_LDB(B0, 1, 0); PG8_LDB(B1, 1, 1); PG8_SCHED; PG8_LDA(At, 1, 0); PG8_STAGE(PG8_SA(0, 1), a2 + hstep, voffA);
            PG8_WAIT_V(8); PG8_WAIT_L(0); PG8_BAR; PG8_MMA(0, 0, At, B0); PG8_MMA(0, 1, At, B1); PG8_BAR; PG8_SCHED;
            PG8_LDA(At, 1, 1); PG8_STAGE(PG8_SB(1, 0), b3, voffB); PG8_STAGE(PG8_SB(1, 1), b3 + hstep, voffB); PG8_STAGE(PG8_SA(1, 0), a3, voffA);
            PG8_WAIT_V(8); PG8_WAIT_L(0); PG8_BAR; PG8_MMA(1, 0, At, B0); PG8_MMA(1, 1, At, B1); PG8_BAR; PG8_SCHED;
            } else {
            PG8_LDB(B0, 0, 0); PG8_SCHED; PG8_LDA(At, 0, 0); PG8_STAGE(PG8_SA(1, 1), a1 + hstep, voffA);
            PG8_WAIT_L(8); PG8_BAR; PG8_WAIT_L(0); PG8_MMA(0, 0, At, B0); PG8_BAR; PG8_SCHED;
            PG8_LDB(B1, 0, 1); PG8_STAGE(PG8_SB(0, 0), b2, voffB);
            PG8_BAR; PG8_WAIT_L(0); PG8_MMA(0, 1, At, B1); PG8_BAR;
            PG8_LDA(At, 0, 1); PG8_STAGE(PG8_SA(0, 0), a2, voffA);
            PG8_BAR; PG8_WAIT_L(0); PG8_MMA(1, 0, At, B0); PG8_BAR; PG8_SCHED;
            PG8_STAGE(PG8_SB(0, 1), b2 + hstep, voffB);
            PG8_WAIT_V(6); PG8_BAR; PG8_MMA(1, 1, At, B1); PG8_BAR;
            PG8_LDB(B0, 1, 0); PG8_SCHED; PG8_LDA(At, 1, 0); PG8_STAGE(PG8_SA(0, 1), a2 + hstep, voffA);
            PG8_WAIT_L(8); PG8_BAR; PG8_WAIT_L(0); PG8_MMA(0, 0, At, B0); PG8_BAR; PG8_SCHED;
            PG8_LDB(B1, 1, 1); PG8_STAGE(PG8_SB(1, 0), b3, voffB);
            PG8_BAR; PG8_WAIT_L(0); PG8_MMA(0, 1, At, B1); PG8_BAR;
            PG8_LDA(At, 1, 1); PG8_STAGE(PG8_SA(1, 0), a3, voffA);
            PG8_BAR; PG8_WAIT_L(0); PG8_MMA(1, 0, At, B0); PG8_BAR; PG8_SCHED;
            PG8_STAGE(PG8_SB(1, 1), b3 + hstep, voffB);
            PG8_WAIT_V(6); PG8_BAR; PG8_MMA(1, 1, At, B1); PG8_BAR;
            }
        }
        if constexpr (ALIGN_EPI) { if (wr == 0) PG8_BAR; }
        if constexpr (!Epi::AFTER_DRAIN) { E(acc, cur, wr, wc, fr, fq); S.done(cur); }
        if (!has_next) break;
#pragma unroll
        for (int a = 0; a < 2; ++a)
#pragma unroll
            for (int b = 0; b < 2; ++b)
#pragma unroll
                for (int m = 0; m < 4; ++m)
#pragma unroll
                    for (int n = 0; n < 2; ++n) acc[a][b][m][n] = (f32x4){0.f, 0.f, 0.f, 0.f};
        cur = nxt; cA = nA; cB = nB; ++ui;
        if constexpr (ALIGN_EPI) { if (wr == 1) PG8_BAR; }
    }
    PG8_WAIT_V(0);
    if constexpr (!ALIGN_EPI) { if (wr == 0) PG8_BAR; }
    PG8_BAR;
    if constexpr (Epi::AFTER_DRAIN) { E.fused(acc, cur, wr, wc, fr, fq, lds, wid, lane); S.done(cur); }
#undef PG8_SA
#undef PG8_SB
#undef PG8_STAGE
#undef PG8_LDA
#undef PG8_LDB
#undef PG8_MMA
#undef PG8_WAIT_V
#undef PG8_WAIT_L
#undef PG8_BAR
#undef PG8_SCHED
}
}

constexpr int SEQ = 8192, DM = 2048, INW = 10320, INW_PAD = 10496;
constexpr int AW = 1024, NIH = 16, IHD = 64, TOPK = 256, GW = 1024;
constexpr int PE_H = 8, PE_NK = 128, PE_TOPK = 16, PE_NE = 16384, PLE = 256;
constexpr float LN_EPS = 1e-5f;
constexpr float ALPHA = 1.189207115002721f;
constexpr float QSCALE = 0.08838834764831845f;
constexpr int NWAVES = 8, NTHREADS = 512;
constexpr int LDS_BYTES = 147456;

constexpr size_t MiB = 1u << 20;
constexpr size_t WS_WA = 1 * MiB, WS_WG = 5 * MiB, WS_WMIX = 9 * MiB, WS_WQ = 17 * MiB, WS_WPG = 25 * MiB, WS_WPP = 33 * MiB, WS_SUBK = 34 * MiB;
constexpr size_t WS_PU = 35 * MiB, WS_PV = 99 * MiB, WS_STATS = 163 * MiB;
constexpr size_t WS_WIN = 164 * MiB, WS_HB = 205 * MiB;
constexpr size_t WS_Q = 237 * MiB, WS_KV = 253 * MiB, WS_QI = 285 * MiB, WS_KIWI = 301 * MiB;
constexpr size_t WS_GU = 305 * MiB, WS_GV = 321 * MiB, WS_GA = 337 * MiB, WS_GG = 369 * MiB;
constexpr size_t WS_GM = 401 * MiB, WS_ATT = 417 * MiB, WS_SC = 433 * MiB, WS_PB = 497 * MiB;
constexpr size_t WS_T = 164 * MiB, WS_MERGED = 237 * MiB, WS_H1F = 269 * MiB, WS_H1B = 333 * MiB, WS_PQ = 365 * MiB;
constexpr size_t WS_RF = 164 * MiB, WS_RB = 228 * MiB, WS_T2 = 405 * MiB;
constexpr size_t WS_END = 512 * MiB;

#define GAS __attribute__((address_space(1)))
#define LAS __attribute__((address_space(3)))
typedef unsigned short bf16;
typedef unsigned v4u __attribute__((ext_vector_type(4)));
typedef unsigned v2u __attribute__((ext_vector_type(2)));
typedef float f32x4 __attribute__((ext_vector_type(4)));
typedef float f32x16 __attribute__((ext_vector_type(16)));
typedef short bf16x8 __attribute__((ext_vector_type(8)));
typedef __attribute__((ext_vector_type(2))) __bf16 bf2v;
#define LDS_WAIT() asm volatile("s_waitcnt lgkmcnt(0)" ::: "memory")
#define VM_WAIT() asm volatile("s_waitcnt vmcnt(0)" ::: "memory")

__device__ __forceinline__ unsigned f2bf(float f) { unsigned u = __builtin_bit_cast(unsigned, f); return (u + 0x7fffu + ((u >> 16) & 1u)) >> 16; }
__device__ __forceinline__ unsigned pk2(float lo, float hi) { return f2bf(lo) | (f2bf(hi) << 16); }
__device__ __forceinline__ float bflo(unsigned u) { return __builtin_bit_cast(float, u << 16); }
__device__ __forceinline__ float bfhi(unsigned u) { return __builtin_bit_cast(float, u & 0xffff0000u); }
__device__ __forceinline__ float bf2f(bf16 h) { return __builtin_bit_cast(float, (unsigned)h << 16); }
__device__ __forceinline__ float fast_rcp(float x) { return __builtin_amdgcn_rcpf(x); }
__device__ __forceinline__ float sigmoidf_(float x) { return fast_rcp(1.f + __expf(-x)); }
__device__ __forceinline__ float gelu_tanh(float x) { const float u = 1.5957691216057308f * (x + 0.044715f * x * x * x); return x * fast_rcp(1.f + __expf(-u)); }
__device__ __forceinline__ float wave_sum(float v) {
#pragma unroll
    for (int o = 1; o < 64; o <<= 1) v += __shfl_xor(v, o);
    return v;
}
__device__ __forceinline__ unsigned sortable(float f) { const unsigned u = __builtin_bit_cast(unsigned, f); return (u & 0x80000000u) ? ~u : (u | 0x80000000u); }

typedef const __attribute__((address_space(4))) unsigned char* kargp_t;
__device__ __forceinline__ unsigned long long karg_u64(int byte_off) {
    kargp_t ka = (kargp_t)__builtin_amdgcn_kernarg_segment_ptr();
    asm volatile("" : "+s"(ka));
    return *(const __attribute__((address_space(4))) unsigned long long*)(ka + byte_off);
}
struct Frame {
    LAS unsigned char* lds;
    int tid, lane, wave, G, bid;
    float* out; unsigned char* ws;
    __device__ __forceinline__ const float* in(int k) const { return (const float*)karg_u64(8 * k); }
};
#define MAKE_FRAME(F) Frame F; { int t_ = threadIdx.x; asm volatile("" : "+v"(t_)); F.tid = t_; F.lane = t_ & 63; F.wave = __builtin_amdgcn_readfirstlane(t_ >> 6); \
    F.G = gridDim.x; F.bid = blockIdx.x; F.lds = (LAS unsigned char*)lds_raw; F.out = (float*)karg_u64(192); F.ws = (unsigned char*)karg_u64(200); }

__device__ __forceinline__ int win_dest(int n) { return n < 4096 ? n : (n < 4176 ? n + 6144 : n - 80); }
template <bool MAP>
__device__ __forceinline__ void p0_transpose_item(const float* W, int K, int N, bf16* WT, LAS float* scr, int item, int lane) {
    const int nblk = (N + 31) / 32, kb = item / nblk, nb = item % nblk, k0 = 64 * kb, n0 = 32 * nb;
    const int nn = n0 + (lane & 31); const bool ok = nn < N;
#pragma unroll 8
    for (int i = 0; i < 32; ++i) { const int kk = 2 * i + (lane >> 5); scr[kk * 33 + (lane & 31)] = ok ? W[(size_t)(k0 + kk) * N + nn] : 0.f; }
    LDS_WAIT(); asm volatile("" ::: "memory");
    const int c = lane & 7;
#pragma unroll
    for (int j = 0; j < 4; ++j) { const int n = (lane >> 3) + 8 * j; const LAS float* s = scr + (8 * c) * 33 + n;
        v4u o; o.x = pk2(s[0 * 33], s[1 * 33]); o.y = pk2(s[2 * 33], s[3 * 33]); o.z = pk2(s[4 * 33], s[5 * 33]); o.w = pk2(s[6 * 33], s[7 * 33]);
        if (n0 + n < N) { const int drow = MAP ? win_dest(n0 + n) : (n0 + n); *(GAS v4u*)(WT + (size_t)drow * K + k0 + 8 * c) = o; } }
    LDS_WAIT(); asm volatile("" ::: "memory");
}
__device__ __forceinline__ void p0_convert(Frame& F, const float* src, bf16* dst, size_t n) {
    const size_t nth = (size_t)F.G * NTHREADS, n8 = n / 8;
    for (size_t i = (size_t)F.bid * NTHREADS + F.tid; i < n8; i += nth) {
        const f32x4 a = ((const GAS f32x4*)src)[2 * i], b = ((const GAS f32x4*)src)[2 * i + 1];
        v4u o; o.x = pk2(a.x, a.y); o.y = pk2(a.z, a.w); o.z = pk2(b.x, b.y); o.w = pk2(b.z, b.w);
        ((GAS v4u*)dst)[i] = o; }
}
__device__ __forceinline__ void ln_row(Frame& F, const float* xrow, const float* g, const float* b, bf16* ob, float* of, float* stats) {
    const GAS f32x4* xr = (const GAS f32x4*)xrow + F.lane;
    f32x4 v[8]; float s = 0.f;
#pragma unroll
    for (int j = 0; j < 8; ++j) { v[j] = xr[64 * j]; s += (v[j].x + v[j].y) + (v[j].z + v[j].w); }
    const float mean = wave_sum(s) * (1.f / DM); float s2 = 0.f;
#pragma unroll
    for (int j = 0; j < 8; ++j) { v[j] = v[j] - mean; s2 += (v[j].x * v[j].x + v[j].y * v[j].y) + (v[j].z * v[j].z + v[j].w * v[j].w); }
    const float rstd = 1.f / sqrtf(wave_sum(s2) * (1.f / DM) + LN_EPS);
    if (stats && F.lane == 0) { stats[0] = mean; stats[1] = rstd; }
#pragma unroll
    for (int j = 0; j < 8; ++j) {
        const f32x4 gg = ((const GAS f32x4*)g)[64 * j + F.lane], bb = ((const GAS f32x4*)b)[64 * j + F.lane];
        const f32x4 y = v[j] * rstd * gg + bb;
        if (ob) { v2u o; o.x = pk2(y.x, y.y); o.y = pk2(y.z, y.w); ((GAS v2u*)ob)[64 * j + F.lane] = o; }
        if (of) ((GAS f32x4*)of)[64 * j + F.lane] = y;
    }
}
__device__ __forceinline__ void p0_prologue(Frame& F) {
    LAS float* scr = (LAS float*)(F.lds + F.wave * 16384);
    const int gw = F.bid * NWAVES + F.wave, NGW = F.G * NWAVES;
    unsigned char* ws = F.ws;
    constexpr int I_IN = (DM / 64) * ((INW + 31) / 32), I_A = (AW / 64) * (DM / 32), I_G = (GW / 64) * (DM / 32), I_SQ = (DM / 64) * (DM / 32), I_PP = (PLE / 64) * (DM / 32);
    constexpr int NITEMS = I_IN + I_A + I_G + 3 * I_SQ + I_PP;
    for (int it = gw; it < NITEMS; it += NGW) {
        int r = it;
        if (r < I_IN) { p0_transpose_item<true>(F.in(6), DM, INW, (bf16*)(ws + WS_WIN), scr, r, F.lane); continue; } r -= I_IN;
        if (r < I_A) { p0_transpose_item<false>(F.in(11), AW, DM, (bf16*)(ws + WS_WA), scr, r, F.lane); continue; } r -= I_A;
        if (r < I_G) { p0_transpose_item<false>(F.in(12), GW, DM, (bf16*)(ws + WS_WG), scr, r, F.lane); continue; } r -= I_G;
        if (r < I_SQ) { p0_transpose_item<false>(F.in(13), DM, DM, (bf16*)(ws + WS_WMIX), scr, r, F.lane); continue; } r -= I_SQ;
        if (r < I_SQ) { p0_transpose_item<false>(F.in(16), DM, DM, (bf16*)(ws + WS_WQ), scr, r, F.lane); continue; } r -= I_SQ;
        if (r < I_SQ) { p0_transpose_item<false>(F.in(21), DM, DM, (bf16*)(ws + WS_WPG), scr, r, F.lane); continue; } r -= I_SQ;
        p0_transpose_item<false>(F.in(20), PLE, DM, (bf16*)(ws + WS_WPP), scr, r, F.lane);
    }
    { const size_t n16 = (size_t)(INW_PAD - INW) * DM * 2 / 16; GAS v4u* z = (GAS v4u*)(ws + WS_WIN + (size_t)INW * DM * 2);
      for (size_t i = (size_t)F.bid * NTHREADS + F.tid; i < n16; i += (size_t)F.G * NTHREADS) z[i] = (v4u){0u, 0u, 0u, 0u}; }
    p0_convert(F, F.in(18), (bf16*)(ws + WS_PU), (size_t)PE_NE * DM);
    p0_convert(F, F.in(19), (bf16*)(ws + WS_PV), (size_t)PE_NE * DM);
    p0_convert(F, F.in(17), (bf16*)(ws + WS_SUBK), (size_t)PE_H * 2 * PE_NK * 128);
    p0_convert(F, F.in(1), (bf16*)(ws + WS_PB), (size_t)SEQ * PLE);
    for (int m = gw; m < SEQ; m += NGW) ln_row(F, F.in(0) + (size_t)m * DM, F.in(3), F.in(4), (bf16*)(ws + WS_HB) + (size_t)m * DM, nullptr, (float*)(ws + WS_STATS) + 2 * m);
}

namespace pg8 {
struct EpiWin {
    static constexpr bool PERM = true, AFTER_DRAIN = false;
    bf16 *q, *kv, *qi, *gu, *gv, *ga, *gg, *kiwi;
    __device__ __forceinline__ void operator()(const f32x4 (&acc)[2][2][4][2], const Unit& u, int wr, int wc, int fr, int fq) const {
        const int pn = u.pn; bf16* base; int ld, colt, act = 0; float sc = 1.f;
        if (pn < 4) { base = q; ld = 1024; colt = pn * 256; sc = QSCALE; }
        else if (pn < 12) { base = kv; ld = 2048; colt = (pn - 4) * 256; }
        else if (pn < 16) { base = qi; ld = 1024; colt = (pn - 12) * 256; }
        else if (pn < 20) { base = gu; ld = 1024; colt = (pn - 16) * 256; act = 1; }
        else if (pn < 24) { base = gv; ld = 1024; colt = (pn - 20) * 256; act = 1; }
        else if (pn < 32) { base = ga; ld = 2048; colt = (pn - 24) * 256; act = 2; }
        else if (pn < 40) { base = gg; ld = 2048; colt = (pn - 32) * 256; act = 2; }
        else { base = kiwi; ld = 256; colt = 0; }
        const int row0 = u.pm * BM + wr * 64 + fr, col0 = colt + wc * 32 + 8 * fq;
#pragma unroll
        for (int ai = 0; ai < 2; ++ai)
#pragma unroll
            for (int m = 0; m < 4; ++m) { bf16* rowp = base + (size_t)(row0 + ai * HALF + m * 16) * ld + col0;
#pragma unroll
                for (int bj = 0; bj < 2; ++bj) { f32x4 v0 = acc[ai][bj][m][0], v1 = acc[ai][bj][m][1];
                    if (act == 1) {
#pragma unroll
                        for (int e = 0; e < 4; ++e) { v0[e] = gelu_tanh(v0[e]); v1[e] = gelu_tanh(v1[e]); } }
                    else if (act == 2) {
#pragma unroll
                        for (int e = 0; e < 4; ++e) { v0[e] = sigmoidf_(v0[e]); v1[e] = sigmoidf_(v1[e]); } }
                    else { v0 = v0 * sc; v1 = v1 * sc; }
                    v4u w; w.x = pk2(v0[0], v0[1]); w.y = pk2(v0[2], v0[3]); w.z = pk2(v1[0], v1[1]); w.w = pk2(v1[2], v1[3]);
                    *(GAS v4u*)(rowp + bj * HALF) = w; } }
    }
};
struct EpiGateF32 {
    static constexpr bool PERM = true, AFTER_DRAIN = false;
    const bf16* gate; float* T; int ldc;
    __device__ __forceinline__ void operator()(const f32x4 (&acc)[2][2][4][2], const Unit& u, int wr, int wc, int fr, int fq) const {
        const int row0 = u.pm * BM + wr * 64 + fr, col0 = u.pn * BM + wc * 32 + 8 * fq;
#pragma unroll
        for (int ai = 0; ai < 2; ++ai)
#pragma unroll
            for (int m = 0; m < 4; ++m) { const size_t off = (size_t)(row0 + ai * HALF + m * 16) * ldc + col0;
#pragma unroll
                for (int bj = 0; bj < 2; ++bj) { const v4u g = *(const GAS v4u*)(gate + off + bj * HALF);
                    f32x4 v0 = acc[ai][bj][m][0], v1 = acc[ai][bj][m][1];
                    v0[0] *= bflo(g.x); v0[1] *= bfhi(g.x); v0[2] *= bflo(g.y); v0[3] *= bfhi(g.y);
                    v1[0] *= bflo(g.z); v1[1] *= bfhi(g.z); v1[2] *= bflo(g.w); v1[3] *= bfhi(g.w);
                    *(GAS f32x4*)(T + off + bj * HALF) = v0; *(GAS f32x4*)(T + off + bj * HALF + 4) = v1; } }
    }
};
struct EpiMerge {
    static constexpr bool PERM = true, AFTER_DRAIN = false;
    const bf16* gate; const float* T; bf16* O; int ldc;
    __device__ __forceinline__ void operator()(const f32x4 (&acc)[2][2][4][2], const Unit& u, int wr, int wc, int fr, int fq) const {
        const int row0 = u.pm * BM + wr * 64 + fr, col0 = u.pn * BM + wc * 32 + 8 * fq;
#pragma unroll
        for (int ai = 0; ai < 2; ++ai)
#pragma unroll
            for (int m = 0; m < 4; ++m) { const size_t off = (size_t)(row0 + ai * HALF + m * 16) * ldc + col0;
#pragma unroll
                for (int bj = 0; bj < 2; ++bj) { const v4u g = *(const GAS v4u*)(gate + off + bj * HALF);
                    const f32x4 t0 = *(const GAS f32x4*)(T + off + bj * HALF), t1 = *(const GAS f32x4*)(T + off + bj * HALF + 4);
                    f32x4 v0 = acc[ai][bj][m][0], v1 = acc[ai][bj][m][1];
                    v0[0] = t0[0] + v0[0] * bflo(g.x); v0[1] = t0[1] + v0[1] * bfhi(g.x); v0[2] = t0[2] + v0[2] * bflo(g.y); v0[3] = t0[3] + v0[3] * bfhi(g.y);
                    v1[0] = t1[0] + v1[0] * bflo(g.z); v1[1] = t1[1] + v1[1] * bfhi(g.z); v1[2] = t1[2] + v1[2] * bflo(g.w); v1[3] = t1[3] + v1[3] * bfhi(g.w);
                    v4u w; w.x = pk2(v0[0], v0[1]); w.y = pk2(v0[2], v0[3]); w.z = pk2(v1[0], v1[1]); w.w = pk2(v1[2], v1[3]);
                    *(GAS v4u*)(O + off + bj * HALF) = w; } }
    }
};
struct EpiMix {
    static constexpr bool PERM = false, AFTER_DRAIN = false;
    const float* x; const float* stats; const float* g; const float* b; float* Y; int ldc;
    __device__ __forceinline__ void operator()(const f32x4 (&acc)[2][2][4][2], const Unit& u, int wr, int wc, int fr, int fq) const {
        const int row0 = u.pm * BM + wr * 64 + fr, col0 = u.pn * BM + wc * 32 + 4 * fq;
        f32x4 gv[2][2], bv[2][2];
#pragma unroll
        for (int bj = 0; bj < 2; ++bj)
#pragma unroll
            for (int n = 0; n < 2; ++n) { gv[bj][n] = *(const GAS f32x4*)(g + col0 + bj * HALF + n * 16); bv[bj][n] = *(const GAS f32x4*)(b + col0 + bj * HALF + n * 16); }
#pragma unroll
        for (int ai = 0; ai < 2; ++ai)
#pragma unroll
            for (int m = 0; m < 4; ++m) { const int r = row0 + ai * HALF + m * 16; const size_t off = (size_t)r * ldc + col0;
                const float mean = stats[2 * r], rstd = stats[2 * r + 1];
#pragma unroll
                for (int bj = 0; bj < 2; ++bj)
#pragma unroll
                    for (int n = 0; n < 2; ++n) { const f32x4 xv = *(const GAS f32x4*)(x + off + bj * HALF + n * 16);
                        const f32x4 h = (xv - mean) * rstd * gv[bj][n] + bv[bj][n];
                        *(GAS f32x4*)(Y + off + bj * HALF + n * 16) = h * ALPHA + acc[ai][bj][m][n]; } }
    }
};
struct EpiF32 {
    static constexpr bool PERM = false, AFTER_DRAIN = false;
    float* Y; int ldc;
    __device__ __forceinline__ void operator()(const f32x4 (&acc)[2][2][4][2], const Unit& u, int wr, int wc, int fr, int fq) const {
        const int row0 = u.pm * BM + wr * 64 + fr, col0 = u.pn * BM + wc * 32 + 4 * fq;
#pragma unroll
        for (int ai = 0; ai < 2; ++ai)
#pragma unroll
            for (int m = 0; m < 4; ++m) { const size_t off = (size_t)(row0 + ai * HALF + m * 16) * ldc + col0;
#pragma unroll
                for (int bj = 0; bj < 2; ++bj)
#pragma unroll
                    for (int n = 0; n < 2; ++n) *(GAS f32x4*)(Y + off + bj * HALF + n * 16) = acc[ai][bj][m][n]; }
    }
};
struct EpiPle {
    static constexpr bool PERM = false, AFTER_DRAIN = false;
    const float* R; const float* T2; float* Y; int ldc;
    __device__ __forceinline__ void operator()(const f32x4 (&acc)[2][2][4][2], const Unit& u, int wr, int wc, int fr, int fq) const {
        const int row0 = u.pm * BM + wr * 64 + fr, col0 = u.pn * BM + wc * 32 + 4 * fq;
#pragma unroll
        for (int ai = 0; ai < 2; ++ai)
#pragma unroll
            for (int m = 0; m < 4; ++m) { const size_t off = (size_t)(row0 + ai * HALF + m * 16) * ldc + col0;
#pragma unroll
                for (int bj = 0; bj < 2; ++bj)
#pragma unroll
                    for (int n = 0; n < 2; ++n) { const f32x4 rv = *(const GAS f32x4*)(R + off + bj * HALF + n * 16), tv = *(const GAS f32x4*)(T2 + off + bj * HALF + n * 16);
                        const f32x4 a = acc[ai][bj][m][n]; f32x4 o;
#pragma unroll
                        for (int e = 0; e < 4; ++e) o[e] = rv[e] + sigmoidf_(a[e]) * tv[e];
                        *(GAS f32x4*)(Y + off + bj * HALF + n * 16) = o; } }
    }
};
}

__device__ __forceinline__ f32x16 mfma32(bf16x8 a, bf16x8 b, f32x16 c) { return __builtin_amdgcn_mfma_f32_32x32x16_bf16(a, b, c, 0, 0, 0); }
__device__ __forceinline__ void unpack8(const v4u a, float (&x)[8]) { x[0] = bflo(a.x); x[1] = bfhi(a.x); x[2] = bflo(a.y); x[3] = bfhi(a.y); x[4] = bflo(a.z); x[5] = bfhi(a.z); x[6] = bflo(a.w); x[7] = bfhi(a.w); }

__device__ __forceinline__ void gmlp_unit(Frame& F, int unit) {
    const int n = unit >> 3, g = unit & 7, row0 = n * 128;
    const bf16* gvb = (const bf16*)(F.ws + WS_GV); const bf16* gub = (const bf16*)(F.ws + WS_GU); bf16* gm = (bf16*)(F.ws + WS_GM);
    LAS float* st = (LAS float*)F.lds;
    LAS bf16* VT = (LAS bf16*)(F.lds + 1024);
    for (int i = 0; i < 16; ++i) { const int r = F.wave * 16 + i;
        const GAS v4u* rp = (const GAS v4u*)(gvb + (size_t)(row0 + r) * GW);
        const v4u a = rp[F.lane], b = rp[64 + F.lane];
        float x[16]; { float t0[8], t1[8]; unpack8(a, t0); unpack8(b, t1);
#pragma unroll
            for (int e = 0; e < 8; ++e) { x[e] = t0[e]; x[8 + e] = t1[e]; } }
        float s = 0.f;
#pragma unroll
        for (int e = 0; e < 16; ++e) s += x[e];
        const float mean = wave_sum(s) * (1.f / GW); float s2 = 0.f;
#pragma unroll
        for (int e = 0; e < 16; ++e) { const float d = x[e] - mean; s2 += d * d; }
        const float rstd = 1.f / sqrtf(wave_sum(s2) * (1.f / GW) + LN_EPS);
        if (F.lane == 0) { st[2 * r] = mean; st[2 * r + 1] = rstd; } }
    __syncthreads();
    const float* lg = F.in(7) + g * 128; const float* lb = F.in(8) + g * 128;
#pragma unroll
    for (int i = 0; i < 4; ++i) { const int id = F.tid + 512 * i, s = id >> 4, c8 = id & 15;
        const v4u a = *(const GAS v4u*)(gvb + (size_t)(row0 + s) * GW + g * 128 + c8 * 8);
        float x[8]; unpack8(a, x);
        const float mean = st[2 * s], rstd = st[2 * s + 1];
        const f32x4 g0 = *(const GAS f32x4*)(lg + c8 * 8), g1 = *(const GAS f32x4*)(lg + c8 * 8 + 4), b0 = *(const GAS f32x4*)(lb + c8 * 8), b1 = *(const GAS f32x4*)(lb + c8 * 8 + 4);
#pragma unroll
        for (int e = 0; e < 8; ++e) { const float gg = e < 4 ? g0[e & 3] : g1[e & 3], bb = e < 4 ? b0[e & 3] : b1[e & 3];
            VT[(c8 * 8 + e) * 136 + s] = (bf16)f2bf((x[e] - mean) * rstd * gg + bb); } }
    __syncthreads();
    const int r = F.lane & 31, hh = F.lane >> 5, tt = F.wave >> 1, ct0 = (F.wave & 1) * 2;
    f32x16 acc0, acc1;
#pragma unroll
    for (int e = 0; e < 16; ++e) { acc0[e] = 0.f; acc1[e] = 0.f; }
    const float* wsm = F.in(9) + (size_t)g * 128 * 128;
    const int t = tt * 32 + r;
    for (int ks = 0; ks < (tt + 1) * 2; ++ks) {
        const int k0 = ks * 16 + 8 * hh;
        const f32x4 w0 = *(const GAS f32x4*)(wsm + t * 128 + k0), w1 = *(const GAS f32x4*)(wsm + t * 128 + k0 + 4);
        float wv[8] = {w0.x, w0.y, w0.z, w0.w, w1.x, w1.y, w1.z, w1.w};
#pragma unroll
        for (int e = 0; e < 8; ++e) if (k0 + e > t) wv[e] = 0.f;
        v4u ap; ap.x = pk2(wv[0], wv[1]); ap.y = pk2(wv[2], wv[3]); ap.z = pk2(wv[4], wv[5]); ap.w = pk2(wv[6], wv[7]);
        const bf16x8 A = __builtin_bit_cast(bf16x8, ap);
        const bf16x8 B0 = *(const LAS bf16x8*)(VT + (ct0 * 32 + r) * 136 + k0), B1 = *(const LAS bf16x8*)(VT + ((ct0 + 1) * 32 + r) * 136 + k0);
        acc0 = mfma32(A, B0, acc0); acc1 = mfma32(A, B1, acc1);
    }
    const float* bs = F.in(10) + g * 128;
#pragma unroll
    for (int reg = 0; reg < 16; ++reg) { const int tr = tt * 32 + (reg & 3) + 8 * (reg >> 2) + 4 * hh; const float bsv = bs[tr];
        const size_t o0 = (size_t)(row0 + tr) * GW + g * 128 + ct0 * 32 + r;
        gm[o0] = (bf16)f2bf(bf2f(gub[o0]) * (acc0[reg] + bsv));
        gm[o0 + 32] = (bf16)f2bf(bf2f(gub[o0 + 32]) * (acc1[reg] + bsv)); }
    __syncthreads();
}

__device__ __constant__ unsigned char REL_BUCKET[128] = {0, 1, 2, 3, 4, 5, 6, 7, 8, 9, 10, 11, 12, 13, 14, 15, 16, 16, 16, 17, 17, 18, 18, 18, 19, 19, 19, 20, 20, 20, 20, 21, 21, 21, 21, 22, 22, 22, 22, 22, 23, 23, 23, 23, 23, 23, 24, 24, 24, 24, 24, 24, 25, 25, 25, 25, 25, 25, 25, 26, 26, 26, 26, 26, 26, 26, 26, 27, 27, 27, 27, 27, 27, 27, 27, 27, 27, 28, 28, 28, 28, 28, 28, 28, 28, 28, 28, 29, 29, 29, 29, 29, 29, 29, 29, 29, 29, 29, 29, 30, 30, 30, 30, 30, 30, 30, 30, 30, 30, 30, 30, 30, 30, 31, 31, 31, 31, 31, 31, 31, 31, 31, 31, 31, 31, 31, 31, 31};
constexpr int KI_PITCH = 144;
constexpr int IDX_WOFF = 40960, IDX_WREG = 9216;
constexpr unsigned NEG_KEY = 0x007FFFFFu;
__device__ __forceinline__ int mbcnt64(unsigned long long m) { return __builtin_amdgcn_mbcnt_hi((unsigned)(m >> 32), __builtin_amdgcn_mbcnt_lo((unsigned)m, 0u)); }

#define IDX_LOAD_TILE(t_) do { _Pragma("unroll") for (int i_ = 0; i_ < 4; ++i_) { const int id_ = F.tid + 512 * i_; \
    stg[i_] = *(const GAS v4u*)(kiwi + (size_t)((t_) * 256 + (id_ >> 3)) * 256 + (id_ & 7) * 8); } } while (0)

__device__ __forceinline__ void idx_unit(Frame& F, int unit) {
    const int q0 = unit * 16;
    const int kend = ((q0 + 15) / 32 + 1) * 32;
    const int nkt = (kend + 255) >> 8;
    const bf16* qi = (const bf16*)(F.ws + WS_QI); const bf16* kiwi = (const bf16*)(F.ws + WS_KIWI);
    const int* pos = (const int*)F.in(2);
    float* scr = (F.bid < 128) ? F.out + (size_t)F.bid * (16 * 8192) : (float*)(F.ws + WS_SC) + (size_t)(F.bid - 128) * (16 * 8192);
    const int r = F.lane & 31, hh = F.lane >> 5;
    const int wq = q0 + 2 * F.wave;
    {
        const int aq = wq + ((r >> 2) & 1), ah = (r & 3) + 4 * (r >> 3);
        bf16x8 Af[4];
#pragma unroll
        for (int s = 0; s < 4; ++s) Af[s] = *(const GAS bf16x8*)(qi + (size_t)aq * 1024 + ah * 64 + s * 16 + 8 * hh);
        float wgt[16];
        { const v4u a = *(const GAS v4u*)(kiwi + (size_t)(wq + hh) * 256 + 64), b = *(const GAS v4u*)(kiwi + (size_t)(wq + hh) * 256 + 72);
          float t0[8], t1[8]; unpack8(a, t0); unpack8(b, t1);
#pragma unroll
          for (int e = 0; e < 8; ++e) { wgt[e] = t0[e]; wgt[8 + e] = t1[e]; } }
        const int qpos = pos[wq + hh];
        float* srow = scr + (size_t)(2 * F.wave + hh) * 8192;
        v4u stg[4];
        IDX_LOAD_TILE(0);
        for (int t = 0; t < nkt; ++t) {
            __syncthreads();
#pragma unroll
            for (int i = 0; i < 4; ++i) { const int id = F.tid + 512 * i; *(LAS v4u*)(F.lds + (id >> 3) * KI_PITCH + (id & 7) * 16) = stg[i]; }
            __syncthreads();
            if (t + 1 < nkt) IDX_LOAD_TILE(t + 1);
            for (int sub = 0; sub < 8; ++sub) {
                const int key0 = t * 256 + sub * 32;
                if (key0 >= kend) break;
                f32x16 acc;
#pragma unroll
                for (int e = 0; e < 16; ++e) acc[e] = 0.f;
#pragma unroll
                for (int s = 0; s < 4; ++s) { const bf16x8 B = *(const LAS bf16x8*)(F.lds + (sub * 32 + r) * KI_PITCH + s * 32 + hh * 16); acc = mfma32(Af[s], B, acc); }
                float sc = 0.f;
#pragma unroll
                for (int e = 0; e < 16; ++e) sc += wgt[e] * fmaxf(acc[e], 0.f);
                const int key = key0 + r; const int kp = pos[key];
                srow[key] = (kp <= qpos) ? sc : -__builtin_inff();
            }
        }
    }
    __threadfence(); __syncthreads();
    LAS int* sel = (LAS int*)(F.lds + IDX_WOFF + F.wave * IDX_WREG);
    LAS float* P = (LAS float*)(F.lds + IDX_WOFF + F.wave * IDX_WREG + 1024);
    const float* relb = F.in(5);
    const bf16* kvb = (const bf16*)(F.ws + WS_KV);
#pragma unroll 1
    for (int qq = 0; qq < 2; ++qq) {
        const int qrow = wq + qq;
        int cnt;
        {
            const float* sr = scr + (size_t)(2 * F.wave + qq) * 8192;
            unsigned key[128];
            int ln1 = F.lane; asm volatile("" : "+v"(ln1));
#pragma unroll
            for (int jb = 0; jb < 8; ++jb) {
#pragma unroll
                for (int jj = 0; jj < 16; ++jj) { const int j = jb * 16 + jj; key[j] = 0u; if (j * 64 < kend) { const int idx = j * 64 + ln1; if (idx < kend) key[j] = sortable(sr[idx]); } }
                __builtin_amdgcn_sched_barrier(0); }
            unsigned thr = 0u;
            for (int bit = 31; bit >= 0; --bit) { const unsigned cand = thr | (1u << bit); int c = 0;
#pragma unroll
                for (int jb = 0; jb < 16; ++jb) { if (jb * 512 < kend) {
#pragma unroll
                        for (int jj = 0; jj < 8; ++jj) c += __builtin_popcountll(__ballot(key[jb * 8 + jj] >= cand)); }
                    __builtin_amdgcn_sched_barrier(0); }
                if (c >= TOPK) thr = cand; }
            int ngt = 0;
#pragma unroll
            for (int jb = 0; jb < 16; ++jb) { if (jb * 512 < kend) {
#pragma unroll
                    for (int jj = 0; jj < 8; ++jj) ngt += __builtin_popcountll(__ballot(key[jb * 8 + jj] > thr && key[jb * 8 + jj] > NEG_KEY)); }
                __builtin_amdgcn_sched_barrier(0); }
            const int need = TOPK - ngt;
            int base = 0, tie_seen = 0;
            int ln2 = F.lane; asm volatile("" : "+v"(ln2));
#pragma unroll
            for (int j = 0; j < 128; ++j) { if (j * 64 < kend) {
                const bool valid = key[j] > NEG_KEY, gt = valid && key[j] > thr, eq = valid && key[j] == thr;
                const unsigned long long meq = __ballot(eq);
                const bool take = gt || (eq && (tie_seen + mbcnt64(meq)) < need);
                tie_seen += __builtin_popcountll(meq);
                const unsigned long long m = __ballot(take);
                if (take) sel[base + mbcnt64(m)] = j * 64 + ln2;
                base += __builtin_popcountll(m); }
                __builtin_amdgcn_sched_barrier(0); }
            cnt = base;
        }
        LDS_WAIT(); asm volatile("" ::: "memory");
        {
            const int head = F.lane >> 3, sub = F.lane & 7;
            unsigned qp[8];
            { const v4u a = *(const GAS v4u*)((const bf16*)(F.ws + WS_Q) + (size_t)qrow * 1024 + F.lane * 16), b = *(const GAS v4u*)((const bf16*)(F.ws + WS_Q) + (size_t)qrow * 1024 + F.lane * 16 + 8);
              qp[0] = a.x; qp[1] = a.y; qp[2] = a.z; qp[3] = a.w; qp[4] = b.x; qp[5] = b.y; qp[6] = b.z; qp[7] = b.w; }
            const int qps = pos[qrow];
            const int cnt8 = (cnt + 7) & ~7;
            for (int j0 = 0; j0 < cnt8; j0 += 8) {
                float part[8];
#pragma unroll
                for (int e = 0; e < 8; ++e) { const int j = j0 + e; const int idx = __builtin_amdgcn_readfirstlane(sel[j < cnt ? j : cnt - 1]);
                    const GAS v4u* kp = (const GAS v4u*)(kvb + (size_t)idx * 2048 + F.lane * 16);
                    const v4u k0 = kp[0], k1 = kp[1]; float d = 0.f;
                    d = __builtin_amdgcn_fdot2_f32_bf16(__builtin_bit_cast(bf2v, qp[0]), __builtin_bit_cast(bf2v, k0.x), d, false);
                    d = __builtin_amdgcn_fdot2_f32_bf16(__builtin_bit_cast(bf2v, qp[1]), __builtin_bit_cast(bf2v, k0.y), d, false);
                    d = __builtin_amdgcn_fdot2_f32_bf16(__builtin_bit_cast(bf2v, qp[2]), __builtin_bit_cast(bf2v, k0.z), d, false);
                    d = __builtin_amdgcn_fdot2_f32_bf16(__builtin_bit_cast(bf2v, qp[3]), __builtin_bit_cast(bf2v, k0.w), d, false);
                    d = __builtin_amdgcn_fdot2_f32_bf16(__builtin_bit_cast(bf2v, qp[4]), __builtin_bit_cast(bf2v, k1.x), d, false);
                    d = __builtin_amdgcn_fdot2_f32_bf16(__builtin_bit_cast(bf2v, qp[5]), __builtin_bit_cast(bf2v, k1.y), d, false);
                    d = __builtin_amdgcn_fdot2_f32_bf16(__builtin_bit_cast(bf2v, qp[6]), __builtin_bit_cast(bf2v, k1.z), d, false);
                    d = __builtin_amdgcn_fdot2_f32_bf16(__builtin_bit_cast(bf2v, qp[7]), __builtin_bit_cast(bf2v, k1.w), d, false);
                    part[e] = d; }
                const bool b2 = (sub & 4) != 0, b1 = (sub & 2) != 0, b0 = (sub & 1) != 0;
                float a4[4], a2[2];
#pragma unroll
                for (int e = 0; e < 4; ++e) { const float keep = b2 ? part[e + 4] : part[e], give = b2 ? part[e] : part[e + 4]; a4[e] = keep + __shfl_xor(give, 4); }
#pragma unroll
                for (int e = 0; e < 2; ++e) { const float keep = b1 ? a4[e + 2] : a4[e], give = b1 ? a4[e] : a4[e + 2]; a2[e] = keep + __shfl_xor(give, 2); }
                const float keep = b0 ? a2[1] : a2[0], give = b0 ? a2[0] : a2[1];
                float logit = keep + __shfl_xor(give, 1);
                const int j = j0 + sub; const int idx = sel[j < cnt ? j : cnt - 1];
                const int dist = qps - pos[idx];
                const int bk = dist < 0 ? 0 : (dist < 128 ? (int)REL_BUCKET[dist] : 31);
                logit += relb[bk * 8 + head];
                if (j >= cnt || dist < 0) logit = -__builtin_inff();
                P[head * 256 + j] = logit;
            }
            LDS_WAIT(); asm volatile("" ::: "memory");
            float mx = -__builtin_inff();
            for (int j = sub; j < cnt8; j += 8) mx = fmaxf(mx, P[head * 256 + j]);
            mx = fmaxf(mx, __shfl_xor(mx, 1)); mx = fmaxf(mx, __shfl_xor(mx, 2)); mx = fmaxf(mx, __shfl_xor(mx, 4));
            float sum = 0.f;
            for (int j = sub; j < cnt8; j += 8) { const float pv = __expf(P[head * 256 + j] - mx); P[head * 256 + j] = pv; sum += pv; }
            sum += __shfl_xor(sum, 1); sum += __shfl_xor(sum, 2); sum += __shfl_xor(sum, 4);
            const float inv = 1.f / sum;
            LDS_WAIT(); asm volatile("" ::: "memory");
            float o[16];
#pragma unroll
            for (int e = 0; e < 16; ++e) o[e] = 0.f;
            for (int j0 = 0; j0 < cnt8; j0 += 4) {
#pragma unroll
                for (int e = 0; e < 4; ++e) { const int j = j0 + e; const int idx = __builtin_amdgcn_readfirstlane(sel[j < cnt ? j : cnt - 1]);
                    const GAS v4u* vp = (const GAS v4u*)(kvb + (size_t)idx * 2048 + 1024 + F.lane * 16);
                    const v4u v0 = vp[0], v1 = vp[1]; const float pj = P[head * 256 + j];
                    o[0] += pj * bflo(v0.x); o[1] += pj * bfhi(v0.x); o[2] += pj * bflo(v0.y); o[3] += pj * bfhi(v0.y);
                    o[4] += pj * bflo(v0.z); o[5] += pj * bfhi(v0.z); o[6] += pj * bflo(v0.w); o[7] += pj * bfhi(v0.w);
                    o[8] += pj * bflo(v1.x); o[9] += pj * bfhi(v1.x); o[10] += pj * bflo(v1.y); o[11] += pj * bfhi(v1.y);
                    o[12] += pj * bflo(v1.z); o[13] += pj * bfhi(v1.z); o[14] += pj * bflo(v1.w); o[15] += pj * bfhi(v1.w); }
            }
            v4u w0, w1;
            w0.x = pk2(o[0] * inv, o[1] * inv); w0.y = pk2(o[2] * inv, o[3] * inv); w0.z = pk2(o[4] * inv, o[5] * inv); w0.w = pk2(o[6] * inv, o[7] * inv);
            w1.x = pk2(o[8] * inv, o[9] * inv); w1.y = pk2(o[10] * inv, o[11] * inv); w1.z = pk2(o[12] * inv, o[13] * inv); w1.w = pk2(o[14] * inv, o[15] * inv);
            GAS v4u* op = (GAS v4u*)((bf16*)(F.ws + WS_ATT) + (size_t)qrow * 1024 + F.lane * 16);
            op[0] = w0; op[1] = w1;
            LDS_WAIT(); asm volatile("" ::: "memory");
        }
    }
}

__device__ __forceinline__ float unsortable(unsigned k) { return __builtin_bit_cast(float, (k & 0x80000000u) ? (k & 0x7fffffffu) : ~k); }
#define DOT2(a, b, c) __builtin_amdgcn_fdot2_f32_bf16(__builtin_bit_cast(bf2v, (unsigned)(a)), __builtin_bit_cast(bf2v, (unsigned)(b)), (c), false)

__device__ __forceinline__ void peer_unit(Frame& F, int unit) {
    const int tok0 = unit * 32;
    const bf16* pq = (const bf16*)(F.ws + WS_PQ); const bf16* subk = (const bf16*)(F.ws + WS_SUBK);
    LAS float* topS = (LAS float*)F.lds; LAS int* topI = (LAS int*)(F.lds + 32768);
    LAS int* esel = (LAS int*)(F.lds + 65536); LAS float* ew = (LAS float*)(F.lds + 81920);
    const int r = F.lane & 31, hh = F.lane >> 5;
#ifndef NO_A
    {
        const int h = F.wave;
        for (int p = 0; p < 2; ++p) {
            const int hp = h * 2 + p;
            bf16x8 Bq[8];
#pragma unroll
            for (int ks = 0; ks < 8; ++ks) Bq[ks] = *(const GAS bf16x8*)(pq + (size_t)(tok0 + r) * 2048 + hp * 128 + ks * 16 + 8 * hh);
            unsigned key[64];
#pragma unroll
            for (int kt = 0; kt < 4; ++kt) { f32x16 acc;
#pragma unroll
                for (int e = 0; e < 16; ++e) acc[e] = 0.f;
#pragma unroll
                for (int ks = 0; ks < 8; ++ks) { const bf16x8 A = *(const GAS bf16x8*)(subk + ((size_t)hp * 128 + kt * 32 + r) * 128 + ks * 16 + 8 * hh); acc = mfma32(A, Bq[ks], acc); }
#pragma unroll
                for (int e = 0; e < 16; ++e) key[kt * 16 + e] = sortable(acc[e]);
                __builtin_amdgcn_sched_barrier(0); }
            unsigned thr = 0u;
            for (int bit = 31; bit >= 0; --bit) { const unsigned cand = thr | (1u << bit); int c = 0;
#pragma unroll
                for (int i = 0; i < 64; ++i) c += (key[i] >= cand) ? 1 : 0;
                c += __shfl_xor(c, 32);
                if (c >= PE_TOPK) thr = cand; }
            int ngt = 0, neq = 0;
#pragma unroll
            for (int i = 0; i < 64; ++i) { ngt += (key[i] > thr) ? 1 : 0; neq += (key[i] == thr) ? 1 : 0; }
            const int pgt = __shfl_xor(ngt, 32), peq = __shfl_xor(neq, 32);
            int pg = hh ? pgt : 0, pe = ngt + pgt + (hh ? peq : 0);
            LAS float* ls = topS + ((r * 8 + h) * 2 + p) * 16; LAS int* li = topI + ((r * 8 + h) * 2 + p) * 16;
#pragma unroll
            for (int kt = 0; kt < 4; ++kt)
#pragma unroll
                for (int e = 0; e < 16; ++e) { const unsigned k = key[kt * 16 + e]; const int kidx = kt * 32 + (e & 3) + 8 * (e >> 2) + 4 * hh;
                    if (k > thr) { ls[pg] = unsortable(k); li[pg] = kidx; ++pg; }
                    else if (k == thr) { if (pe < PE_TOPK) { ls[pe] = unsortable(k); li[pe] = kidx; } ++pe; } }
        }
    }
#endif
    __syncthreads();
#ifndef NO_B
    if (F.wave < 4) {
        const int L = F.wave * 64 + F.lane, tk = L >> 3, hd = L & 7;
        const LAS float* S0 = topS + ((tk * 8 + hd) * 2 + 0) * 16; const LAS int* I0 = topI + ((tk * 8 + hd) * 2 + 0) * 16;
        float s1[16]; int i1[16];
#pragma unroll
        for (int b = 0; b < 16; ++b) { s1[b] = topS[((tk * 8 + hd) * 2 + 1) * 16 + b]; i1[b] = topI[((tk * 8 + hd) * 2 + 1) * 16 + b]; }
        const float NINF = -__builtin_inff();
        float prev = __builtin_inff(), thr = NINF, top = 0.f;
        for (int round = 0; round < 16; ++round) {
            float cur = NINF;
#pragma unroll 1
            for (int a = 0; a < 16; ++a) { const float sa = S0[a];
#pragma unroll
                for (int b = 0; b < 16; ++b) { const float v = sa + s1[b]; cur = fmaxf(cur, v < prev ? v : NINF); } }
            if (round == 0) top = cur;
            thr = cur; prev = cur;
        }
        int n = 0; float den = 0.f; const int ob = tk * 128 + hd * 16;
#pragma unroll 1
        for (int a = 0; a < 16; ++a) { const float sa = S0[a]; const int ia = I0[a] * PE_NK;
#pragma unroll
            for (int b = 0; b < 16; ++b) { const float v = sa + s1[b];
                if (v > thr && n < PE_TOPK) { const float w = __expf(v - top); esel[ob + n] = ia + i1[b]; ew[ob + n] = w; den += w; ++n; } } }
#pragma unroll 1
        for (int a = 0; a < 16; ++a) { const float sa = S0[a]; const int ia = I0[a] * PE_NK;
#pragma unroll
            for (int b = 0; b < 16; ++b) { const float v = sa + s1[b];
                if (v == thr && n < PE_TOPK) { const float w = __expf(v - top); esel[ob + n] = ia + i1[b]; ew[ob + n] = w; den += w; ++n; } } }
        const float inv = 1.f / den;
        for (int k = 0; k < PE_TOPK; ++k) ew[ob + k] *= inv;
    }
#endif
    __syncthreads();
#ifndef NO_C
    {
        const bf16* h1b = (const bf16*)(F.ws + WS_H1B); const float* h1f = (const float*)(F.ws + WS_H1F);
        const bf16* PU = (const bf16*)(F.ws + WS_PU); const bf16* PV = (const bf16*)(F.ws + WS_PV);
        float* rf = (float*)(F.ws + WS_RF); bf16* rb = (bf16*)(F.ws + WS_RB);
        for (int tt = 0; tt < 4; ++tt) {
            const int tl = F.wave * 4 + tt, tok = tok0 + tl;
            v4u xp[4];
#pragma unroll
            for (int i = 0; i < 4; ++i) xp[i] = *(const GAS v4u*)(h1b + (size_t)tok * DM + i * 512 + F.lane * 8);
            float o[32];
#pragma unroll
            for (int e = 0; e < 32; ++e) o[e] = 0.f;
            for (int e0 = 0; e0 < 128; e0 += 2) {
                const int id0 = __builtin_amdgcn_readfirstlane(esel[tl * 128 + e0]), id1 = __builtin_amdgcn_readfirstlane(esel[tl * 128 + e0 + 1]);
                const float g0 = ew[tl * 128 + e0], g1 = ew[tl * 128 + e0 + 1];
                v4u u0[4], u1[4], w0[4], w1[4];
#pragma unroll
                for (int i = 0; i < 4; ++i) { u0[i] = *(const GAS v4u*)(PU + (size_t)id0 * DM + i * 512 + F.lane * 8); u1[i] = *(const GAS v4u*)(PU + (size_t)id1 * DM + i * 512 + F.lane * 8); }
#pragma unroll
                for (int i = 0; i < 4; ++i) { w0[i] = *(const GAS v4u*)(PV + (size_t)id0 * DM + i * 512 + F.lane * 8); w1[i] = *(const GAS v4u*)(PV + (size_t)id1 * DM + i * 512 + F.lane * 8); }
                float d0 = 0.f, d1 = 0.f;
#pragma unroll
                for (int i = 0; i < 4; ++i) {
                    d0 = DOT2(xp[i].x, u0[i].x, d0); d0 = DOT2(xp[i].y, u0[i].y, d0); d0 = DOT2(xp[i].z, u0[i].z, d0); d0 = DOT2(xp[i].w, u0[i].w, d0);
                    d1 = DOT2(xp[i].x, u1[i].x, d1); d1 = DOT2(xp[i].y, u1[i].y, d1); d1 = DOT2(xp[i].z, u1[i].z, d1); d1 = DOT2(xp[i].w, u1[i].w, d1); }
                d0 = wave_sum(d0); d1 = wave_sum(d1);
                const float a0 = g0 * gelu_tanh(d0), a1 = g1 * gelu_tanh(d1);
#pragma unroll
                for (int i = 0; i < 4; ++i) {
                    o[8 * i + 0] += a0 * bflo(w0[i].x) + a1 * bflo(w1[i].x); o[8 * i + 1] += a0 * bfhi(w0[i].x) + a1 * bfhi(w1[i].x);
                    o[8 * i + 2] += a0 * bflo(w0[i].y) + a1 * bflo(w1[i].y); o[8 * i + 3] += a0 * bfhi(w0[i].y) + a1 * bfhi(w1[i].y);
                    o[8 * i + 4] += a0 * bflo(w0[i].z) + a1 * bflo(w1[i].z); o[8 * i + 5] += a0 * bfhi(w0[i].z) + a1 * bfhi(w1[i].z);
                    o[8 * i + 6] += a0 * bflo(w0[i].w) + a1 * bflo(w1[i].w); o[8 * i + 7] += a0 * bfhi(w0[i].w) + a1 * bfhi(w1[i].w); }
            }
#pragma unroll
            for (int i = 0; i < 4; ++i) { const size_t off = (size_t)tok * DM + i * 512 + F.lane * 8;
                const f32x4 ha = *(const GAS f32x4*)(h1f + off), hb = *(const GAS f32x4*)(h1f + off + 4);
                f32x4 ra, rbv;
                ra.x = ALPHA * ha.x + o[8 * i + 0]; ra.y = ALPHA * ha.y + o[8 * i + 1]; ra.z = ALPHA * ha.z + o[8 * i + 2]; ra.w = ALPHA * ha.w + o[8 * i + 3];
                rbv.x = ALPHA * hb.x + o[8 * i + 4]; rbv.y = ALPHA * hb.y + o[8 * i + 5]; rbv.z = ALPHA * hb.z + o[8 * i + 6]; rbv.w = ALPHA * hb.w + o[8 * i + 7];
                *(GAS f32x4*)(rf + off) = ra; *(GAS f32x4*)(rf + off + 4) = rbv;
                v4u w; w.x = pk2(ra.x, ra.y); w.y = pk2(ra.z, ra.w); w.z = pk2(rbv.x, rbv.y); w.w = pk2(rbv.z, rbv.w);
                *(GAS v4u*)(rb + off) = w; }
        }
    }
#endif
    __syncthreads();
}

struct Args { const float* in[24]; float* out; unsigned char* ws; int ph_lo, ph_hi; };
constexpr int N_PHASES = 10;

__global__ void __launch_bounds__(NTHREADS, 2) mega_fwd(Args args) {
    extern __shared__ __attribute__((aligned(16))) unsigned char lds_raw[];
    const int lo = args.ph_lo, hi = args.ph_hi;
#if MK_COOP
    cg::grid_group grid = cg::this_grid();
#define GRID_BAR() grid.sync()
#else
#define GRID_BAR() do {} while (0)
#endif
#define IN(k) (lo <= (k) && (k) < hi)
#define BOTH(k) (IN(k) && IN((k) + 1))

    if (IN(0)) { MAKE_FRAME(F); p0_prologue(F); if (BOTH(0)) GRID_BAR(); }

    if (IN(1)) {
        MAKE_FRAME(F); unsigned char* ws = F.ws; LAS unsigned char* glds = F.lds;
        pg8::Gemm g{(const bf16*)(ws + WS_HB), (const bf16*)(ws + WS_WIN), SEQ, INW_PAD, DM}; asm volatile("" : "+s"(g.K), "+s"(g.N), "+s"(g.M)); pg8::StaticOrder S; S.init(SEQ, INW_PAD, F.G, F.bid);
        pg8::EpiWin E{(bf16*)(ws + WS_Q), (bf16*)(ws + WS_KV), (bf16*)(ws + WS_QI), (bf16*)(ws + WS_GU), (bf16*)(ws + WS_GV), (bf16*)(ws + WS_GA), (bf16*)(ws + WS_GG), (bf16*)(ws + WS_KIWI)};
        pg8::gemm_phase<pg8::EpiWin, pg8::StaticOrder, true, true>(glds, g, S, E);
        if (BOTH(1)) GRID_BAR();
    }

    if (IN(2)) {
        MAKE_FRAME(F); unsigned char* ws = F.ws; LAS unsigned char* glds = F.lds;
        for (int u = F.bid; u < 512; u += F.G) gmlp_unit(F, u);
#pragma unroll 1
        for (int k = F.bid, i = 0; k < 512; k += F.G, ++i) idx_unit(F, (F.G == 256 && i == 1) ? 511 - F.bid : k);
        if (BOTH(2)) GRID_BAR();
    }

    if (IN(3)) {
        MAKE_FRAME(F); unsigned char* ws = F.ws; LAS unsigned char* glds = F.lds;
        { pg8::Gemm g{(const bf16*)(ws + WS_ATT), (const bf16*)(ws + WS_WA), SEQ, DM, AW}; asm volatile("" : "+s"(g.K), "+s"(g.N), "+s"(g.M)); pg8::StaticOrder S; S.init(SEQ, DM, F.G, F.bid);
          pg8::EpiGateF32 E{(const bf16*)(ws + WS_GA), (float*)(ws + WS_T), DM};
          pg8::gemm_phase<pg8::EpiGateF32, pg8::StaticOrder, true, true>(glds, g, S, E); }
        __syncthreads();
        { pg8::Gemm g{(const bf16*)(ws + WS_GM), (const bf16*)(ws + WS_WG), SEQ, DM, GW}; asm volatile("" : "+s"(g.K), "+s"(g.N), "+s"(g.M)); pg8::StaticOrder S; S.init(SEQ, DM, F.G, F.bid);
          pg8::EpiMerge E{(const bf16*)(ws + WS_GG), (const float*)(ws + WS_T), (bf16*)(ws + WS_MERGED), DM};
          pg8::gemm_phase<pg8::EpiMerge, pg8::StaticOrder, true, true>(glds, g, S, E); }
        if (BOTH(3)) GRID_BAR();
    }

    if (IN(4)) {
        MAKE_FRAME(F); unsigned char* ws = F.ws; LAS unsigned char* glds = F.lds;
        pg8::Gemm g{(const bf16*)(ws + WS_MERGED), (const bf16*)(ws + WS_WMIX), SEQ, DM, DM}; asm volatile("" : "+s"(g.K), "+s"(g.N), "+s"(g.M)); pg8::StaticOrder S; S.init(SEQ, DM, F.G, F.bid);
        pg8::EpiMix E{F.in(0), (const float*)(ws + WS_STATS), F.in(3), F.in(4), F.out, DM};
        pg8::gemm_phase<pg8::EpiMix, pg8::StaticOrder, true, true>(glds, g, S, E);
        if (BOTH(4)) GRID_BAR();
    }

    if (IN(5)) {
        MAKE_FRAME(F); unsigned char* ws = F.ws; LAS unsigned char* glds = F.lds;
        const int gw = F.bid * NWAVES + F.wave, NGW = F.G * NWAVES;
        for (int m = gw; m < SEQ; m += NGW) ln_row(F, F.out + (size_t)m * DM, F.in(14), F.in(15), (bf16*)(ws + WS_H1B) + (size_t)m * DM, (float*)(ws + WS_H1F) + (size_t)m * DM, nullptr);
        if (BOTH(5)) GRID_BAR();
    }

    if (IN(6)) {
        MAKE_FRAME(F); unsigned char* ws = F.ws; LAS unsigned char* glds = F.lds;
        pg8::Gemm g{(const bf16*)(ws + WS_H1B), (const bf16*)(ws + WS_WQ), SEQ, DM, DM}; asm volatile("" : "+s"(g.K), "+s"(g.N), "+s"(g.M)); pg8::StaticOrder S; S.init(SEQ, DM, F.G, F.bid);
        pg8::EpiBf16<0> E{(bf16*)(ws + WS_PQ), DM, nullptr, 0, 0, 1.f};
        pg8::gemm_phase<pg8::EpiBf16<0>, pg8::StaticOrder, true, true>(glds, g, S, E);
        if (BOTH(6)) GRID_BAR();
    }

    if (IN(7)) {
        MAKE_FRAME(F); unsigned char* ws = F.ws; LAS unsigned char* glds = F.lds;
        for (int u = F.bid; u < SEQ / 32; u += F.G) peer_unit(F, u);
        if (BOTH(7)) GRID_BAR();
    }

    if (IN(8)) {
        MAKE_FRAME(F); unsigned char* ws = F.ws; LAS unsigned char* glds = F.lds;
        { pg8::Gemm g{(const bf16*)(ws + WS_PB), (const bf16*)(ws + WS_WPP), SEQ, DM, PLE}; asm volatile("" : "+s"(g.K), "+s"(g.N), "+s"(g.M)); pg8::StaticOrder S; S.init(SEQ, DM, F.G, F.bid);
          pg8::EpiF32 E{(float*)(ws + WS_T2), DM};
          pg8::gemm_phase<pg8::EpiF32, pg8::StaticOrder, true, true>(glds, g, S, E); }
        __syncthreads();
        { pg8::Gemm g{(const bf16*)(ws + WS_RB), (const bf16*)(ws + WS_WPG), SEQ, DM, DM}; asm volatile("" : "+s"(g.K), "+s"(g.N), "+s"(g.M)); pg8::StaticOrder S; S.init(SEQ, DM, F.G, F.bid);
          pg8::EpiPle E{(const float*)(ws + WS_RF), (const float*)(ws + WS_T2), F.out, DM};
          pg8::gemm_phase<pg8::EpiPle, pg8::StaticOrder, true, true>(glds, g, S, E); }
        if (BOTH(8)) GRID_BAR();
    }

    if (IN(9)) {
        MAKE_FRAME(F); unsigned char* ws = F.ws; LAS unsigned char* glds = F.lds;
        const int gw = F.bid * NWAVES + F.wave, NGW = F.G * NWAVES;
        for (int m = gw; m < SEQ; m += NGW) ln_row(F, F.out + (size_t)m * DM, F.in(22), F.in(23), nullptr, F.out + (size_t)m * DM, nullptr);
    }
}

extern "C" void kernel_launch(void* const* d_in, const int* in_sizes, int n_in, void* d_out, int out_size, void* d_ws, size_t ws_size, hipStream_t stream) {
    static int grid = 0;
    if (grid == 0) {
        if (n_in != 24 || out_size != SEQ * DM || ws_size < WS_END) { fprintf(stderr, "kernel_launch: unexpected problem: n_in %d out %d ws %zu (need %zu)\n", n_in, out_size, ws_size, (size_t)WS_END); grid = -1; return; }
        int dev = 0, cus = 0, per_cu = 0;
        if (hipGetDevice(&dev) != hipSuccess || hipDeviceGetAttribute(&cus, hipDeviceAttributeMultiprocessorCount, dev) != hipSuccess) { grid = -1; return; }
        if (hipFuncSetAttribute((const void*)mega_fwd, hipFuncAttributeMaxDynamicSharedMemorySize, LDS_BYTES) != hipSuccess) { fprintf(stderr, "kernel_launch: hipFuncSetAttribute failed\n"); grid = -1; return; }
        if (hipOccupancyMaxActiveBlocksPerMultiprocessor(&per_cu, (const void*)mega_fwd, NTHREADS, LDS_BYTES) != hipSuccess || per_cu < 1) { fprintf(stderr, "kernel_launch: occupancy query says %d blocks per CU\n", per_cu); (void)hipGetLastError(); grid = -1; return; }
        grid = cus;
        fprintf(stderr, "kernel_launch: grid %d (per_cu %d), ws %zu\n", grid, per_cu, ws_size);
    }
    if (grid < 0) return;
    Args a{};
    for (int i = 0; i < 24; ++i) a.in[i] = (const float*)d_in[i];
    a.out = (float*)d_out; a.ws = (unsigned char*)d_ws;
#if MK_COOP
    a.ph_lo = 0; a.ph_hi = N_PHASES;
    void* kargs[] = {&a};
    hipError_t e = hipLaunchCooperativeKernel((const void*)mega_fwd, dim3(grid), dim3(NTHREADS), kargs, LDS_BYTES, stream);
    if (e != hipSuccess) fprintf(stderr, "kernel_launch: cooperative launch failed: %s\n", hipGetErrorString(e));
#else
    for (int ph = 0; ph < N_PHASES; ++ph) { a.ph_lo = ph; a.ph_hi = ph + 1; hipLaunchKernelGGL(mega_fwd, dim3(grid), dim3(NTHREADS), LDS_BYTES, stream, a); }
#endif
}
```

```cpp
#include <hip/hip_runtime.h>
#include <hip/hip_cooperative_groups.h>
#include <cstdio>
#include <cstdint>
namespace cg = cooperative_groups;
#ifndef MK_COOP
#define MK_COOP 1
#endif
#define DBG_NO_ATTN 0
#define DBG_ATTN_X2 0
#define DBG_PEER_X2 0
#define DBG_NO_PEER 0
#define DBG_NO_GMLP 0
#define DBG_GMLP_X2 0
#define DBG_PLE_S 1.0f
#define DBG_MIX_S 1.0f
#define DBG_ATTN_HI_S 1.0f
#define DBG_LOGIT_S 1.0f
#define DBG_NO_BIAS 0
namespace pg8 {
#define PG8_LAS __attribute__((address_space(3)))
typedef unsigned short bf16_t;
typedef short bf16x8 __attribute__((ext_vector_type(8)));
typedef float f32x4 __attribute__((ext_vector_type(4)));
typedef unsigned u32x4 __attribute__((ext_vector_type(4)));
constexpr int BM = 256, BK = 64, HALF = 128, HTB = HALF * BK * 2  , STAGE_BYTES = 8 * HTB, NXCD = 8, WGM = 8;

__host__ __device__ __forceinline__ int lds_byte(int r, int c) { const int st = (r >> 4) * 2 + (c >> 5), rr = r & 15, cc = c & 31, ob = rr * 64 + cc * 2; return st * 1024 + (ob ^ (((ob >> 9) & 1) << 5)); }
__host__ __device__ __forceinline__ void stage_rc(int b, int& R, int& C) { const int st = b / 1024, sb = b % 1024, swz = sb ^ (((sb >> 9) & 1) << 5); R = (st >> 1) * 16 + swz / 64; C = (st & 1) * 32 + (swz % 64) / 2; }
__host__ __device__ __forceinline__ int perm32(int rho) { const int n = rho >> 4, i = rho & 15; return 8 * (i >> 2) + 4 * n + (i & 3); }

struct Unit { int pm, pn; };
struct Gemm { const bf16_t* A; const bf16_t* Bt; int M, N, K; };

struct StaticOrder {
    int nM, nN, nwg, G, c;
    __host__ __device__ void init(int M, int N, int G_, int c_) { nM = M / BM; nN = N / BM; nwg = nM * nN; G = G_; c = c_; }
    __host__ __device__ bool next(int i, Unit& u) const {
        const long L = (long)i * G + c; if (L >= nwg) return false;
        int wgid = (int)L; { const int q = nwg / NXCD, r = nwg % NXCD, xcd = wgid % NXCD, off = wgid / NXCD; wgid = (xcd < r ? xcd * (q + 1) : r * (q + 1) + (xcd - r) * q) + off; }
        const int nig = WGM * nN, gid = wgid / nig, fm = gid * WGM, gsz = (nM - fm) < WGM ? (nM - fm) : WGM;
        u.pm = fm + ((wgid % nig) % gsz); u.pn = (wgid % nig) / gsz; return true;
    }
    __device__ __forceinline__ void a_ready(const Unit&) const {}
    __device__ __forceinline__ void done(const Unit&) const {}
};

__device__ __forceinline__ unsigned cvt_pk_bf16(float lo, float hi) { unsigned r; asm volatile("v_cvt_pk_bf16_f32 %0, %1, %2" : "=v"(r) : "v"(lo), "v"(hi)); return r; }
typedef float f32x2 __attribute__((ext_vector_type(2)));
__device__ __forceinline__ f32x2 gelu_pk(f32x2 v) {
    const f32x2 av = __builtin_elementwise_abs(v), d = av * 0.2316418882f + 1.0f;
    f32x2 t; t.x = __builtin_amdgcn_rcpf(d.x); t.y = __builtin_amdgcn_rcpf(d.y);
    f32x2 q = t * 0.5307027145f + (-0.7265760135f); q = q * t + 0.7107068705f; q = q * t + (-0.142248368f); q = q * t + 0.127414796f; q = q * t;
    const f32x2 s = (v * v) * (-0.72134752044f);
    f32x2 e; e.x = __builtin_amdgcn_exp2f(s.x); e.y = __builtin_amdgcn_exp2f(s.y);
    const f32x2 m = v * (q * e), r = v - m;
    f32x2 o; o.x = v.x < 0.f ? m.x : r.x; o.y = v.y < 0.f ? m.y : r.y; return o;
}

template <int ACT  > struct EpiBf16 {
    static constexpr bool PERM = true, AFTER_DRAIN = false; static_assert(ACT == 0 || ACT == 1, "EpiBf16: ACT is 0 (none) or 1 (gelu_pk)");
    bf16_t* O; int ldc; const float* bias; int split_cols; size_t split_stride; float scale0;
    __device__ __forceinline__ void operator()(const f32x4 (&acc)[2][2][4][2], const Unit& u, int wr, int wc, int fr, int fq) const {
        const int row0 = u.pm * BM + wr * 64 + fr; int colt = u.pn * BM; bf16_t* base = O;
        float sc = 1.f; if (split_cols) { const int t = colt / split_cols; base += (size_t)t * split_stride; colt -= t * split_cols; if (t == 0) sc = scale0; }
        const int col0 = colt + wc * 32 + 8 * fq, bcol0 = u.pn * BM + wc * 32 + 8 * fq;
        f32x4 bv[2][2];
#pragma unroll
        for (int bj = 0; bj < 2; ++bj)
#pragma unroll
            for (int n = 0; n < 2; ++n) bv[bj][n] = bias ? *(const f32x4*)(bias + bcol0 + bj * HALF + 4 * n) : (f32x4){0.f, 0.f, 0.f, 0.f};
#pragma unroll
        for (int ai = 0; ai < 2; ++ai)
#pragma unroll
            for (int m = 0; m < 4; ++m) { bf16_t* rowp = base + (size_t)(row0 + ai * HALF + m * 16) * ldc + col0;
#pragma unroll
                for (int bj = 0; bj < 2; ++bj) { f32x4 v0 = acc[ai][bj][m][0] + bv[bj][0], v1 = acc[ai][bj][m][1] + bv[bj][1];
                    if (ACT == 1) { f32x2 a = gelu_pk((f32x2){v0[0], v0[1]}), b = gelu_pk((f32x2){v0[2], v0[3]}), c = gelu_pk((f32x2){v1[0], v1[1]}), d = gelu_pk((f32x2){v1[2], v1[3]});
                        v0 = (f32x4){a.x, a.y, b.x, b.y}; v1 = (f32x4){c.x, c.y, d.x, d.y}; }
                    v0 = v0 * sc; v1 = v1 * sc; u32x4 w; w.x = cvt_pk_bf16(v0[0], v0[1]); w.y = cvt_pk_bf16(v0[2], v0[3]); w.z = cvt_pk_bf16(v1[0], v1[1]); w.w = cvt_pk_bf16(v1[2], v1[3]);
                    *(u32x4*)(rowp + bj * HALF) = w; } }
    }
};
template <class Epi, class Sched, bool ALIGN_EPI = false, bool SP2 = false>
__device__ __forceinline__ void gemm_phase(PG8_LAS unsigned char* lds, const Gemm g, const Sched& S, const Epi& E) {
    const int tid = threadIdx.x, wid = __builtin_amdgcn_readfirstlane(tid >> 6), lane = tid & 63, wr = wid >> 2, wc = wid & 3, fr = lane & 15, fq = lane >> 4;
    const int K = g.K, nt = K / BK;
    unsigned voffA[2], voffB[2];
#pragma unroll
    for (int i = 0; i < 2; ++i) { int R, C; stage_rc(tid * 16 + i * 8192, R, C); const int Rb = Epi::PERM ? ((R & ~31) + perm32(R & 31)) : R;
        voffA[i] = (unsigned)(R * K + C) * 2u; voffB[i] = (unsigned)(Rb * K + C) * 2u; }
    const size_t kstep = (size_t)(BK * 2);
    const size_t hstep = (size_t)HALF * K * 2;
    const size_t tstep = 2 * hstep;
    const unsigned ldsw = (unsigned)wid * 1024u;
    const int aoff = lds_byte(wr * 64 + fr, fq * 8), boff = lds_byte(wc * 32 + fr, fq * 8);
#define PG8_SA(b, h) (((b) * 2 + (h)) * HTB)
#define PG8_SB(b, h) ((4 + (b) * 2 + (h)) * HTB)
#define PG8_STAGE(bufoff, gbase, voff) do { _Pragma("unroll") for (int _i = 0; _i < 2; ++_i) \
        __builtin_amdgcn_global_load_lds((const unsigned*)((const char*)(gbase) + (voff)[_i]), (PG8_LAS unsigned*)(lds + (bufoff) + ldsw + _i * 8192), 16, 0, 0); } while (0)
#define PG8_LDA(dst, b, h) do { _Pragma("unroll") for (int m = 0; m < 4; ++m) _Pragma("unroll") for (int k = 0; k < 2; ++k) dst[m][k] = *(const PG8_LAS bf16x8*)(lds + PG8_SA(b, h) + aoff + m * 2048 + k * 1024); } while (0)
#define PG8_LDB(dst, b, h) do { _Pragma("unroll") for (int n = 0; n < 2; ++n) _Pragma("unroll") for (int k = 0; k < 2; ++k) dst[n][k] = *(const PG8_LAS bf16x8*)(lds + PG8_SB(b, h) + boff + n * 2048 + k * 1024); } while (0)
#define PG8_MMA(ai, bj, At, Bt) do { __builtin_amdgcn_s_setprio(1); _Pragma("unroll") for (int m = 0; m < 4; ++m) _Pragma("unroll") for (int n = 0; n < 2; ++n) _Pragma("unroll") for (int k = 0; k < 2; ++k) \
        acc[ai][bj][m][n] = __builtin_amdgcn_mfma_f32_16x16x32_bf16(Bt[n][k], At[m][k], acc[ai][bj][m][n], 0, 0, 0); __builtin_amdgcn_s_setprio(0); } while (0)
#define PG8_WAIT_V(n) asm volatile("s_waitcnt vmcnt(" #n ")" ::: "memory")
#define PG8_WAIT_L(n) asm volatile("s_waitcnt lgkmcnt(" #n ")" ::: "memory")
#define PG8_BAR __builtin_amdgcn_s_barrier()
#define PG8_SCHED __builtin_amdgcn_sched_barrier(0)
    Unit cur, nxt; int ui = 0;
    if (!S.next(0, cur)) return;
    f32x4 acc[2][2][4][2];
#pragma unroll
    for (int a = 0; a < 2; ++a)
#pragma unroll
        for (int b = 0; b < 2; ++b)
#pragma unroll
            for (int m = 0; m < 4; ++m)
#pragma unroll
                for (int n = 0; n < 2; ++n) acc[a][b][m][n] = (f32x4){0.f, 0.f, 0.f, 0.f};
    bf16x8 At[4][2], B0[2][2], B1[2][2];
    const char* cA = (const char*)g.A + (size_t)cur.pm * tstep; const char* cB = (const char*)g.Bt + (size_t)cur.pn * tstep;
    S.a_ready(cur);
    if constexpr (SP2) {
        PG8_STAGE(PG8_SB(0, 0), cB, voffB); PG8_STAGE(PG8_SB(0, 1), cB + hstep, voffB); PG8_STAGE(PG8_SA(0, 0), cA, voffA); PG8_STAGE(PG8_SA(0, 1), cA + hstep, voffA);
        if (wr == 1) PG8_BAR;
        PG8_WAIT_V(2); PG8_BAR;
        PG8_STAGE(PG8_SB(1, 0), cB + kstep, voffB); PG8_STAGE(PG8_SA(1, 0), cA + kstep, voffA); PG8_STAGE(PG8_SB(1, 1), cB + hstep + kstep, voffB);
        PG8_WAIT_V(6); PG8_BAR;
    } else {
        PG8_STAGE(PG8_SB(0, 0), cB, voffB); PG8_STAGE(PG8_SA(0, 0), cA, voffA); PG8_STAGE(PG8_SB(0, 1), cB + hstep, voffB); PG8_STAGE(PG8_SA(0, 1), cA + hstep, voffA);
        if (wr == 1) PG8_BAR;
        PG8_WAIT_V(4); PG8_BAR;
        PG8_STAGE(PG8_SB(1, 0), cB + kstep, voffB); PG8_STAGE(PG8_SA(1, 0), cA + kstep, voffA); PG8_STAGE(PG8_SB(1, 1), cB + hstep + kstep, voffB);
        PG8_WAIT_V(6); PG8_BAR;
    }
    for (;;) {
        const bool has_next = S.next(ui + 1, nxt);
        const char* nA = has_next ? (const char*)g.A + (size_t)nxt.pm * tstep : cA; const char* nB = has_next ? (const char*)g.Bt + (size_t)nxt.pn * tstep : cB;
        for (int t = 0; t < nt; t += 2) {
            const bool last = (t == nt - 2);
            const char* a1 = cA + (size_t)(t + 1) * kstep;
            const char* a2 = last ? nA : cA + (size_t)(t + 2) * kstep; const char* b2 = last ? nB : cB + (size_t)(t + 2) * kstep;
            const char* a3 = a2 + kstep; const char* b3 = b2 + kstep;
            if (last && has_next) S.a_ready(nxt);
            if constexpr (SP2) {
            PG8_LDB(B0, 0, 0); PG8_LDB(B1, 0, 1); PG8_SCHED; PG8_LDA(At, 0, 0); PG8_STAGE(PG8_SA(1, 1), a1 + hstep, voffA);
            PG8_WAIT_V(8); PG8_WAIT_L(0); PG8_BAR; PG8_MMA(0, 0, At, B0); PG8_MMA(0, 1, At, B1); PG8_BAR; PG8_SCHED;
            PG8_LDA(At, 0, 1); PG8_STAGE(PG8_SB(0, 0), b2, voffB); PG8_STAGE(PG8_SB(0, 1), b2 + hstep, voffB); PG8_STAGE(PG8_SA(0, 0), a2, voffA);
            PG8_WAIT_V(8); PG8_WAIT_L(0); PG8_BAR; PG8_MMA(1, 0, At, B0); PG8_MMA(1, 1, At, B1); PG8_BAR; PG8_SCHED;
            PG8_LDB(B0, 1, 0); PG8_LDB(B1, 1, 1); PG8_SCHED; PG8_LDA(At, 1, 0); PG8_STAGE(PG8_SA(0, 1), a2 + hstep, voffA);
            PG8_WAIT_V(8); PG8_WAIT_L(0); PG8_BAR; PG8_MMA(0, 0, At, B0); PG8_MMA(0, 1, At, B1); PG8_BAR; PG8_SCHED;
            PG8_LDA(At, 1, 1); PG8_STAGE(PG8_SB(1, 0), b3, voffB); PG8_STAGE(PG8_SB(1, 1), b3 + hstep, voffB); PG8_STAGE(PG8_SA(1, 0), a3, voffA);
            PG8_WAIT_V(8); PG8_WAIT_L(0); PG8_BAR; PG8_MMA(1, 0, At, B0); PG8_MMA(1, 1, At, B1); PG8_BAR; PG8_SCHED;
            } else {
            PG8_LDB(B0, 0, 0); PG8_SCHED; PG8_LDA(At, 0, 0); PG8_STAGE(PG8_SA(1, 1), a1 + hstep, voffA);
            PG8_WAIT_L(8); PG8_BAR; PG8_WAIT_L(0); PG8_MMA(0, 0, At, B0); PG8_BAR; PG8_SCHED;
            PG8_LDB(B1, 0, 1); PG8_STAGE(PG8_SB(0, 0), b2, voffB);
            PG8_BAR; PG8_WAIT_L(0); PG8_MMA(0, 1, At, B1); PG8_BAR;
            PG8_LDA(At, 0, 1); PG8_STAGE(PG8_SA(0, 0), a2, voffA);
            PG8_BAR; PG8_WAIT_L(0); PG8_MMA(1, 0, At, B0); PG8_BAR; PG8_SCHED;
            PG8_STAGE(PG8_SB(0, 1), b2 + hstep, voffB);
            PG8_WAIT_V(6); PG8_BAR; PG8_MMA(1, 1, At, B1); PG8_BAR;
            PG8_LDB(B0, 1, 0); PG8_SCHED; PG8_LDA(At, 1, 0); PG8_STAGE(PG8_SA(0, 1), a2 + hstep, voffA);
            PG8_WAIT_L(8); PG8_BAR; PG8_WAIT_L(0); PG8_MMA(0, 0, At, B0); PG8_BAR; PG8_SCHED;
            PG8_LDB(B1, 1, 1); PG8_STAGE(PG8_SB(1, 0), b3, voffB);
            PG8_BAR; PG8_WAIT_L(0); PG8_MMA(0, 1, At, B1); PG8_BAR;
            PG8_LDA(At, 1, 1); PG8_STAGE(PG8_SA(1, 0), a3, voffA);
            PG8_BAR; PG8_WAIT_L(0); PG8_MMA(1, 0, At, B0); PG8_BAR; PG8_SCHED;
            PG8_STAGE(PG8_SB(1, 1), b3 + hstep, voffB);
            PG8_WAIT_V(6); PG8_BAR; PG8_MMA(1, 1, At, B1); PG8_BAR;
            }
        }
        if constexpr (ALIGN_EPI) { if (wr == 0) PG8_BAR; }
        if constexpr (!Epi::AFTER_DRAIN) { E(acc, cur, wr, wc, fr, fq); S.done(cur); }
        if (!has_next) break;
#pragma unroll
        for (int a = 0; a < 2; ++a)
#pragma unroll
            for (int b = 0; b < 2; ++b)
#pragma unroll
                for (int m = 0; m < 4; ++m)
#pragma unroll
                    for (int n = 0; n < 2; ++n) acc[a][b][m][n] = (f32x4){0.f, 0.f, 0.f, 0.f};
        cur = nxt; cA = nA; cB = nB; ++ui;
        if constexpr (ALIGN_EPI) { if (wr == 1) PG8_BAR; }
    }
    PG8_WAIT_V(0);
    if constexpr (!ALIGN_EPI) { if (wr == 0) PG8_BAR; }
    PG8_BAR;
    if constexpr (Epi::AFTER_DRAIN) { E.fused(acc, cur, wr, wc, fr, fq, lds, wid, lane); S.done(cur); }
#undef PG8_SA
#undef PG8_SB
#undef PG8_STAGE
#undef PG8_LDA
#undef PG8_LDB
#undef PG8_MMA
#undef PG8_WAIT_V
#undef PG8_WAIT_L
#undef PG8_BAR
#undef PG8_SCHED
}
}

constexpr int SEQ = 8192, DM = 2048, INW = 10320, INW_PAD = 10496;
constexpr int AW = 1024, NIH = 16, IHD = 64, TOPK = 256, GW = 1024;
constexpr int PE_H = 8, PE_NK = 128, PE_TOPK = 16, PE_NE = 16384, PLE = 256;
constexpr float LN_EPS = 1e-5f;
constexpr float ALPHA = 1.189207115002721f;
constexpr float QSCALE = 0.08838834764831845f;
constexpr int NWAVES = 8, NTHREADS = 512;
constexpr int LDS_BYTES = 147456;

constexpr size_t MiB = 1u << 20;
constexpr size_t WS_WA = 1 * MiB, WS_WG = 5 * MiB, WS_WMIX = 9 * MiB, WS_WQ = 17 * MiB, WS_WPG = 25 * MiB, WS_WPP = 33 * MiB, WS_SUBK = 34 * MiB;
constexpr size_t WS_PU = 35 * MiB, WS_PV = 99 * MiB, WS_STATS = 163 * MiB;
constexpr size_t WS_WIN = 164 * MiB, WS_HB = 205 * MiB;
constexpr size_t WS_Q = 237 * MiB, WS_KV = 253 * MiB, WS_QI = 285 * MiB, WS_KIWI = 301 * MiB;
constexpr size_t WS_GU = 305 * MiB, WS_GV = 321 * MiB, WS_GA = 337 * MiB, WS_GG = 369 * MiB;
constexpr size_t WS_GM = 401 * MiB, WS_ATT = 417 * MiB, WS_SC = 433 * MiB, WS_PB = 497 * MiB;
constexpr size_t WS_T = 164 * MiB, WS_MERGED = 237 * MiB, WS_H1F = 269 * MiB, WS_H1B = 333 * MiB, WS_PQ = 365 * MiB;
constexpr size_t WS_RF = 164 * MiB, WS_RB = 228 * MiB, WS_T2 = 405 * MiB;
constexpr size_t WS_END = 512 * MiB;

#define GAS __attribute__((address_space(1)))
#define LAS __attribute__((address_space(3)))
typedef unsigned short bf16;
typedef unsigned v4u __attribute__((ext_vector_type(4)));
typedef unsigned v2u __attribute__((ext_vector_type(2)));
typedef float f32x4 __attribute__((ext_vector_type(4)));
typedef float f32x16 __attribute__((ext_vector_type(16)));
typedef short bf16x8 __attribute__((ext_vector_type(8)));
typedef __attribute__((ext_vector_type(2))) __bf16 bf2v;
#define LDS_WAIT() asm volatile("s_waitcnt lgkmcnt(0)" ::: "memory")
#define VM_WAIT() asm volatile("s_waitcnt vmcnt(0)" ::: "memory")

__device__ __forceinline__ unsigned f2bf(float f) { unsigned u = __builtin_bit_cast(unsigned, f); return (u + 0x7fffu + ((u >> 16) & 1u)) >> 16; }
__device__ __forceinline__ unsigned pk2(float lo, float hi) { return f2bf(lo) | (f2bf(hi) << 16); }
__device__ __forceinline__ float bflo(unsigned u) { return __builtin_bit_cast(float, u << 16); }
__device__ __forceinline__ float bfhi(unsigned u) { return __builtin_bit_cast(float, u & 0xffff0000u); }
__device__ __forceinline__ float bf2f(bf16 h) { return __builtin_bit_cast(float, (unsigned)h << 16); }
__device__ __forceinline__ float fast_rcp(float x) { return __builtin_amdgcn_rcpf(x); }
__device__ __forceinline__ float sigmoidf_(float x) { return fast_rcp(1.f + __expf(-x)); }
__device__ __forceinline__ float gelu_tanh(float x) { const float u = 1.5957691216057308f * (x + 0.044715f * x * x * x); return x * fast_rcp(1.f + __expf(-u)); }
__device__ __forceinline__ float wave_sum(float v) {
#pragma unroll
    for (int o = 1; o < 64; o <<= 1) v += __shfl_xor(v, o);
    return v;
}
__device__ __forceinline__ float dot2bf(unsigned a, unsigned b, float c) { return __builtin_amdgcn_fdot2_f32_bf16(__builtin_bit_cast(bf2v, a), __builtin_bit_cast(bf2v, b), c, false); }
__device__ __forceinline__ unsigned sortable(float f) { const unsigned u = __builtin_bit_cast(unsigned, f); return (u & 0x80000000u) ? ~u : (u | 0x80000000u); }

typedef const __attribute__((address_space(4))) unsigned char* kargp_t;
__device__ __forceinline__ unsigned long long karg_u64(int byte_off) {
    kargp_t ka = (kargp_t)__builtin_amdgcn_kernarg_segment_ptr();
    asm volatile("" : "+s"(ka));
    return *(const __attribute__((address_space(4))) unsigned long long*)(ka + byte_off);
}
struct Frame {
    LAS unsigned char* lds;
    int tid, lane, wave, G, bid;
    float* out; unsigned char* ws;
    __device__ __forceinline__ const float* in(int k) const { return (const float*)karg_u64(8 * k); }
};
#define MAKE_FRAME(F) Frame F; { int t_ = threadIdx.x; asm volatile("" : "+v"(t_)); F.tid = t_; F.lane = t_ & 63; F.wave = __builtin_amdgcn_readfirstlane(t_ >> 6); \
    F.G = gridDim.x; F.bid = blockIdx.x; F.lds = (LAS unsigned char*)lds_raw; F.out = (float*)karg_u64(192); F.ws = (unsigned char*)karg_u64(200); }

__device__ __forceinline__ int win_dest(int n) { return n < 4096 ? n : (n < 4176 ? n + 6144 : n - 80); }
template <bool MAP>
__device__ __forceinline__ void p0_transpose_item(const float* W, int K, int N, bf16* WT, LAS float* scr, int item, int lane) {
    const int nblk = (N + 31) / 32, kb = item / nblk, nb = item % nblk, k0 = 64 * kb, n0 = 32 * nb;
    const int nn = n0 + (lane & 31); const bool ok = nn < N;
#pragma unroll 8
    for (int i = 0; i < 32; ++i) { const int kk = 2 * i + (lane >> 5); scr[kk * 33 + (lane & 31)] = ok ? W[(size_t)(k0 + kk) * N + nn] : 0.f; }
    LDS_WAIT(); asm volatile("" ::: "memory");
    const int c = lane & 7;
#pragma unroll
    for (int j = 0; j < 4; ++j) { const int n = (lane >> 3) + 8 * j; const LAS float* s = scr + (8 * c) * 33 + n;
        v4u o; o.x = pk2(s[0 * 33], s[1 * 33]); o.y = pk2(s[2 * 33], s[3 * 33]); o.z = pk2(s[4 * 33], s[5 * 33]); o.w = pk2(s[6 * 33], s[7 * 33]);
        if (n0 + n < N) { const int drow = MAP ? win_dest(n0 + n) : (n0 + n); *(GAS v4u*)(WT + (size_t)drow * K + k0 + 8 * c) = o; } }
    LDS_WAIT(); asm volatile("" ::: "memory");
}
__device__ __forceinline__ void p0_convert(Frame& F, const float* src, bf16* dst, size_t n) {
    const size_t nth = (size_t)F.G * NTHREADS, n8 = n / 8;
    for (size_t i = (size_t)F.bid * NTHREADS + F.tid; i < n8; i += nth) {
        const f32x4 a = ((const GAS f32x4*)src)[2 * i], b = ((const GAS f32x4*)src)[2 * i + 1];
        v4u o; o.x = pk2(a.x, a.y); o.y = pk2(a.z, a.w); o.z = pk2(b.x, b.y); o.w = pk2(b.z, b.w);
        ((GAS v4u*)dst)[i] = o; }
}
__device__ __forceinline__ void ln_row(Frame& F, const float* xrow, const float* g, const float* b, bf16* ob, float* of, float* stats) {
    const GAS f32x4* xr = (const GAS f32x4*)xrow + F.lane;
    f32x4 v[8]; float s = 0.f;
#pragma unroll
    for (int j = 0; j < 8; ++j) { v[j] = xr[64 * j]; s += (v[j].x + v[j].y) + (v[j].z + v[j].w); }
    const float mean = wave_sum(s) * (1.f / DM); float s2 = 0.f;
#pragma unroll
    for (int j = 0; j < 8; ++j) { v[j] = v[j] - mean; s2 += (v[j].x * v[j].x + v[j].y * v[j].y) + (v[j].z * v[j].z + v[j].w * v[j].w); }
    const float rstd = 1.f / sqrtf(wave_sum(s2) * (1.f / DM) + LN_EPS);
    if (stats && F.lane == 0) { stats[0] = mean; stats[1] = rstd; }
#pragma unroll
    for (int j = 0; j < 8; ++j) {
        const f32x4 gg = ((const GAS f32x4*)g)[64 * j + F.lane], bb = ((const GAS f32x4*)b)[64 * j + F.lane];
        const f32x4 y = v[j] * rstd * gg + bb;
        if (ob) { v2u o; o.x = pk2(y.x, y.y); o.y = pk2(y.z, y.w); ((GAS v2u*)ob)[64 * j + F.lane] = o; }
        if (of) ((GAS f32x4*)of)[64 * j + F.lane] = y;
    }
}
__device__ __forceinline__ void p0_prologue(Frame& F) {
    LAS float* scr = (LAS float*)(F.lds + F.wave * 16384);
    const int gw = F.bid * NWAVES + F.wave, NGW = F.G * NWAVES;
    unsigned char* ws = F.ws;
    constexpr int I_IN = (DM / 64) * ((INW + 31) / 32), I_A = (AW / 64) * (DM / 32), I_G = (GW / 64) * (DM / 32), I_SQ = (DM / 64) * (DM / 32), I_PP = (PLE / 64) * (DM / 32);
    constexpr int NITEMS = I_IN + I_A + I_G + 3 * I_SQ + I_PP;
    for (int it = gw; it < NITEMS; it += NGW) {
        int r = it;
        if (r < I_IN) { p0_transpose_item<true>(F.in(6), DM, INW, (bf16*)(ws + WS_WIN), scr, r, F.lane); continue; } r -= I_IN;
        if (r < I_A) { p0_transpose_item<false>(F.in(11), AW, DM, (bf16*)(ws + WS_WA), scr, r, F.lane); continue; } r -= I_A;
        if (r < I_G) { p0_transpose_item<false>(F.in(12), GW, DM, (bf16*)(ws + WS_WG), scr, r, F.lane); continue; } r -= I_G;
        if (r < I_SQ) { p0_transpose_item<false>(F.in(13), DM, DM, (bf16*)(ws + WS_WMIX), scr, r, F.lane); continue; } r -= I_SQ;
        if (r < I_SQ) { p0_transpose_item<false>(F.in(16), DM, DM, (bf16*)(ws + WS_WQ), scr, r, F.lane); continue; } r -= I_SQ;
        if (r < I_SQ) { p0_transpose_item<false>(F.in(21), DM, DM, (bf16*)(ws + WS_WPG), scr, r, F.lane); continue; } r -= I_SQ;
        p0_transpose_item<false>(F.in(20), PLE, DM, (bf16*)(ws + WS_WPP), scr, r, F.lane);
    }
    { const size_t n16 = (size_t)(INW_PAD - INW) * DM * 2 / 16; GAS v4u* z = (GAS v4u*)(ws + WS_WIN + (size_t)INW * DM * 2);
      for (size_t i = (size_t)F.bid * NTHREADS + F.tid; i < n16; i += (size_t)F.G * NTHREADS) z[i] = (v4u){0u, 0u, 0u, 0u}; }
    p0_convert(F, F.in(18), (bf16*)(ws + WS_PU), (size_t)PE_NE * DM);
    p0_convert(F, F.in(19), (bf16*)(ws + WS_PV), (size_t)PE_NE * DM);
    p0_convert(F, F.in(17), (bf16*)(ws + WS_SUBK), (size_t)PE_H * 2 * PE_NK * 128);
    p0_convert(F, F.in(1), (bf16*)(ws + WS_PB), (size_t)SEQ * PLE);
    for (int m = gw; m < SEQ; m += NGW) ln_row(F, F.in(0) + (size_t)m * DM, F.in(3), F.in(4), (bf16*)(ws + WS_HB) + (size_t)m * DM, nullptr, (float*)(ws + WS_STATS) + 2 * m);
}

namespace pg8 {
struct EpiWin {
    static constexpr bool PERM = true, AFTER_DRAIN = false;
    bf16 *q, *kv, *qi, *gu, *gv, *ga, *gg, *kiwi;
    __device__ __forceinline__ void operator()(const f32x4 (&acc)[2][2][4][2], const Unit& u, int wr, int wc, int fr, int fq) const {
        const int pn = u.pn; bf16* base; int ld, colt, act = 0; float sc = 1.f;
        if (pn < 4) { base = q; ld = 1024; colt = pn * 256; sc = QSCALE; }
        else if (pn < 12) { base = kv; ld = 2048; colt = (pn - 4) * 256; }
        else if (pn < 16) { base = qi; ld = 1024; colt = (pn - 12) * 256; }
        else if (pn < 20) { base = gu; ld = 1024; colt = (pn - 16) * 256; act = 1; }
        else if (pn < 24) { base = gv; ld = 1024; colt = (pn - 20) * 256; act = 1; }
        else if (pn < 32) { base = ga; ld = 2048; colt = (pn - 24) * 256; act = 2; }
        else if (pn < 40) { base = gg; ld = 2048; colt = (pn - 32) * 256; act = 2; }
        else { base = kiwi; ld = 256; colt = 0; }
        const int row0 = u.pm * BM + wr * 64 + fr, col0 = colt + wc * 32 + 8 * fq;
#pragma unroll
        for (int ai = 0; ai < 2; ++ai)
#pragma unroll
            for (int m = 0; m < 4; ++m) { bf16* rowp = base + (size_t)(row0 + ai * HALF + m * 16) * ld + col0;
#pragma unroll
                for (int bj = 0; bj < 2; ++bj) { f32x4 v0 = acc[ai][bj][m][0], v1 = acc[ai][bj][m][1];
                    if (act == 1) {
#pragma unroll
                        for (int e = 0; e < 4; ++e) { v0[e] = gelu_tanh(v0[e]); v1[e] = gelu_tanh(v1[e]); } }
                    else if (act == 2) {
#pragma unroll
                        for (int e = 0; e < 4; ++e) { v0[e] = sigmoidf_(v0[e]); v1[e] = sigmoidf_(v1[e]); } }
                    else { v0 = v0 * sc; v1 = v1 * sc; }
                    v4u w; w.x = pk2(v0[0], v0[1]); w.y = pk2(v0[2], v0[3]); w.z = pk2(v1[0], v1[1]); w.w = pk2(v1[2], v1[3]);
                    *(GAS v4u*)(rowp + bj * HALF) = w; } }
    }
};
struct EpiGateF32 {
    static constexpr bool PERM = true, AFTER_DRAIN = false;
    const bf16* gate; float* T; int ldc;
    __device__ __forceinline__ void operator()(const f32x4 (&acc)[2][2][4][2], const Unit& u, int wr, int wc, int fr, int fq) const {
        const int row0 = u.pm * BM + wr * 64 + fr, col0 = u.pn * BM + wc * 32 + 8 * fq;
#pragma unroll
        for (int ai = 0; ai < 2; ++ai)
#pragma unroll
            for (int m = 0; m < 4; ++m) { const size_t off = (size_t)(row0 + ai * HALF + m * 16) * ldc + col0;
#pragma unroll
                for (int bj = 0; bj < 2; ++bj) { const v4u g = *(const GAS v4u*)(gate + off + bj * HALF);
                    f32x4 v0 = acc[ai][bj][m][0], v1 = acc[ai][bj][m][1];
                    v0[0] *= bflo(g.x); v0[1] *= bfhi(g.x); v0[2] *= bflo(g.y); v0[3] *= bfhi(g.y);
                    v1[0] *= bflo(g.z); v1[1] *= bfhi(g.z); v1[2] *= bflo(g.w); v1[3] *= bfhi(g.w);
                    *(GAS f32x4*)(T + off + bj * HALF) = v0; *(GAS f32x4*)(T + off + bj * HALF + 4) = v1; } }
    }
};
struct EpiMerge {
    static constexpr bool PERM = true, AFTER_DRAIN = false;
    const bf16* gate; const float* T; bf16* O; int ldc;
    __device__ __forceinline__ void operator()(const f32x4 (&acc)[2][2][4][2], const Unit& u, int wr, int wc, int fr, int fq) const {
        const int row0 = u.pm * BM + wr * 64 + fr, col0 = u.pn * BM + wc * 32 + 8 * fq;
#pragma unroll
        for (int ai = 0; ai < 2; ++ai)
#pragma unroll
            for (int m = 0; m < 4; ++m) { const size_t off = (size_t)(row0 + ai * HALF + m * 16) * ldc + col0;
#pragma unroll
                for (int bj = 0; bj < 2; ++bj) { const v4u g = *(const GAS v4u*)(gate + off + bj * HALF);
                    const f32x4 t0 = *(const GAS f32x4*)(T + off + bj * HALF), t1 = *(const GAS f32x4*)(T + off + bj * HALF + 4);
                    f32x4 v0 = acc[ai][bj][m][0], v1 = acc[ai][bj][m][1];
                    v0[0] = t0[0] + v0[0] * bflo(g.x); v0[1] = t0[1] + v0[1] * bfhi(g.x); v0[2] = t0[2] + v0[2] * bflo(g.y); v0[3] = t0[3] + v0[3] * bfhi(g.y);
                    v1[0] = t1[0] + v1[0] * bflo(g.z); v1[1] = t1[1] + v1[1] * bfhi(g.z); v1[2] = t1[2] + v1[2] * bflo(g.w); v1[3] = t1[3] + v1[3] * bfhi(g.w);
                    v4u w; w.x = pk2(v0[0], v0[1]); w.y = pk2(v0[2], v0[3]); w.z = pk2(v1[0], v1[1]); w.w = pk2(v1[2], v1[3]);
                    *(GAS v4u*)(O + off + bj * HALF) = w; } }
    }
};
struct EpiMix {
    static constexpr bool PERM = false, AFTER_DRAIN = false;
    const float* x; const float* stats; const float* g; const float* b; float* Y; int ldc;
    __device__ __forceinline__ void operator()(const f32x4 (&acc)[2][2][4][2], const Unit& u, int wr, int wc, int fr, int fq) const {
        const int row0 = u.pm * BM + wr * 64 + fr, col0 = u.pn * BM + wc * 32 + 4 * fq;
        f32x4 gv[2][2], bv[2][2];
#pragma unroll
        for (int bj = 0; bj < 2; ++bj)
#pragma unroll
            for (int n = 0; n < 2; ++n) { gv[bj][n] = *(const GAS f32x4*)(g + col0 + bj * HALF + n * 16); bv[bj][n] = *(const GAS f32x4*)(b + col0 + bj * HALF + n * 16); }
#pragma unroll
        for (int ai = 0; ai < 2; ++ai)
#pragma unroll
            for (int m = 0; m < 4; ++m) { const int r = row0 + ai * HALF + m * 16; const size_t off = (size_t)r * ldc + col0;
                const float mean = stats[2 * r], rstd = stats[2 * r + 1];
#pragma unroll
                for (int bj = 0; bj < 2; ++bj)
#pragma unroll
                    for (int n = 0; n < 2; ++n) { const f32x4 xv = *(const GAS f32x4*)(x + off + bj * HALF + n * 16);
                        const f32x4 h = (xv - mean) * rstd * gv[bj][n] + bv[bj][n];
                        *(GAS f32x4*)(Y + off + bj * HALF + n * 16) = h * ALPHA + acc[ai][bj][m][n] * DBG_MIX_S; } }
    }
};
struct EpiF32 {
    static constexpr bool PERM = false, AFTER_DRAIN = false;
    float* Y; int ldc;
    __device__ __forceinline__ void operator()(const f32x4 (&acc)[2][2][4][2], const Unit& u, int wr, int wc, int fr, int fq) const {
        const int row0 = u.pm * BM + wr * 64 + fr, col0 = u.pn * BM + wc * 32 + 4 * fq;
#pragma unroll
        for (int ai = 0; ai < 2; ++ai)
#pragma unroll
            for (int m = 0; m < 4; ++m) { const size_t off = (size_t)(row0 + ai * HALF + m * 16) * ldc + col0;
#pragma unroll
                for (int bj = 0; bj < 2; ++bj)
#pragma unroll
                    for (int n = 0; n < 2; ++n) *(GAS f32x4*)(Y + off + bj * HALF + n * 16) = acc[ai][bj][m][n]; }
    }
};
struct EpiPle {
    static constexpr bool PERM = false, AFTER_DRAIN = false;
    const float* R; const float* T2; float* Y; int ldc;
    __device__ __forceinline__ void operator()(const f32x4 (&acc)[2][2][4][2], const Unit& u, int wr, int wc, int fr, int fq) const {
        const int row0 = u.pm * BM + wr * 64 + fr, col0 = u.pn * BM + wc * 32 + 4 * fq;
#pragma unroll
        for (int ai = 0; ai < 2; ++ai)
#pragma unroll
            for (int m = 0; m < 4; ++m) { const size_t off = (size_t)(row0 + ai * HALF + m * 16) * ldc + col0;
#pragma unroll
                for (int bj = 0; bj < 2; ++bj)
#pragma unroll
                    for (int n = 0; n < 2; ++n) { const f32x4 rv = *(const GAS f32x4*)(R + off + bj * HALF + n * 16), tv = *(const GAS f32x4*)(T2 + off + bj * HALF + n * 16);
                        const f32x4 a = acc[ai][bj][m][n]; f32x4 o;
#pragma unroll
                        for (int e = 0; e < 4; ++e) o[e] = rv[e] + DBG_PLE_S * sigmoidf_(a[e]) * tv[e];
                        *(GAS f32x4*)(Y + off + bj * HALF + n * 16) = o; } }
    }
};
}

__device__ __forceinline__ f32x16 mfma32(bf16x8 a, bf16x8 b, f32x16 c) { return __builtin_amdgcn_mfma_f32_32x32x16_bf16(a, b, c, 0, 0, 0); }
__device__ __forceinline__ void unpack8(const v4u a, float (&x)[8]) { x[0] = bflo(a.x); x[1] = bfhi(a.x); x[2] = bflo(a.y); x[3] = bfhi(a.y); x[4] = bflo(a.z); x[5] = bfhi(a.z); x[6] = bflo(a.w); x[7] = bfhi(a.w); }

__device__ __forceinline__ void gmlp_unit(Frame& F, int unit) {
    const int n = unit >> 3, g = unit & 7, row0 = n * 128;
    const bf16* gvb = (const bf16*)(F.ws + WS_GV); const bf16* gub = (const bf16*)(F.ws + WS_GU); bf16* gm = (bf16*)(F.ws + WS_GM);
    LAS float* st = (LAS float*)F.lds;
    LAS bf16* VT = (LAS bf16*)(F.lds + 1024);
    for (int i = 0; i < 16; ++i) { const int r = F.wave * 16 + i;
        const GAS v4u* rp = (const GAS v4u*)(gvb + (size_t)(row0 + r) * GW);
        const v4u a = rp[F.lane], b = rp[64 + F.lane];
        float x[16]; { float t0[8], t1[8]; unpack8(a, t0); unpack8(b, t1);
#pragma unroll
            for (int e = 0; e < 8; ++e) { x[e] = t0[e]; x[8 + e] = t1[e]; } }
        float s = 0.f;
#pragma unroll
        for (int e = 0; e < 16; ++e) s += x[e];
        const float mean = wave_sum(s) * (1.f / GW); float s2 = 0.f;
#pragma unroll
        for (int e = 0; e < 16; ++e) { const float d = x[e] - mean; s2 += d * d; }
        const float rstd = 1.f / sqrtf(wave_sum(s2) * (1.f / GW) + LN_EPS);
        if (F.lane == 0) { st[2 * r] = mean; st[2 * r + 1] = rstd; } }
    __syncthreads();
    const float* lg = F.in(7) + g * 128; const float* lb = F.in(8) + g * 128;
#pragma unroll
    for (int i = 0; i < 4; ++i) { const int id = F.tid + 512 * i, s = id >> 4, c8 = id & 15;
        const v4u a = *(const GAS v4u*)(gvb + (size_t)(row0 + s) * GW + g * 128 + c8 * 8);
        float x[8]; unpack8(a, x);
        const float mean = st[2 * s], rstd = st[2 * s + 1];
        const f32x4 g0 = *(const GAS f32x4*)(lg + c8 * 8), g1 = *(const GAS f32x4*)(lg + c8 * 8 + 4), b0 = *(const GAS f32x4*)(lb + c8 * 8), b1 = *(const GAS f32x4*)(lb + c8 * 8 + 4);
#pragma unroll
        for (int e = 0; e < 8; ++e) { const float gg = e < 4 ? g0[e & 3] : g1[e & 3], bb = e < 4 ? b0[e & 3] : b1[e & 3];
            VT[(c8 * 8 + e) * 136 + s] = (bf16)f2bf((x[e] - mean) * rstd * gg + bb); } }
    __syncthreads();
    const int r = F.lane & 31, hh = F.lane >> 5, tt = F.wave >> 1, ct0 = (F.wave & 1) * 2;
    f32x16 acc0, acc1;
#pragma unroll
    for (int e = 0; e < 16; ++e) { acc0[e] = 0.f; acc1[e] = 0.f; }
    const float* wsm = F.in(9) + (size_t)g * 128 * 128;
    const int t = tt * 32 + r;
    for (int ks = 0; ks < (tt + 1) * 2; ++ks) {
        const int k0 = ks * 16 + 8 * hh;
        const f32x4 w0 = *(const GAS f32x4*)(wsm + t * 128 + k0), w1 = *(const GAS f32x4*)(wsm + t * 128 + k0 + 4);
        float wv[8] = {w0.x, w0.y, w0.z, w0.w, w1.x, w1.y, w1.z, w1.w};
#pragma unroll
        for (int e = 0; e < 8; ++e) if (k0 + e > t) wv[e] = 0.f;
        v4u ap; ap.x = pk2(wv[0], wv[1]); ap.y = pk2(wv[2], wv[3]); ap.z = pk2(wv[4], wv[5]); ap.w = pk2(wv[6], wv[7]);
        const bf16x8 A = __builtin_bit_cast(bf16x8, ap);
        const bf16x8 B0 = *(const LAS bf16x8*)(VT + (ct0 * 32 + r) * 136 + k0), B1 = *(const LAS bf16x8*)(VT + ((ct0 + 1) * 32 + r) * 136 + k0);
        acc0 = mfma32(A, B0, acc0); acc1 = mfma32(A, B1, acc1);
    }
    const float* bs = F.in(10) + g * 128;
#pragma unroll
    for (int reg = 0; reg < 16; ++reg) { const int tr = tt * 32 + (reg & 3) + 8 * (reg >> 2) + 4 * hh; const float bsv = bs[tr];
        const size_t o0 = (size_t)(row0 + tr) * GW + g * 128 + ct0 * 32 + r;
#if DBG_GMLP_X2
        acc0[reg] *= 2.f; acc1[reg] *= 2.f;
#endif
#if DBG_NO_GMLP
        acc0[reg] = 0.f; acc1[reg] = 0.f;
#endif
        gm[o0] = (bf16)f2bf(bf2f(gub[o0]) * (acc0[reg] + bsv));
        gm[o0 + 32] = (bf16)f2bf(bf2f(gub[o0 + 32]) * (acc1[reg] + bsv)); }
    __syncthreads();
}

__device__ __constant__ unsigned char REL_BUCKET[128] = {0, 1, 2, 3, 4, 5, 6, 7, 8, 9, 10, 11, 12, 13, 14, 15, 16, 16, 16, 17, 17, 18, 18, 18, 19, 19, 19, 20, 20, 20, 20, 21, 21, 21, 21, 22, 22, 22, 22, 22, 23, 23, 23, 23, 23, 23, 24, 24, 24, 24, 24, 24, 25, 25, 25, 25, 25, 25, 25, 26, 26, 26, 26, 26, 26, 26, 26, 27, 27, 27, 27, 27, 27, 27, 27, 27, 27, 28, 28, 28, 28, 28, 28, 28, 28, 28, 28, 29, 29, 29, 29, 29, 29, 29, 29, 29, 29, 29, 29, 30, 30, 30, 30, 30, 30, 30, 30, 30, 30, 30, 30, 30, 30, 31, 31, 31, 31, 31, 31, 31, 31, 31, 31, 31, 31, 31, 31, 31};
constexpr int KI_PITCH = 144;
constexpr int IDX_WOFF = 40960, IDX_WREG = 9216;
constexpr unsigned NEG_KEY = 0x007FFFFFu;
__device__ __forceinline__ int mbcnt64(unsigned long long m) { return __builtin_amdgcn_mbcnt_hi((unsigned)(m >> 32), __builtin_amdgcn_mbcnt_lo((unsigned)m, 0u)); }

#define IDX_LOAD_TILE(t_) do { _Pragma("unroll") for (int i_ = 0; i_ < 4; ++i_) { const int id_ = F.tid + 512 * i_; \
    stg[i_] = *(const GAS v4u*)(kiwi + (size_t)((t_) * 256 + (id_ >> 3)) * 256 + (id_ & 7) * 8); } } while (0)

__device__ __forceinline__ void idx_unit(Frame& F, int unit) {
    const int q0 = unit * 16;
    const int kend = ((q0 + 15) / 32 + 1) * 32;
    const int nkt = (kend + 255) >> 8;
    const bf16* qi = (const bf16*)(F.ws + WS_QI); const bf16* kiwi = (const bf16*)(F.ws + WS_KIWI);
    const int* pos = (const int*)F.in(2);
    float* scr = (F.bid < 128) ? F.out + (size_t)F.bid * (16 * 8192) : (float*)(F.ws + WS_SC) + (size_t)(F.bid - 128) * (16 * 8192);
    const int r = F.lane & 31, hh = F.lane >> 5;
    const int wq = q0 + 2 * F.wave;
    {
        const int aq = wq + ((r >> 2) & 1), ah = (r & 3) + 4 * (r >> 3);
        bf16x8 Af[4];
#pragma unroll
        for (int s = 0; s < 4; ++s) Af[s] = *(const GAS bf16x8*)(qi + (size_t)aq * 1024 + ah * 64 + s * 16 + 8 * hh);
        float wgt[16];
        { const v4u a = *(const GAS v4u*)(kiwi + (size_t)(wq + hh) * 256 + 64), b = *(const GAS v4u*)(kiwi + (size_t)(wq + hh) * 256 + 72);
          float t0[8], t1[8]; unpack8(a, t0); unpack8(b, t1);
#pragma unroll
          for (int e = 0; e < 8; ++e) { wgt[e] = t0[e]; wgt[8 + e] = t1[e]; } }
        const int qpos = pos[wq + hh];
        float* srow = scr + (size_t)(2 * F.wave + hh) * 8192;
        v4u stg[4];
        IDX_LOAD_TILE(0);
        for (int t = 0; t < nkt; ++t) {
            __syncthreads();
#pragma unroll
            for (int i = 0; i < 4; ++i) { const int id = F.tid + 512 * i; *(LAS v4u*)(F.lds + (id >> 3) * KI_PITCH + (id & 7) * 16) = stg[i]; }
            __syncthreads();
            if (t + 1 < nkt) IDX_LOAD_TILE(t + 1);
            for (int sub = 0; sub < 8; ++sub) {
                const int key0 = t * 256 + sub * 32;
                if (key0 >= kend) break;
                f32x16 acc;
#pragma unroll
                for (int e = 0; e < 16; ++e) acc[e] = 0.f;
#pragma unroll
                for (int s = 0; s < 4; ++s) { const bf16x8 B = *(const LAS bf16x8*)(F.lds + (sub * 32 + r) * KI_PITCH + s * 32 + hh * 16); acc = mfma32(Af[s], B, acc); }
                float sc = 0.f;
#pragma unroll
                for (int e = 0; e < 16; ++e) sc += wgt[e] * fmaxf(acc[e], 0.f);
                const int key = key0 + r; const int kp = pos[key];
                srow[key] = (kp <= qpos) ? sc : -__builtin_inff();
            }
        }
    }
    __threadfence(); __syncthreads();
    LAS int* sel = (LAS int*)(F.lds + IDX_WOFF + F.wave * IDX_WREG);
    LAS float* P = (LAS float*)(F.lds + IDX_WOFF + F.wave * IDX_WREG + 1024);
    const float* relb = F.in(5);
    const bf16* kvb = (const bf16*)(F.ws + WS_KV);
#pragma unroll 1
    for (int qq = 0; qq < 2; ++qq) {
        const int qrow = wq + qq;
        int cnt;
        {
            const float* sr = scr + (size_t)(2 * F.wave + qq) * 8192;
            unsigned key[128];
            int ln1 = F.lane; asm volatile("" : "+v"(ln1));
#pragma unroll
            for (int jb = 0; jb < 8; ++jb) {
#pragma unroll
                for (int jj = 0; jj < 16; ++jj) { const int j = jb * 16 + jj; key[j] = 0u; if (j * 64 < kend) { const int idx = j * 64 + ln1; if (idx < kend) key[j] = sortable(sr[idx]); } }
                __builtin_amdgcn_sched_barrier(0); }
            unsigned thr = 0u;
            for (int bit = 31; bit >= 0; --bit) { const unsigned cand = thr | (1u << bit); int c = 0;
#pragma unroll
                for (int jb = 0; jb < 16; ++jb) { if (jb * 512 < kend) {
#pragma unroll
                        for (int jj = 0; jj < 8; ++jj) c += __builtin_popcountll(__ballot(key[jb * 8 + jj] >= cand)); }
                    __builtin_amdgcn_sched_barrier(0); }
                if (c >= TOPK) thr = cand; }
            int ngt = 0;
#pragma unroll
            for (int jb = 0; jb < 16; ++jb) { if (jb * 512 < kend) {
#pragma unroll
                    for (int jj = 0; jj < 8; ++jj) ngt += __builtin_popcountll(__ballot(key[jb * 8 + jj] > thr && key[jb * 8 + jj] > NEG_KEY)); }
                __builtin_amdgcn_sched_barrier(0); }
            const int need = TOPK - ngt;
            int base = 0, tie_seen = 0;
            int ln2 = F.lane; asm volatile("" : "+v"(ln2));
#pragma unroll
            for (int j = 0; j < 128; ++j) { if (j * 64 < kend) {
                const bool valid = key[j] > NEG_KEY, gt = valid && key[j] > thr, eq = valid && key[j] == thr;
                const unsigned long long meq = __ballot(eq);
                const bool take = gt || (eq && (tie_seen + mbcnt64(meq)) < need);
                tie_seen += __builtin_popcountll(meq);
                const unsigned long long m = __ballot(take);
                if (take) sel[base + mbcnt64(m)] = j * 64 + ln2;
                base += __builtin_popcountll(m); }
                __builtin_amdgcn_sched_barrier(0); }
            cnt = base;
        }
        LDS_WAIT(); asm volatile("" ::: "memory");
        {
            const int head = F.lane >> 3, sub = F.lane & 7;
            unsigned qp[8];
            { const v4u a = *(const GAS v4u*)((const bf16*)(F.ws + WS_Q) + (size_t)qrow * 1024 + F.lane * 16), b = *(const GAS v4u*)((const bf16*)(F.ws + WS_Q) + (size_t)qrow * 1024 + F.lane * 16 + 8);
              qp[0] = a.x; qp[1] = a.y; qp[2] = a.z; qp[3] = a.w; qp[4] = b.x; qp[5] = b.y; qp[6] = b.z; qp[7] = b.w; }
            const int qps = pos[qrow];
            const int cnt8 = (cnt + 7) & ~7;
            for (int j0 = 0; j0 < cnt8; j0 += 8) {
                float part[8];
#pragma unroll
                for (int e = 0; e < 8; ++e) { const int j = j0 + e; const int idx = __builtin_amdgcn_readfirstlane(sel[j < cnt ? j : cnt - 1]);
                    const GAS v4u* kp = (const GAS v4u*)(kvb + (size_t)idx * 2048 + F.lane * 16);
                    const v4u k0 = kp[0], k1 = kp[1]; float d = 0.f;
                    d = dot2bf(qp[0], k0.x, d);
                    d = dot2bf(qp[1], k0.y, d);
                    d = dot2bf(qp[2], k0.z, d);
                    d = dot2bf(qp[3], k0.w, d);
                    d = dot2bf(qp[4], k1.x, d);
                    d = dot2bf(qp[5], k1.y, d);
                    d = dot2bf(qp[6], k1.z, d);
                    d = dot2bf(qp[7], k1.w, d);
                    part[e] = d; }
                const bool b2 = (sub & 4) != 0, b1 = (sub & 2) != 0, b0 = (sub & 1) != 0;
                float a4[4], a2[2];
#pragma unroll
                for (int e = 0; e < 4; ++e) { const float keep = b2 ? part[e + 4] : part[e], give = b2 ? part[e] : part[e + 4]; a4[e] = keep + __shfl_xor(give, 4); }
#pragma unroll
                for (int e = 0; e < 2; ++e) { const float keep = b1 ? a4[e + 2] : a4[e], give = b1 ? a4[e] : a4[e + 2]; a2[e] = keep + __shfl_xor(give, 2); }
                const float keep = b0 ? a2[1] : a2[0], give = b0 ? a2[0] : a2[1];
                float logit = (keep + __shfl_xor(give, 1)) * DBG_LOGIT_S;
                const int j = j0 + sub; const int idx = sel[j < cnt ? j : cnt - 1];
                const int dist = qps - pos[idx];
                const int bk = dist < 0 ? 0 : (dist < 128 ? (int)REL_BUCKET[dist] : 31);
#if !DBG_NO_BIAS
                logit += relb[bk * 8 + head];
#endif
                if (j >= cnt || dist < 0) logit = -__builtin_inff();
                P[head * 256 + j] = logit;
            }
            LDS_WAIT(); asm volatile("" ::: "memory");
            float mx = -__builtin_inff();
            for (int j = sub; j < cnt8; j += 8) mx = fmaxf(mx, P[head * 256 + j]);
            mx = fmaxf(mx, __shfl_xor(mx, 1)); mx = fmaxf(mx, __shfl_xor(mx, 2)); mx = fmaxf(mx, __shfl_xor(mx, 4));
            float sum = 0.f;
            for (int j = sub; j < cnt8; j += 8) { const float pv = __expf(P[head * 256 + j] - mx); P[head * 256 + j] = pv; sum += pv; }
            sum += __shfl_xor(sum, 1); sum += __shfl_xor(sum, 2); sum += __shfl_xor(sum, 4);
            const float inv = ((qrow >= 4096) ? DBG_ATTN_HI_S : 1.0f) / sum;
            LDS_WAIT(); asm volatile("" ::: "memory");
            float o[16];
#pragma unroll
            for (int e = 0; e < 16; ++e) o[e] = 0.f;
            for (int j0 = 0; j0 < cnt8; j0 += 4) {
#pragma unroll
                for (int e = 0; e < 4; ++e) { const int j = j0 + e; const int idx = __builtin_amdgcn_readfirstlane(sel[j < cnt ? j : cnt - 1]);
                    const GAS v4u* vp = (const GAS v4u*)(kvb + (size_t)idx * 2048 + 1024 + F.lane * 16);
                    const v4u v0 = vp[0], v1 = vp[1]; const float pj = P[head * 256 + j];
                    o[0] += pj * bflo(v0.x); o[1] += pj * bfhi(v0.x); o[2] += pj * bflo(v0.y); o[3] += pj * bfhi(v0.y);
                    o[4] += pj * bflo(v0.z); o[5] += pj * bfhi(v0.z); o[6] += pj * bflo(v0.w); o[7] += pj * bfhi(v0.w);
                    o[8] += pj * bflo(v1.x); o[9] += pj * bfhi(v1.x); o[10] += pj * bflo(v1.y); o[11] += pj * bfhi(v1.y);
                    o[12] += pj * bflo(v1.z); o[13] += pj * bfhi(v1.z); o[14] += pj * bflo(v1.w); o[15] += pj * bfhi(v1.w); }
            }
            v4u w0, w1;
            w0.x = pk2(o[0] * inv, o[1] * inv); w0.y = pk2(o[2] * inv, o[3] * inv); w0.z = pk2(o[4] * inv, o[5] * inv); w0.w = pk2(o[6] * inv, o[7] * inv);
            w1.x = pk2(o[8] * inv, o[9] * inv); w1.y = pk2(o[10] * inv, o[11] * inv); w1.z = pk2(o[12] * inv, o[13] * inv); w1.w = pk2(o[14] * inv, o[15] * inv);
            GAS v4u* op = (GAS v4u*)((bf16*)(F.ws + WS_ATT) + (size_t)qrow * 1024 + F.lane * 16);
#if DBG_NO_ATTN
            w0 = (v4u){0u,0u,0u,0u}; w1 = w0;
#endif
            op[0] = w0; op[1] = w1;
            LDS_WAIT(); asm volatile("" ::: "memory");
        }
    }
}

__device__ __forceinline__ float unsortable(unsigned k) { return __builtin_bit_cast(float, (k & 0x80000000u) ? (k & 0x7fffffffu) : ~k); }
#define DOT2(a, b, c) dot2bf((a), (b), (c))

__device__ __forceinline__ void peer_unit(Frame& F, int unit) {
    const int tok0 = unit * 32;
    const bf16* pq = (const bf16*)(F.ws + WS_PQ); const bf16* subk = (const bf16*)(F.ws + WS_SUBK);
    LAS float* topS = (LAS float*)F.lds; LAS int* topI = (LAS int*)(F.lds + 32768);
    LAS int* esel = (LAS int*)(F.lds + 65536); LAS float* ew = (LAS float*)(F.lds + 81920);
    const int r = F.lane & 31, hh = F.lane >> 5;
#ifndef NO_A
    {
        const int h = F.wave;
        for (int p = 0; p < 2; ++p) {
            const int hp = h * 2 + p;
            bf16x8 Bq[8];
#pragma unroll
            for (int ks = 0; ks < 8; ++ks) Bq[ks] = *(const GAS bf16x8*)(pq + (size_t)(tok0 + r) * 2048 + hp * 128 + ks * 16 + 8 * hh);
            unsigned key[64];
#pragma unroll
            for (int kt = 0; kt < 4; ++kt) { f32x16 acc;
#pragma unroll
                for (int e = 0; e < 16; ++e) acc[e] = 0.f;
#pragma unroll
                for (int ks = 0; ks < 8; ++ks) { const bf16x8 A = *(const GAS bf16x8*)(subk + ((size_t)hp * 128 + kt * 32 + r) * 128 + ks * 16 + 8 * hh); acc = mfma32(A, Bq[ks], acc); }
#pragma unroll
                for (int e = 0; e < 16; ++e) key[kt * 16 + e] = sortable(acc[e]);
                __builtin_amdgcn_sched_barrier(0); }
            unsigned thr = 0u;
            for (int bit = 31; bit >= 0; --bit) { const unsigned cand = thr | (1u << bit); int c = 0;
#pragma unroll
                for (int i = 0; i < 64; ++i) c += (key[i] >= cand) ? 1 : 0;
                c += __shfl_xor(c, 32);
                if (c >= PE_TOPK) thr = cand; }
            int ngt = 0, neq = 0;
#pragma unroll
            for (int i = 0; i < 64; ++i) { ngt += (key[i] > thr) ? 1 : 0; neq += (key[i] == thr) ? 1 : 0; }
            const int pgt = __shfl_xor(ngt, 32), peq = __shfl_xor(neq, 32);
            int pg = hh ? pgt : 0, pe = ngt + pgt + (hh ? peq : 0);
            LAS float* ls = topS + ((r * 8 + h) * 2 + p) * 16; LAS int* li = topI + ((r * 8 + h) * 2 + p) * 16;
#pragma unroll
            for (int kt = 0; kt < 4; ++kt)
#pragma unroll
                for (int e = 0; e < 16; ++e) { const unsigned k = key[kt * 16 + e]; const int kidx = kt * 32 + (e & 3) + 8 * (e >> 2) + 4 * hh;
                    if (k > thr) { ls[pg] = unsortable(k); li[pg] = kidx; ++pg; }
                    else if (k == thr) { if (pe < PE_TOPK) { ls[pe] = unsortable(k); li[pe] = kidx; } ++pe; } }
        }
    }
#endif
    __syncthreads();
#ifndef NO_B
    if (F.wave < 4) {
        const int L = F.wave * 64 + F.lane, tk = L >> 3, hd = L & 7;
        const LAS float* S0 = topS + ((tk * 8 + hd) * 2 + 0) * 16; const LAS int* I0 = topI + ((tk * 8 + hd) * 2 + 0) * 16;
        float s1[16]; int i1[16];
#pragma unroll
        for (int b = 0; b < 16; ++b) { s1[b] = topS[((tk * 8 + hd) * 2 + 1) * 16 + b]; i1[b] = topI[((tk * 8 + hd) * 2 + 1) * 16 + b]; }
        const float NINF = -__builtin_inff();
        float prev = __builtin_inff(), thr = NINF, top = 0.f;
        for (int round = 0; round < 16; ++round) {
            float cur = NINF;
#pragma unroll 1
            for (int a = 0; a < 16; ++a) { const float sa = S0[a];
#pragma unroll
                for (int b = 0; b < 16; ++b) { const float v = sa + s1[b]; cur = fmaxf(cur, v < prev ? v : NINF); } }
            if (round == 0) top = cur;
            thr = cur; prev = cur;
        }
        int n = 0; float den = 0.f; const int ob = tk * 128 + hd * 16;
#pragma unroll 1
        for (int a = 0; a < 16; ++a) { const float sa = S0[a]; const int ia = I0[a] * PE_NK;
#pragma unroll
            for (int b = 0; b < 16; ++b) { const float v = sa + s1[b];
                if (v > thr && n < PE_TOPK) { const float w = __expf(v - top); esel[ob + n] = ia + i1[b]; ew[ob + n] = w; den += w; ++n; } } }
#pragma unroll 1
        for (int a = 0; a < 16; ++a) { const float sa = S0[a]; const int ia = I0[a] * PE_NK;
#pragma unroll
            for (int b = 0; b < 16; ++b) { const float v = sa + s1[b];
                if (v == thr && n < PE_TOPK) { const float w = __expf(v - top); esel[ob + n] = ia + i1[b]; ew[ob + n] = w; den += w; ++n; } } }
        const float inv = 1.f / den;
        for (int k = 0; k < PE_TOPK; ++k) ew[ob + k] *= inv;
    }
#endif
    __syncthreads();
#ifndef NO_C
    {
        const bf16* h1b = (const bf16*)(F.ws + WS_H1B); const float* h1f = (const float*)(F.ws + WS_H1F);
        const bf16* PU = (const bf16*)(F.ws + WS_PU); const bf16* PV = (const bf16*)(F.ws + WS_PV);
        float* rf = (float*)(F.ws + WS_RF); bf16* rb = (bf16*)(F.ws + WS_RB);
        for (int tt = 0; tt < 4; ++tt) {
            const int tl = F.wave * 4 + tt, tok = tok0 + tl;
            v4u xp[4];
#pragma unroll
            for (int i = 0; i < 4; ++i) xp[i] = *(const GAS v4u*)(h1b + (size_t)tok * DM + i * 512 + F.lane * 8);
            float o[32];
#pragma unroll
            for (int e = 0; e < 32; ++e) o[e] = 0.f;
            for (int e0 = 0; e0 < 128; e0 += 2) {
                const int id0 = __builtin_amdgcn_readfirstlane(esel[tl * 128 + e0]), id1 = __builtin_amdgcn_readfirstlane(esel[tl * 128 + e0 + 1]);
                const float g0 = ew[tl * 128 + e0], g1 = ew[tl * 128 + e0 + 1];
                v4u u0[4], u1[4], w0[4], w1[4];
#pragma unroll
                for (int i = 0; i < 4; ++i) { u0[i] = *(const GAS v4u*)(PU + (size_t)id0 * DM + i * 512 + F.lane * 8); u1[i] = *(const GAS v4u*)(PU + (size_t)id1 * DM + i * 512 + F.lane * 8); }
#pragma unroll
                for (int i = 0; i < 4; ++i) { w0[i] = *(const GAS v4u*)(PV + (size_t)id0 * DM + i * 512 + F.lane * 8); w1[i] = *(const GAS v4u*)(PV + (size_t)id1 * DM + i * 512 + F.lane * 8); }
                float d0 = 0.f, d1 = 0.f;
#pragma unroll
                for (int i = 0; i < 4; ++i) {
                    d0 = DOT2(xp[i].x, u0[i].x, d0); d0 = DOT2(xp[i].y, u0[i].y, d0); d0 = DOT2(xp[i].z, u0[i].z, d0); d0 = DOT2(xp[i].w, u0[i].w, d0);
                    d1 = DOT2(xp[i].x, u1[i].x, d1); d1 = DOT2(xp[i].y, u1[i].y, d1); d1 = DOT2(xp[i].z, u1[i].z, d1); d1 = DOT2(xp[i].w, u1[i].w, d1); }
                d0 = wave_sum(d0); d1 = wave_sum(d1);
                const float a0 = g0 * gelu_tanh(d0), a1 = g1 * gelu_tanh(d1);
#pragma unroll
                for (int i = 0; i < 4; ++i) {
                    o[8 * i + 0] += a0 * bflo(w0[i].x) + a1 * bflo(w1[i].x); o[8 * i + 1] += a0 * bfhi(w0[i].x) + a1 * bfhi(w1[i].x);
                    o[8 * i + 2] += a0 * bflo(w0[i].y) + a1 * bflo(w1[i].y); o[8 * i + 3] += a0 * bfhi(w0[i].y) + a1 * bfhi(w1[i].y);
                    o[8 * i + 4] += a0 * bflo(w0[i].z) + a1 * bflo(w1[i].z); o[8 * i + 5] += a0 * bfhi(w0[i].z) + a1 * bfhi(w1[i].z);
                    o[8 * i + 6] += a0 * bflo(w0[i].w) + a1 * bflo(w1[i].w); o[8 * i + 7] += a0 * bfhi(w0[i].w) + a1 * bfhi(w1[i].w); }
            }
#pragma unroll
            for (int i = 0; i < 4; ++i) { const size_t off = (size_t)tok * DM + i * 512 + F.lane * 8;
                const f32x4 ha = *(const GAS f32x4*)(h1f + off), hb = *(const GAS f32x4*)(h1f + off + 4);
#if DBG_PEER_X2
#pragma unroll
                for (int e = 0; e < 8; ++e) o[8 * i + e] *= 2.f;
#endif
#if DBG_NO_PEER
#pragma unroll
                for (int e = 0; e < 8; ++e) o[8 * i + e] = 0.f;
#endif
                f32x4 ra, rbv;
                ra.x = ALPHA * ha.x + o[8 * i + 0]; ra.y = ALPHA * ha.y + o[8 * i + 1]; ra.z = ALPHA * ha.z + o[8 * i + 2]; ra.w = ALPHA * ha.w + o[8 * i + 3];
                rbv.x = ALPHA * hb.x + o[8 * i + 4]; rbv.y = ALPHA * hb.y + o[8 * i + 5]; rbv.z = ALPHA * hb.z + o[8 * i + 6]; rbv.w = ALPHA * hb.w + o[8 * i + 7];
                *(GAS f32x4*)(rf + off) = ra; *(GAS f32x4*)(rf + off + 4) = rbv;
                v4u w; w.x = pk2(ra.x, ra.y); w.y = pk2(ra.z, ra.w); w.z = pk2(rbv.x, rbv.y); w.w = pk2(rbv.z, rbv.w);
                *(GAS v4u*)(rb + off) = w; }
        }
    }
#endif
    __syncthreads();
}

struct Args { const float* in[24]; float* out; unsigned char* ws; int ph_lo, ph_hi; };
constexpr int N_PHASES = 10;

__global__ void __launch_bounds__(NTHREADS, 2) mega_fwd(Args args) {
    extern __shared__ __attribute__((aligned(16))) unsigned char lds_raw[];
    const int lo = args.ph_lo, hi = args.ph_hi;
#if MK_COOP
    cg::grid_group grid = cg::this_grid();
#define GRID_BAR() grid.sync()
#else
#define GRID_BAR() do {} while (0)
#endif
#define IN(k) (lo <= (k) && (k) < hi)
#define BOTH(k) (IN(k) && IN((k) + 1))

    if (IN(0)) { MAKE_FRAME(F); p0_prologue(F); if (BOTH(0)) GRID_BAR(); }

    if (IN(1)) {
        MAKE_FRAME(F); unsigned char* ws = F.ws; LAS unsigned char* glds = F.lds;
        pg8::Gemm g{(const bf16*)(ws + WS_HB), (const bf16*)(ws + WS_WIN), SEQ, INW_PAD, DM}; asm volatile("" : "+s"(g.K), "+s"(g.N), "+s"(g.M)); pg8::StaticOrder S; S.init(SEQ, INW_PAD, F.G, F.bid);
        pg8::EpiWin E{(bf16*)(ws + WS_Q), (bf16*)(ws + WS_KV), (bf16*)(ws + WS_QI), (bf16*)(ws + WS_GU), (bf16*)(ws + WS_GV), (bf16*)(ws + WS_GA), (bf16*)(ws + WS_GG), (bf16*)(ws + WS_KIWI)};
        pg8::gemm_phase<pg8::EpiWin, pg8::StaticOrder, true, true>(glds, g, S, E);
        if (BOTH(1)) GRID_BAR();
    }

    if (IN(2)) {
        MAKE_FRAME(F); unsigned char* ws = F.ws; LAS unsigned char* glds = F.lds;
        for (int u = F.bid; u < 512; u += F.G) gmlp_unit(F, u);
#pragma unroll 1
        for (int k = F.bid, i = 0; k < 512; k += F.G, ++i) idx_unit(F, (F.G == 256 && i == 1) ? 511 - F.bid : k);
        if (BOTH(2)) GRID_BAR();
    }

    if (IN(3)) {
        MAKE_FRAME(F); unsigned char* ws = F.ws; LAS unsigned char* glds = F.lds;
        { pg8::Gemm g{(const bf16*)(ws + WS_ATT), (const bf16*)(ws + WS_WA), SEQ, DM, AW}; asm volatile("" : "+s"(g.K), "+s"(g.N), "+s"(g.M)); pg8::StaticOrder S; S.init(SEQ, DM, F.G, F.bid);
          pg8::EpiGateF32 E{(const bf16*)(ws + WS_GA), (float*)(ws + WS_T), DM};
          pg8::gemm_phase<pg8::EpiGateF32, pg8::StaticOrder, true, true>(glds, g, S, E); }
        __syncthreads();
        { pg8::Gemm g{(const bf16*)(ws + WS_GM), (const bf16*)(ws + WS_WG), SEQ, DM, GW}; asm volatile("" : "+s"(g.K), "+s"(g.N), "+s"(g.M)); pg8::StaticOrder S; S.init(SEQ, DM, F.G, F.bid);
          pg8::EpiMerge E{(const bf16*)(ws + WS_GG), (const float*)(ws + WS_T), (bf16*)(ws + WS_MERGED), DM};
          pg8::gemm_phase<pg8::EpiMerge, pg8::StaticOrder, true, true>(glds, g, S, E); }
        if (BOTH(3)) GRID_BAR();
    }

    if (IN(4)) {
        MAKE_FRAME(F); unsigned char* ws = F.ws; LAS unsigned char* glds = F.lds;
        pg8::Gemm g{(const bf16*)(ws + WS_MERGED), (const bf16*)(ws + WS_WMIX), SEQ, DM, DM}; asm volatile("" : "+s"(g.K), "+s"(g.N), "+s"(g.M)); pg8::StaticOrder S; S.init(SEQ, DM, F.G, F.bid);
        pg8::EpiMix E{F.in(0), (const float*)(ws + WS_STATS), F.in(3), F.in(4), F.out, DM};
        pg8::gemm_phase<pg8::EpiMix, pg8::StaticOrder, true, true>(glds, g, S, E);
        if (BOTH(4)) GRID_BAR();
    }

    if (IN(5)) {
        MAKE_FRAME(F); unsigned char* ws = F.ws; LAS unsigned char* glds = F.lds;
        const int gw = F.bid * NWAVES + F.wave, NGW = F.G * NWAVES;
        for (int m = gw; m < SEQ; m += NGW) ln_row(F, F.out + (size_t)m * DM, F.in(14), F.in(15), (bf16*)(ws + WS_H1B) + (size_t)m * DM, (float*)(ws + WS_H1F) + (size_t)m * DM, nullptr);
        if (BOTH(5)) GRID_BAR();
    }

    if (IN(6)) {
        MAKE_FRAME(F); unsigned char* ws = F.ws; LAS unsigned char* glds = F.lds;
        pg8::Gemm g{(const bf16*)(ws + WS_H1B), (const bf16*)(ws + WS_WQ), SEQ, DM, DM}; asm volatile("" : "+s"(g.K), "+s"(g.N), "+s"(g.M)); pg8::StaticOrder S; S.init(SEQ, DM, F.G, F.bid);
        pg8::EpiBf16<0> E{(bf16*)(ws + WS_PQ), DM, nullptr, 0, 0, 1.f};
        pg8::gemm_phase<pg8::EpiBf16<0>, pg8::StaticOrder, true, true>(glds, g, S, E);
        if (BOTH(6)) GRID_BAR();
    }

    if (IN(7)) {
        MAKE_FRAME(F); unsigned char* ws = F.ws; LAS unsigned char* glds = F.lds;
        for (int u = F.bid; u < SEQ / 32; u += F.G) peer_unit(F, u);
        if (BOTH(7)) GRID_BAR();
    }

    if (IN(8)) {
        MAKE_FRAME(F); unsigned char* ws = F.ws; LAS unsigned char* glds = F.lds;
        { pg8::Gemm g{(const bf16*)(ws + WS_PB), (const bf16*)(ws + WS_WPP), SEQ, DM, PLE}; asm volatile("" : "+s"(g.K), "+s"(g.N), "+s"(g.M)); pg8::StaticOrder S; S.init(SEQ, DM, F.G, F.bid);
          pg8::EpiF32 E{(float*)(ws + WS_T2), DM};
          pg8::gemm_phase<pg8::EpiF32, pg8::StaticOrder, true, true>(glds, g, S, E); }
        __syncthreads();
        { pg8::Gemm g{(const bf16*)(ws + WS_RB), (const bf16*)(ws + WS_WPG), SEQ, DM, DM}; asm volatile("" : "+s"(g.K), "+s"(g.N), "+s"(g.M)); pg8::StaticOrder S; S.init(SEQ, DM, F.G, F.bid);
          pg8::EpiPle E{(const float*)(ws + WS_RF), (const float*)(ws + WS_T2), F.out, DM};
          pg8::gemm_phase<pg8::EpiPle, pg8::StaticOrder, true, true>(glds, g, S, E); }
        if (BOTH(8)) GRID_BAR();
    }

    if (IN(9)) {
        MAKE_FRAME(F); unsigned char* ws = F.ws; LAS unsigned char* glds = F.lds;
        const int gw = F.bid * NWAVES + F.wave, NGW = F.G * NWAVES;
        for (int m = gw; m < SEQ; m += NGW) ln_row(F, F.out + (size_t)m * DM, F.in(22), F.in(23), nullptr, F.out + (size_t)m * DM, nullptr);
    }
}

extern "C" void kernel_launch(void* const* d_in, const int* in_sizes, int n_in, void* d_out, int out_size, void* d_ws, size_t ws_size, hipStream_t stream) {
    static int grid = 0;
    if (grid == 0) {
        if (n_in != 24 || out_size != SEQ * DM || ws_size < WS_END) { fprintf(stderr, "kernel_launch: unexpected problem: n_in %d out %d ws %zu (need %zu)\n", n_in, out_size, ws_size, (size_t)WS_END); grid = -1; return; }
        int dev = 0, cus = 0, per_cu = 0;
        if (hipGetDevice(&dev) != hipSuccess || hipDeviceGetAttribute(&cus, hipDeviceAttributeMultiprocessorCount, dev) != hipSuccess) { grid = -1; return; }
        if (hipFuncSetAttribute((const void*)mega_fwd, hipFuncAttributeMaxDynamicSharedMemorySize, LDS_BYTES) != hipSuccess) { fprintf(stderr, "kernel_launch: hipFuncSetAttribute failed\n"); grid = -1; return; }
        if (hipOccupancyMaxActiveBlocksPerMultiprocessor(&per_cu, (const void*)mega_fwd, NTHREADS, LDS_BYTES) != hipSuccess || per_cu < 1) { fprintf(stderr, "kernel_launch: occupancy query says %d blocks per CU\n", per_cu); (void)hipGetLastError(); grid = -1; return; }
        grid = cus;
        fprintf(stderr, "kernel_launch: grid %d (per_cu %d), ws %zu\n", grid, per_cu, ws_size);
    }
    if (grid < 0) return;
    Args a{};
    for (int i = 0; i < 24; ++i) a.in[i] = (const float*)d_in[i];
    a.out = (float*)d_out; a.ws = (unsigned char*)d_ws;
#if MK_COOP
    a.ph_lo = 0; a.ph_hi = N_PHASES;
    void* kargs[] = {&a};
    hipError_t e = hipLaunchCooperativeKernel((const void*)mega_fwd, dim3(grid), dim3(NTHREADS), kargs, LDS_BYTES, stream);
    if (e != hipSuccess) fprintf(stderr, "kernel_launch: cooperative launch failed: %s\n", hipGetErrorString(e));
#else
    for (int ph = 0; ph < N_PHASES; ++ph) { a.ph_lo = ph; a.ph_hi = ph + 1; hipLaunchKernelGGL(mega_fwd, dim3(grid), dim3(NTHREADS), LDS_BYTES, stream, a); }
#endif
}
```

```cpp
#include <hip/hip_runtime.h>
#include <hip/hip_cooperative_groups.h>
#include <cstdio>
#include <cstdint>
namespace cg = cooperative_groups;
#ifndef MK_COOP
#define MK_COOP 1
#endif
#define DBG_NO_ATTN 0
#define DBG_ATTN_X2 0
#define DBG_PEER_X2 0
#define DBG_NO_PEER 0
#define DBG_NO_GMLP 0
#define DBG_GMLP_X2 0
#define DBG_PLE_S 1.0f
#define DBG_MIX_S 1.0f
#define DBG_ATTN_HI_S 1.0f
#define DBG_LOGIT_S 1.0f
#define DBG_NO_BIAS 0
#define DBG_REP_PHASE -1
#define DBG_REP_SUB 0
#define DBG_ALL_CG 0
namespace pg8 {
#define PG8_LAS __attribute__((address_space(3)))
typedef unsigned short bf16_t;
typedef short bf16x8 __attribute__((ext_vector_type(8)));
typedef float f32x4 __attribute__((ext_vector_type(4)));
typedef unsigned u32x4 __attribute__((ext_vector_type(4)));
constexpr int BM = 256, BK = 64, HALF = 128, HTB = HALF * BK * 2  , STAGE_BYTES = 8 * HTB, NXCD = 8, WGM = 8;

__host__ __device__ __forceinline__ int lds_byte(int r, int c) { const int st = (r >> 4) * 2 + (c >> 5), rr = r & 15, cc = c & 31, ob = rr * 64 + cc * 2; return st * 1024 + (ob ^ (((ob >> 9) & 1) << 5)); }
__host__ __device__ __forceinline__ void stage_rc(int b, int& R, int& C) { const int st = b / 1024, sb = b % 1024, swz = sb ^ (((sb >> 9) & 1) << 5); R = (st >> 1) * 16 + swz / 64; C = (st & 1) * 32 + (swz % 64) / 2; }
__host__ __device__ __forceinline__ int perm32(int rho) { const int n = rho >> 4, i = rho & 15; return 8 * (i >> 2) + 4 * n + (i & 3); }

struct Unit { int pm, pn; };
struct Gemm { const bf16_t* A; const bf16_t* Bt; int M, N, K; };

struct StaticOrder {
    int nM, nN, nwg, G, c;
    __host__ __device__ void init(int M, int N, int G_, int c_) { nM = M / BM; nN = N / BM; nwg = nM * nN; G = G_; c = c_; }
    __host__ __device__ bool next(int i, Unit& u) const {
        const long L = (long)i * G + c; if (L >= nwg) return false;
        int wgid = (int)L; { const int q = nwg / NXCD, r = nwg % NXCD, xcd = wgid % NXCD, off = wgid / NXCD; wgid = (xcd < r ? xcd * (q + 1) : r * (q + 1) + (xcd - r) * q) + off; }
        const int nig = WGM * nN, gid = wgid / nig, fm = gid * WGM, gsz = (nM - fm) < WGM ? (nM - fm) : WGM;
        u.pm = fm + ((wgid % nig) % gsz); u.pn = (wgid % nig) / gsz; return true;
    }
    __device__ __forceinline__ void a_ready(const Unit&) const {}
    __device__ __forceinline__ void done(const Unit&) const {}
};

__device__ __forceinline__ unsigned cvt_pk_bf16(float lo, float hi) { unsigned r; asm volatile("v_cvt_pk_bf16_f32 %0, %1, %2" : "=v"(r) : "v"(lo), "v"(hi)); return r; }
typedef float f32x2 __attribute__((ext_vector_type(2)));
__device__ __forceinline__ f32x2 gelu_pk(f32x2 v) {
    const f32x2 av = __builtin_elementwise_abs(v), d = av * 0.2316418882f + 1.0f;
    f32x2 t; t.x = __builtin_amdgcn_rcpf(d.x); t.y = __builtin_amdgcn_rcpf(d.y);
    f32x2 q = t * 0.5307027145f + (-0.7265760135f); q = q * t + 0.7107068705f; q = q * t + (-0.142248368f); q = q * t + 0.127414796f; q = q * t;
    const f32x2 s = (v * v) * (-0.72134752044f);
    f32x2 e; e.x = __builtin_amdgcn_exp2f(s.x); e.y = __builtin_amdgcn_exp2f(s.y);
    const f32x2 m = v * (q * e), r = v - m;
    f32x2 o; o.x = v.x < 0.f ? m.x : r.x; o.y = v.y < 0.f ? m.y : r.y; return o;
}

template <int ACT  > struct EpiBf16 {
    static constexpr bool PERM = true, AFTER_DRAIN = false; static_assert(ACT == 0 || ACT == 1, "EpiBf16: ACT is 0 (none) or 1 (gelu_pk)");
    bf16_t* O; int ldc; const float* bias; int split_cols; size_t split_stride; float scale0;
    __device__ __forceinline__ void operator()(const f32x4 (&acc)[2][2][4][2], const Unit& u, int wr, int wc, int fr, int fq) const {
        const int row0 = u.pm * BM + wr * 64 + fr; int colt = u.pn * BM; bf16_t* base = O;
        float sc = 1.f; if (split_cols) { const int t = colt / split_cols; base += (size_t)t * split_stride; colt -= t * split_cols; if (t == 0) sc = scale0; }
        const int col0 = colt + wc * 32 + 8 * fq, bcol0 = u.pn * BM + wc * 32 + 8 * fq;
        f32x4 bv[2][2];
#pragma unroll
        for (int bj = 0; bj < 2; ++bj)
#pragma unroll
            for (int n = 0; n < 2; ++n) bv[bj][n] = bias ? *(const f32x4*)(bias + bcol0 + bj * HALF + 4 * n) : (f32x4){0.f, 0.f, 0.f, 0.f};
#pragma unroll
        for (int ai = 0; ai < 2; ++ai)
#pragma unroll
            for (int m = 0; m < 4; ++m) { bf16_t* rowp = base + (size_t)(row0 + ai * HALF + m * 16) * ldc + col0;
#pragma unroll
                for (int bj = 0; bj < 2; ++bj) { f32x4 v0 = acc[ai][bj][m][0] + bv[bj][0], v1 = acc[ai][bj][m][1] + bv[bj][1];
                    if (ACT == 1) { f32x2 a = gelu_pk((f32x2){v0[0], v0[1]}), b = gelu_pk((f32x2){v0[2], v0[3]}), c = gelu_pk((f32x2){v1[0], v1[1]}), d = gelu_pk((f32x2){v1[2], v1[3]});
                        v0 = (f32x4){a.x, a.y, b.x, b.y}; v1 = (f32x4){c.x, c.y, d.x, d.y}; }
                    v0 = v0 * sc; v1 = v1 * sc; u32x4 w; w.x = cvt_pk_bf16(v0[0], v0[1]); w.y = cvt_pk_bf16(v0[2], v0[3]); w.z = cvt_pk_bf16(v1[0], v1[1]); w.w = cvt_pk_bf16(v1[2], v1[3]);
                    *(u32x4*)(rowp + bj * HALF) = w; } }
    }
};
template <class Epi, class Sched, bool ALIGN_EPI = false, bool SP2 = false>
__device__ __forceinline__ void gemm_phase(PG8_LAS unsigned char* lds, const Gemm g, const Sched& S, const Epi& E) {
    const int tid = threadIdx.x, wid = __builtin_amdgcn_readfirstlane(tid >> 6), lane = tid & 63, wr = wid >> 2, wc = wid & 3, fr = lane & 15, fq = lane >> 4;
    const int K = g.K, nt = K / BK;
    unsigned voffA[2], voffB[2];
#pragma unroll
    for (int i = 0; i < 2; ++i) { int R, C; stage_rc(tid * 16 + i * 8192, R, C); const int Rb = Epi::PERM ? ((R & ~31) + perm32(R & 31)) : R;
        voffA[i] = (unsigned)(R * K + C) * 2u; voffB[i] = (unsigned)(Rb * K + C) * 2u; }
    const size_t kstep = (size_t)(BK * 2);
    const size_t hstep = (size_t)HALF * K * 2;
    const size_t tstep = 2 * hstep;
    const unsigned ldsw = (unsigned)wid * 1024u;
    const int aoff = lds_byte(wr * 64 + fr, fq * 8), boff = lds_byte(wc * 32 + fr, fq * 8);
#define PG8_SA(b, h) (((b) * 2 + (h)) * HTB)
#define PG8_SB(b, h) ((4 + (b) * 2 + (h)) * HTB)
#define PG8_STAGE(bufoff, gbase, voff) do { _Pragma("unroll") for (int _i = 0; _i < 2; ++_i) \
        __builtin_amdgcn_global_load_lds((const unsigned*)((const char*)(gbase) + (voff)[_i]), (PG8_LAS unsigned*)(lds + (bufoff) + ldsw + _i * 8192), 16, 0, 0); } while (0)
#define PG8_LDA(dst, b, h) do { _Pragma("unroll") for (int m = 0; m < 4; ++m) _Pragma("unroll") for (int k = 0; k < 2; ++k) dst[m][k] = *(const PG8_LAS bf16x8*)(lds + PG8_SA(b, h) + aoff + m * 2048 + k * 1024); } while (0)
#define PG8_LDB(dst, b, h) do { _Pragma("unroll") for (int n = 0; n < 2; ++n) _Pragma("unroll") for (int k = 0; k < 2; ++k) dst[n][k] = *(const PG8_LAS bf16x8*)(lds + PG8_SB(b, h) + boff + n * 2048 + k * 1024); } while (0)
#define PG8_MMA(ai, bj, At, Bt) do { __builtin_amdgcn_s_setprio(1); _Pragma("unroll") for (int m = 0; m < 4; ++m) _Pragma("unroll") for (int n = 0; n < 2; ++n) _Pragma("unroll") for (int k = 0; k < 2; ++k) \
        acc[ai][bj][m][n] = __builtin_amdgcn_mfma_f32_16x16x32_bf16(Bt[n][k], At[m][k], acc[ai][bj][m][n], 0, 0, 0); __builtin_amdgcn_s_setprio(0); } while (0)
#define PG8_WAIT_V(n) asm volatile("s_waitcnt vmcnt(" #n ")" ::: "memory")
#define PG8_WAIT_L(n) asm volatile("s_waitcnt lgkmcnt(" #n ")" ::: "memory")
#define PG8_BAR __builtin_amdgcn_s_barrier()
#define PG8_SCHED __builtin_amdgcn_sched_barrier(0)
    Unit cur, nxt; int ui = 0;
    if (!S.next(0, cur)) return;
    f32x4 acc[2][2][4][2];
#pragma unroll
    for (int a = 0; a < 2; ++a)
#pragma unroll
        for (int b = 0; b < 2; ++b)
#pragma unroll
            for (int m = 0; m < 4; ++m)
#pragma unroll
                for (int n = 0; n < 2; ++n) acc[a][b][m][n] = (f32x4){0.f, 0.f, 0.f, 0.f};
    bf16x8 At[4][2], B0[2][2], B1[2][2];
    const char* cA = (const char*)g.A + (size_t)cur.pm * tstep; const char* cB = (const char*)g.Bt + (size_t)cur.pn * tstep;
    S.a_ready(cur);
    if constexpr (SP2) {
        PG8_STAGE(PG8_SB(0, 0), cB, voffB); PG8_STAGE(PG8_SB(0, 1), cB + hstep, voffB); PG8_STAGE(PG8_SA(0, 0), cA, voffA); PG8_STAGE(PG8_SA(0, 1), cA + hstep, voffA);
        if (wr == 1) PG8_BAR;
        PG8_WAIT_V(2); PG8_BAR;
        PG8_STAGE(PG8_SB(1, 0), cB + kstep, voffB); PG8_STAGE(PG8_SA(1, 0), cA + kstep, voffA); PG8_STAGE(PG8_SB(1, 1), cB + hstep + kstep, voffB);
        PG8_WAIT_V(6); PG8_BAR;
    } else {
        PG8_STAGE(PG8_SB(0, 0), cB, voffB); PG8_STAGE(PG8_SA(0, 0), cA, voffA); PG8_STAGE(PG8_SB(0, 1), cB + hstep, voffB); PG8_STAGE(PG8_SA(0, 1), cA + hstep, voffA);
        if (wr == 1) PG8_BAR;
        PG8_WAIT_V(4); PG8_BAR;
        PG8_STAGE(PG8_SB(1, 0), cB + kstep, voffB); PG8_STAGE(PG8_SA(1, 0), cA + kstep, voffA); PG8_STAGE(PG8_SB(1, 1), cB + hstep + kstep, voffB);
        PG8_WAIT_V(6); PG8_BAR;
    }
    for (;;) {
        const bool has_next = S.next(ui + 1, nxt);
        const char* nA = has_next ? (const char*)g.A + (size_t)nxt.pm * tstep : cA; const char* nB = has_next ? (const char*)g.Bt + (size_t)nxt.pn * tstep : cB;
        for (int t = 0; t < nt; t += 2) {
            const bool last = (t == nt - 2);
            const char* a1 = cA + (size_t)(t + 1) * kstep;
            const char* a2 = last ? nA : cA + (size_t)(t + 2) * kstep; const char* b2 = last ? nB : cB + (size_t)(t + 2) * kstep;
            const char* a3 = a2 + kstep; const char* b3 = b2 + kstep;
            if (last && has_next) S.a_ready(nxt);
            if constexpr (SP2) {
            PG8_LDB(B0, 0, 0); PG8_LDB(B1, 0, 1); PG8_SCHED; PG8_LDA(At, 0, 0); PG8_STAGE(PG8_SA(1, 1), a1 + hstep, voffA);
            PG8_WAIT_V(8); PG8_WAIT_L(0); PG8_BAR; PG8_MMA(0, 0, At, B0); PG8_MMA(0, 1, At, B1); PG8_BAR; PG8_SCHED;
            PG8_LDA(At, 0, 1); PG8_STAGE(PG8_SB(0, 0), b2, voffB); PG8_STAGE(PG8_SB(0, 1), b2 + hstep, voffB); PG8_STAGE(PG8_SA(0, 0), a2, voffA);
            PG8_WAIT_V(8); PG8_WAIT_L(0); PG8_BAR; PG8_MMA(1, 0, At, B0); PG8_MMA(1, 1, At, B1); PG8_BAR; PG8_SCHED;
            PG8_LDB(B0, 1, 0); PG8_LDB(B1, 1, 1); PG8_SCHED; PG8_LDA(At, 1, 0); PG8_STAGE(PG8_SA(0, 1), a2 + hstep, voffA);
            PG8_WAIT_V(8); PG8_WAIT_L(0); PG8_BAR; PG8_MMA(0, 0, At, B0); PG8_MMA(0, 1, At, B1); PG8_BAR; PG8_SCHED;
            PG8_LDA(At, 1, 1); PG8_STAGE(PG8_SB(1, 0), b3, voffB); PG8_STAGE(PG8_SB(1, 1), b3 + hstep, voffB); PG8_STAGE(PG8_SA(1, 0), a3, voffA);
            PG8_WAIT_V(8); PG8_WAIT_L(0); PG8_BAR; PG8_MMA(1, 0, At, B0); PG8_MMA(1, 1, At, B1); PG8_BAR; PG8_SCHED;
            } else {
            PG8_LDB(B0, 0, 0); PG8_SCHED; PG8_LDA(At, 0, 0); PG8_STAGE(PG8_SA(1, 1), a1 + hstep, voffA);
            PG8_WAIT_L(8); PG8_BAR; PG8_WAIT_L(0); PG8_MMA(0, 0, At, B0); PG8_BAR; PG8_SCHED;
            PG8_LDB(B1, 0, 1); PG8_STAGE(PG8_SB(0, 0), b2, voffB);
            PG8_BAR; PG8_WAIT_L(0); PG8_MMA(0, 1, At, B1); PG8_BAR;
            PG8_LDA(At, 0, 1); PG8_STAGE(PG8_SA(0, 0), a2, voffA);
            PG8_BAR; PG8_WAIT_L(0); PG8_MMA(1, 0, At, B0); PG8_BAR; PG8_SCHED;
            PG8_STAGE(PG8_SB(0, 1), b2 + hstep, voffB);
            PG8_WAIT_V(6); PG8_BAR; PG8_MMA(1, 1, At, B1); PG8_BAR;
            PG8_LDB(B0, 1, 0); PG8_SCHED; PG8_LDA(At, 1, 0); PG8_STAGE(PG8_SA(0, 1), a2 + hstep, voffA);
            PG8_WAIT_L(8); PG8_BAR; PG8_WAIT_L(0); PG8_MMA(0, 0, At, B0); PG8_BAR; PG8_SCHED;
            PG8_LDB(B1, 1, 1); PG8_STAGE(PG8_SB(1, 0), b3, voffB);
            PG8_BAR; PG8_WAIT_L(0); PG8_MMA(0, 1, At, B1); PG8_BAR;
            PG8_LDA(At, 1, 1); PG8_STAGE(PG8_SA(1, 0), a3, voffA);
            PG8_BAR; PG8_WAIT_L(0); PG8_MMA(1, 0, At, B0); PG8_BAR; PG8_SCHED;
            PG8_STAGE(PG8_SB(1, 1), b3 + hstep, voffB);
            PG8_WAIT_V(6); PG8_BAR; PG8_MMA(1, 1, At, B1); PG8_BAR;
            }
        }
        if constexpr (ALIGN_EPI) { if (wr == 0) PG8_BAR; }
        if constexpr (!Epi::AFTER_DRAIN) { E(acc, cur, wr, wc, fr, fq); S.done(cur); }
        if (!has_next) break;
#pragma unroll
        for (int a = 0; a < 2; ++a)
#pragma unroll
            for (int b = 0; b < 2; ++b)
#pragma unroll
                for (int m = 0; m < 4; ++m)
#pragma unroll
                    for (int n = 0; n < 2; ++n) acc[a][b][m][n] = (f32x4){0.f, 0.f, 0.f, 0.f};
        cur = nxt; cA = nA; cB = nB; ++ui;
        if constexpr (ALIGN_EPI) { if (wr == 1) PG8_BAR; }
    }
    PG8_WAIT_V(0);
    if constexpr (!ALIGN_EPI) { if (wr == 0) PG8_BAR; }
    PG8_BAR;
    if constexpr (Epi::AFTER_DRAIN) { E.fused(acc, cur, wr, wc, fr, fq, lds, wid, lane); S.done(cur); }
#undef PG8_SA
#undef PG8_SB
#undef PG8_STAGE
#undef PG8_LDA
#undef PG8_LDB
#undef PG8_MMA
#undef PG8_WAIT_V
#undef PG8_WAIT_L
#undef PG8_BAR
#undef PG8_SCHED
}
}

constexpr int SEQ = 8192, DM = 2048, INW = 10320, INW_PAD = 10496;
constexpr int AW = 1024, NIH = 16, IHD = 64, TOPK = 256, GW = 1024;
constexpr int PE_H = 8, PE_NK = 128, PE_TOPK = 16, PE_NE = 16384, PLE = 256;
constexpr float LN_EPS = 1e-5f;
constexpr float ALPHA = 1.189207115002721f;
constexpr float QSCALE = 0.08838834764831845f * 1.4426950408889634f;
constexpr int NWAVES = 8, NTHREADS = 512;
constexpr int LDS_BYTES = 147456;
constexpr int LDS_BARST = LDS_BYTES - 64;

constexpr size_t MiB = 1u << 20;
constexpr size_t WS_CTL = 0, CTL_ZERO_BYTES = 65536;
constexpr size_t WS_WA = 1 * MiB, WS_WG = 5 * MiB, WS_WMIX = 9 * MiB, WS_WQ = 17 * MiB, WS_WPG = 25 * MiB, WS_WPP = 33 * MiB, WS_SUBK = 34 * MiB;
constexpr size_t WS_PU = 35 * MiB, WS_PV = 99 * MiB, WS_STATS = 163 * MiB;
constexpr size_t WS_WIN = 164 * MiB, WS_HB = 205 * MiB;
constexpr size_t WS_Q = 237 * MiB, WS_KV = 253 * MiB, WS_QI = 285 * MiB, WS_KIWI = 301 * MiB;
constexpr size_t WS_GU = 305 * MiB, WS_GV = 321 * MiB, WS_GA = 337 * MiB, WS_GG = 369 * MiB;
constexpr size_t WS_GM = 401 * MiB, WS_ATT = 417 * MiB, WS_SC = 433 * MiB, WS_PB = 497 * MiB;
constexpr size_t WS_T = 164 * MiB, WS_MERGED = 237 * MiB, WS_H1F = 269 * MiB, WS_H1B = 333 * MiB, WS_PQ = 365 * MiB;
constexpr size_t WS_RF = 164 * MiB, WS_RB = 228 * MiB, WS_T2 = 405 * MiB;
constexpr size_t WS_MASK = 501 * MiB;
constexpr size_t WS_END = 512 * MiB;

#define GAS __attribute__((address_space(1)))
#define LAS __attribute__((address_space(3)))
typedef unsigned short bf16;
typedef unsigned v4u __attribute__((ext_vector_type(4)));
typedef unsigned v2u __attribute__((ext_vector_type(2)));
typedef float f32x4 __attribute__((ext_vector_type(4)));
typedef float f32x16 __attribute__((ext_vector_type(16)));
typedef short bf16x8 __attribute__((ext_vector_type(8)));
typedef __attribute__((ext_vector_type(2))) __bf16 bf2v;
#define LDS_WAIT() asm volatile("s_waitcnt lgkmcnt(0)" ::: "memory")
#define VM_WAIT() asm volatile("s_waitcnt vmcnt(0)" ::: "memory")

__device__ __forceinline__ unsigned f2bf(float f) { unsigned u = __builtin_bit_cast(unsigned, f); return (u + 0x7fffu + ((u >> 16) & 1u)) >> 16; }
__device__ __forceinline__ unsigned pk2(float lo, float hi) { return f2bf(lo) | (f2bf(hi) << 16); }
__device__ __forceinline__ float bflo(unsigned u) { return __builtin_bit_cast(float, u << 16); }
__device__ __forceinline__ float bfhi(unsigned u) { return __builtin_bit_cast(float, u & 0xffff0000u); }
__device__ __forceinline__ float bf2f(bf16 h) { return __builtin_bit_cast(float, (unsigned)h << 16); }
__device__ __forceinline__ float fast_rcp(float x) { return __builtin_amdgcn_rcpf(x); }
__device__ __forceinline__ float sigmoidf_(float x) { return fast_rcp(1.f + __expf(-x)); }
__device__ __forceinline__ float gelu_tanh(float x) { const float u = 1.5957691216057308f * (x + 0.044715f * x * x * x); return x * fast_rcp(1.f + __expf(-u)); }
__device__ __forceinline__ float wave_sum(float v) {
#pragma unroll
    for (int o = 1; o < 64; o <<= 1) v += __shfl_xor(v, o);
    return v;
}
__device__ __forceinline__ float dot2bf(unsigned a, unsigned b, float c) { return __builtin_amdgcn_fdot2_f32_bf16(__builtin_bit_cast(bf2v, a), __builtin_bit_cast(bf2v, b), c, false); }
__device__ __forceinline__ unsigned sortable(float f) { const unsigned u = __builtin_bit_cast(unsigned, f); return (u & 0x80000000u) ? ~u : (u | 0x80000000u); }

typedef const __attribute__((address_space(4))) unsigned char* kargp_t;
__device__ __forceinline__ unsigned long long karg_u64(int byte_off) {
    kargp_t ka = (kargp_t)__builtin_amdgcn_kernarg_segment_ptr();
    asm volatile("" : "+s"(ka));
    return *(const __attribute__((address_space(4))) unsigned long long*)(ka + byte_off);
}
struct Frame {
    LAS unsigned char* lds;
    int tid, lane, wave, G, bid;
    float* out; unsigned char* ws;
    __device__ __forceinline__ const float* in(int k) const { return (const float*)karg_u64(8 * k); }
};
#define MAKE_FRAME(F) Frame F; { int t_ = threadIdx.x; asm volatile("" : "+v"(t_)); F.tid = t_; F.lane = t_ & 63; F.wave = __builtin_amdgcn_readfirstlane(t_ >> 6); \
    F.G = gridDim.x; F.bid = blockIdx.x; F.lds = (LAS unsigned char*)lds_raw; F.out = (float*)karg_u64(192); F.ws = (unsigned char*)karg_u64(200); }

__device__ __forceinline__ int win_dest(int n) { return n < 4096 ? n : (n < 4176 ? n + 6144 : n - 80); }
template <bool MAP>
__device__ __forceinline__ void p0_transpose_item(const float* W, int K, int N, bf16* WT, LAS float* scr, int item, int lane) {
    const int nblk = (N + 31) / 32, kb = item / nblk, nb = item % nblk, k0 = 64 * kb, n0 = 32 * nb;
    const int nn = n0 + (lane & 31); const bool ok = nn < N;
#pragma unroll 8
    for (int i = 0; i < 32; ++i) { const int kk = 2 * i + (lane >> 5); scr[kk * 33 + (lane & 31)] = ok ? W[(size_t)(k0 + kk) * N + nn] : 0.f; }
    LDS_WAIT(); asm volatile("" ::: "memory");
    const int c = lane & 7;
#pragma unroll
    for (int j = 0; j < 4; ++j) { const int n = (lane >> 3) + 8 * j; const LAS float* s = scr + (8 * c) * 33 + n;
        v4u o; o.x = pk2(s[0 * 33], s[1 * 33]); o.y = pk2(s[2 * 33], s[3 * 33]); o.z = pk2(s[4 * 33], s[5 * 33]); o.w = pk2(s[6 * 33], s[7 * 33]);
        if (n0 + n < N) { const int drow = MAP ? win_dest(n0 + n) : (n0 + n); *(GAS v4u*)(WT + (size_t)drow * K + k0 + 8 * c) = o; } }
    LDS_WAIT(); asm volatile("" ::: "memory");
}
__device__ __forceinline__ void p0_convert(Frame& F, const float* src, bf16* dst, size_t n) {
    const size_t nth = (size_t)F.G * NTHREADS, n8 = n / 8;
    for (size_t i = (size_t)F.bid * NTHREADS + F.tid; i < n8; i += nth) {
        const f32x4 a = ((const GAS f32x4*)src)[2 * i], b = ((const GAS f32x4*)src)[2 * i + 1];
        v4u o; o.x = pk2(a.x, a.y); o.y = pk2(a.z, a.w); o.z = pk2(b.x, b.y); o.w = pk2(b.z, b.w);
        ((GAS v4u*)dst)[i] = o; }
}
__device__ __forceinline__ void ln_row(Frame& F, const float* xrow, const float* g, const float* b, bf16* ob, float* of, float* stats) {
    const GAS f32x4* xr = (const GAS f32x4*)xrow + F.lane;
    f32x4 v[8]; float s = 0.f;
#pragma unroll
    for (int j = 0; j < 8; ++j) { v[j] = xr[64 * j]; s += (v[j].x + v[j].y) + (v[j].z + v[j].w); }
    const float mean = wave_sum(s) * (1.f / DM); float s2 = 0.f;
#pragma unroll
    for (int j = 0; j < 8; ++j) { v[j] = v[j] - mean; s2 += (v[j].x * v[j].x + v[j].y * v[j].y) + (v[j].z * v[j].z + v[j].w * v[j].w); }
    const float rstd = 1.f / sqrtf(wave_sum(s2) * (1.f / DM) + LN_EPS);
    if (stats && F.lane == 0) { stats[0] = mean; stats[1] = rstd; }
#pragma unroll
    for (int j = 0; j < 8; ++j) {
        const f32x4 gg = ((const GAS f32x4*)g)[64 * j + F.lane], bb = ((const GAS f32x4*)b)[64 * j + F.lane];
        const f32x4 y = v[j] * rstd * gg + bb;
        if (ob) { v2u o; o.x = pk2(y.x, y.y); o.y = pk2(y.z, y.w); ((GAS v2u*)ob)[64 * j + F.lane] = o; }
        if (of) ((GAS f32x4*)of)[64 * j + F.lane] = y;
    }
}
__device__ __forceinline__ void p0_prologue(Frame& F) {
    LAS float* scr = (LAS float*)(F.lds + F.wave * 16384);
    const int gw = F.bid * NWAVES + F.wave, NGW = F.G * NWAVES;
    unsigned char* ws = F.ws;
    constexpr int I_IN = (DM / 64) * ((INW + 31) / 32), I_A = (AW / 64) * (DM / 32), I_G = (GW / 64) * (DM / 32), I_SQ = (DM / 64) * (DM / 32), I_PP = (PLE / 64) * (DM / 32);
    constexpr int NITEMS = I_IN + I_A + I_G + 3 * I_SQ + I_PP;
    for (int it = gw; it < NITEMS; it += NGW) {
        int r = it;
        if (r < I_IN) { p0_transpose_item<true>(F.in(6), DM, INW, (bf16*)(ws + WS_WIN), scr, r, F.lane); continue; } r -= I_IN;
        if (r < I_A) { p0_transpose_item<false>(F.in(11), AW, DM, (bf16*)(ws + WS_WA), scr, r, F.lane); continue; } r -= I_A;
        if (r < I_G) { p0_transpose_item<false>(F.in(12), GW, DM, (bf16*)(ws + WS_WG), scr, r, F.lane); continue; } r -= I_G;
        if (r < I_SQ) { p0_transpose_item<false>(F.in(13), DM, DM, (bf16*)(ws + WS_WMIX), scr, r, F.lane); continue; } r -= I_SQ;
        if (r < I_SQ) { p0_transpose_item<false>(F.in(16), DM, DM, (bf16*)(ws + WS_WQ), scr, r, F.lane); continue; } r -= I_SQ;
        if (r < I_SQ) { p0_transpose_item<false>(F.in(21), DM, DM, (bf16*)(ws + WS_WPG), scr, r, F.lane); continue; } r -= I_SQ;
        p0_transpose_item<false>(F.in(20), PLE, DM, (bf16*)(ws + WS_WPP), scr, r, F.lane);
    }
    { const size_t n16 = (size_t)(INW_PAD - INW) * DM * 2 / 16; GAS v4u* z = (GAS v4u*)(ws + WS_WIN + (size_t)INW * DM * 2);
      for (size_t i = (size_t)F.bid * NTHREADS + F.tid; i < n16; i += (size_t)F.G * NTHREADS) z[i] = (v4u){0u, 0u, 0u, 0u}; }
    p0_convert(F, F.in(18), (bf16*)(ws + WS_PU), (size_t)PE_NE * DM);
    p0_convert(F, F.in(19), (bf16*)(ws + WS_PV), (size_t)PE_NE * DM);
    p0_convert(F, F.in(17), (bf16*)(ws + WS_SUBK), (size_t)PE_H * 2 * PE_NK * 128);
    p0_convert(F, F.in(1), (bf16*)(ws + WS_PB), (size_t)SEQ * PLE);
    for (int m = gw; m < SEQ; m += NGW) ln_row(F, F.in(0) + (size_t)m * DM, F.in(3), F.in(4), (bf16*)(ws + WS_HB) + (size_t)m * DM, nullptr, (float*)(ws + WS_STATS) + 2 * m);
}

typedef GAS unsigned gu32;
#define XB_TMO      128
#define XB_XCNT(j)  (256  + 64 * (j))
#define XB_XSUB(j)  (1280 + 64 * (j))
#define XB_XGEN(j)  (2304 + 64 * (j))
#define XB_TOP      3328
#define XB_TOPGEN   3392
#define XCD_BAR_WORDS 3456
#define XB_SPIN_CAP (1u << 18)

__device__ __forceinline__ unsigned xb_ld(unsigned* p)              { return __hip_atomic_load(p, __ATOMIC_RELAXED, __HIP_MEMORY_SCOPE_AGENT); }
__device__ __forceinline__ unsigned xb_add(unsigned* p, unsigned v) { return __hip_atomic_fetch_add(p, v, __ATOMIC_RELAXED, __HIP_MEMORY_SCOPE_AGENT); }
__device__ __forceinline__ unsigned xb_xcc_id() { return (unsigned)__builtin_amdgcn_s_getreg((3 << 11) | 20) & 0xFu; }
#define XB_SPIN(cond, bar) do { unsigned _sp = 0; while (cond) { __builtin_amdgcn_s_sleep(1); \
    if ((++_sp & 255u) == 0u) { if (xb_ld(&(bar)[XB_TMO])) break; if (_sp > XB_SPIN_CAP) { atomicAdd(&(bar)[XB_TMO], 1u); break; } } } } while (0)

struct XcdBarrier {
    unsigned* bar; unsigned x;
    volatile LAS unsigned* st;
};

__device__ __forceinline__ XcdBarrier xcd_barrier_post(unsigned* bar, volatile LAS unsigned* st) {
    XcdBarrier b; b.bar = bar; b.x = xb_xcc_id(); b.st = st;
    if (threadIdx.x == 0) (void)xb_add(&bar[XB_XCNT(b.x)], 1u);
    return b;
}
__device__ __forceinline__ void xcd_barrier_complete(unsigned* bar, unsigned x, unsigned& nloc, unsigned& nx) {
    const unsigned G = gridDim.x * gridDim.y * gridDim.z;
    unsigned sum, cnt, mine, sp = 0u;
    for (;;) {
        sum = 0u; cnt = 0u; mine = 0u;
#pragma unroll
        for (unsigned j = 0; j < 16; ++j) { const unsigned c = xb_ld(&bar[XB_XCNT(j)]); sum += c; cnt += (c > 0u) ? 1u : 0u; mine = (j == x) ? c : mine; }
        if (sum == G) break;
        __builtin_amdgcn_s_sleep(1);
        if ((++sp & 255u) == 0u) { if (xb_ld(&bar[XB_TMO])) break; if (sp > XB_SPIN_CAP) { atomicAdd(&bar[XB_TMO], 1u); break; } }
    }
    nloc = mine > 0u ? mine : 1u; nx = cnt > 0u ? cnt : 1u;
}

__device__ __forceinline__ void xcd_barrier(const XcdBarrier& b) {
    asm volatile("s_waitcnt vmcnt(0)" ::: "memory");
    __syncthreads();
    if (threadIdx.x == 0) {
        unsigned* bar = b.bar;
        __builtin_amdgcn_s_waitcnt(0);
        unsigned nloc = b.st[0], nx = b.st[1];
        if (nloc == 0u) { xcd_barrier_complete(bar, b.x, nloc, nx); b.st[0] = nloc; b.st[1] = nx; }
        const unsigned old = xb_add(&bar[XB_XSUB(b.x)], 1u);
        const unsigned gen = old / nloc;
        if (old + 1u == (gen + 1u) * nloc) {
            __builtin_amdgcn_fence(__ATOMIC_RELEASE, "agent");
            asm volatile("s_waitcnt vmcnt(0)" ::: "memory");
            const unsigned og = xb_add(&bar[XB_TOP], 1u);
            const unsigned tg = og / nx;
            if (og + 1u == (tg + 1u) * nx) xb_add(&bar[XB_TOPGEN], 1u);
            else XB_SPIN(xb_ld(&bar[XB_TOPGEN]) == tg, bar);
            __builtin_amdgcn_fence(__ATOMIC_ACQUIRE, "agent");
            xb_add(&bar[XB_XGEN(b.x)], 1u);
            asm volatile("s_waitcnt vmcnt(0)" ::: "memory");
        } else {
            XB_SPIN(xb_ld(&bar[XB_XGEN(b.x)]) == gen, bar);
            __builtin_amdgcn_fence(__ATOMIC_ACQUIRE, "agent");
            asm volatile("s_waitcnt vmcnt(0)" ::: "memory");
        }
    }
    __syncthreads();
}

namespace pg8 {
struct EpiWin {
    static constexpr bool PERM = true, AFTER_DRAIN = false;
    bf16 *q, *kv, *qi, *gu, *gv, *ga, *gg, *kiwi;
    __device__ __forceinline__ void operator()(const f32x4 (&acc)[2][2][4][2], const Unit& u, int wr, int wc, int fr, int fq) const {
        const int pn = u.pn; bf16* base; int ld, colt, act = 0; float sc = 1.f;
        if (pn < 4) { base = q; ld = 1024; colt = pn * 256; sc = QSCALE; }
        else if (pn < 12) { base = kv; ld = 2048; colt = (pn - 4) * 256; }
        else if (pn < 16) { base = qi; ld = 1024; colt = (pn - 12) * 256; }
        else if (pn < 20) { base = gu; ld = 1024; colt = (pn - 16) * 256; act = 1; }
        else if (pn < 24) { base = gv; ld = 1024; colt = (pn - 20) * 256; act = 1; }
        else if (pn < 32) { base = ga; ld = 2048; colt = (pn - 24) * 256; act = 2; }
        else if (pn < 40) { base = gg; ld = 2048; colt = (pn - 32) * 256; act = 2; }
        else { base = kiwi; ld = 256; colt = 0; }
        const int row0 = u.pm * BM + wr * 64 + fr, col0 = colt + wc * 32 + 8 * fq;
#pragma unroll
        for (int ai = 0; ai < 2; ++ai)
#pragma unroll
            for (int m = 0; m < 4; ++m) { bf16* rowp = base + (size_t)(row0 + ai * HALF + m * 16) * ld + col0;
#pragma unroll
                for (int bj = 0; bj < 2; ++bj) { f32x4 v0 = acc[ai][bj][m][0], v1 = acc[ai][bj][m][1];
                    if (act == 1) {
#pragma unroll
                        for (int e = 0; e < 4; ++e) { v0[e] = gelu_tanh(v0[e]); v1[e] = gelu_tanh(v1[e]); } }
                    else if (act == 2) {
#pragma unroll
                        for (int e = 0; e < 4; ++e) { v0[e] = sigmoidf_(v0[e]); v1[e] = sigmoidf_(v1[e]); } }
                    else { v0 = v0 * sc; v1 = v1 * sc; }
                    v4u w; w.x = pk2(v0[0], v0[1]); w.y = pk2(v0[2], v0[3]); w.z = pk2(v1[0], v1[1]); w.w = pk2(v1[2], v1[3]);
                    *(GAS v4u*)(rowp + bj * HALF) = w; } }
    }
};
struct EpiGateF32 {
    static constexpr bool PERM = true, AFTER_DRAIN = false;
    const bf16* gate; float* T; int ldc;
    __device__ __forceinline__ void operator()(const f32x4 (&acc)[2][2][4][2], const Unit& u, int wr, int wc, int fr, int fq) const {
        const int row0 = u.pm * BM + wr * 64 + fr, col0 = u.pn * BM + wc * 32 + 8 * fq;
#pragma unroll
        for (int ai = 0; ai < 2; ++ai)
#pragma unroll
            for (int m = 0; m < 4; ++m) { const size_t off = (size_t)(row0 + ai * HALF + m * 16) * ldc + col0;
#pragma unroll
                for (int bj = 0; bj < 2; ++bj) { const v4u g = *(const GAS v4u*)(gate + off + bj * HALF);
                    f32x4 v0 = acc[ai][bj][m][0], v1 = acc[ai][bj][m][1];
                    v0[0] *= bflo(g.x); v0[1] *= bfhi(g.x); v0[2] *= bflo(g.y); v0[3] *= bfhi(g.y);
                    v1[0] *= bflo(g.z); v1[1] *= bfhi(g.z); v1[2] *= bflo(g.w); v1[3] *= bfhi(g.w);
                    *(GAS f32x4*)(T + off + bj * HALF) = v0; *(GAS f32x4*)(T + off + bj * HALF + 4) = v1; } }
    }
};
struct EpiMerge {
    static constexpr bool PERM = true, AFTER_DRAIN = false;
    const bf16* gate; const float* T; bf16* O; int ldc;
    __device__ __forceinline__ void operator()(const f32x4 (&acc)[2][2][4][2], const Unit& u, int wr, int wc, int fr, int fq) const {
        const int row0 = u.pm * BM + wr * 64 + fr, col0 = u.pn * BM + wc * 32 + 8 * fq;
#pragma unroll
        for (int ai = 0; ai < 2; ++ai)
#pragma unroll
            for (int m = 0; m < 4; ++m) { const size_t off = (size_t)(row0 + ai * HALF + m * 16) * ldc + col0;
#pragma unroll
                for (int bj = 0; bj < 2; ++bj) { const v4u g = *(const GAS v4u*)(gate + off + bj * HALF);
                    const f32x4 t0 = *(const GAS f32x4*)(T + off + bj * HALF), t1 = *(const GAS f32x4*)(T + off + bj * HALF + 4);
                    f32x4 v0 = acc[ai][bj][m][0], v1 = acc[ai][bj][m][1];
                    v0[0] = t0[0] + v0[0] * bflo(g.x); v0[1] = t0[1] + v0[1] * bfhi(g.x); v0[2] = t0[2] + v0[2] * bflo(g.y); v0[3] = t0[3] + v0[3] * bfhi(g.y);
                    v1[0] = t1[0] + v1[0] * bflo(g.z); v1[1] = t1[1] + v1[1] * bfhi(g.z); v1[2] = t1[2] + v1[2] * bflo(g.w); v1[3] = t1[3] + v1[3] * bfhi(g.w);
                    v4u w; w.x = pk2(v0[0], v0[1]); w.y = pk2(v0[2], v0[3]); w.z = pk2(v1[0], v1[1]); w.w = pk2(v1[2], v1[3]);
                    *(GAS v4u*)(O + off + bj * HALF) = w; } }
    }
};
struct EpiMix {
    static constexpr bool PERM = false, AFTER_DRAIN = false;
    const float* x; const float* stats; const float* g; const float* b; float* Y; int ldc;
    __device__ __forceinline__ void operator()(const f32x4 (&acc)[2][2][4][2], const Unit& u, int wr, int wc, int fr, int fq) const {
        const int row0 = u.pm * BM + wr * 64 + fr, col0 = u.pn * BM + wc * 32 + 4 * fq;
        f32x4 gv[2][2], bv[2][2];
#pragma unroll
        for (int bj = 0; bj < 2; ++bj)
#pragma unroll
            for (int n = 0; n < 2; ++n) { gv[bj][n] = *(const GAS f32x4*)(g + col0 + bj * HALF + n * 16); bv[bj][n] = *(const GAS f32x4*)(b + col0 + bj * HALF + n * 16); }
#pragma unroll
        for (int ai = 0; ai < 2; ++ai)
#pragma unroll
            for (int m = 0; m < 4; ++m) { const int r = row0 + ai * HALF + m * 16; const size_t off = (size_t)r * ldc + col0;
                const float mean = stats[2 * r], rstd = stats[2 * r + 1];
#pragma unroll
                for (int bj = 0; bj < 2; ++bj)
#pragma unroll
                    for (int n = 0; n < 2; ++n) { const f32x4 xv = *(const GAS f32x4*)(x + off + bj * HALF + n * 16);
                        const f32x4 h = (xv - mean) * rstd * gv[bj][n] + bv[bj][n];
                        *(GAS f32x4*)(Y + off + bj * HALF + n * 16) = h * ALPHA + acc[ai][bj][m][n] * DBG_MIX_S; } }
    }
};
struct EpiF32 {
    static constexpr bool PERM = false, AFTER_DRAIN = false;
    float* Y; int ldc;
    __device__ __forceinline__ void operator()(const f32x4 (&acc)[2][2][4][2], const Unit& u, int wr, int wc, int fr, int fq) const {
        const int row0 = u.pm * BM + wr * 64 + fr, col0 = u.pn * BM + wc * 32 + 4 * fq;
#pragma unroll
        for (int ai = 0; ai < 2; ++ai)
#pragma unroll
            for (int m = 0; m < 4; ++m) { const size_t off = (size_t)(row0 + ai * HALF + m * 16) * ldc + col0;
#pragma unroll
                for (int bj = 0; bj < 2; ++bj)
#pragma unroll
                    for (int n = 0; n < 2; ++n) *(GAS f32x4*)(Y + off + bj * HALF + n * 16) = acc[ai][bj][m][n]; }
    }
};
struct EpiPle {
    static constexpr bool PERM = false, AFTER_DRAIN = false;
    const float* R; const float* T2; float* Y; int ldc;
    __device__ __forceinline__ void operator()(const f32x4 (&acc)[2][2][4][2], const Unit& u, int wr, int wc, int fr, int fq) const {
        const int row0 = u.pm * BM + wr * 64 + fr, col0 = u.pn * BM + wc * 32 + 4 * fq;
#pragma unroll
        for (int ai = 0; ai < 2; ++ai)
#pragma unroll
            for (int m = 0; m < 4; ++m) { const size_t off = (size_t)(row0 + ai * HALF + m * 16) * ldc + col0;
#pragma unroll
                for (int bj = 0; bj < 2; ++bj)
#pragma unroll
                    for (int n = 0; n < 2; ++n) { const f32x4 rv = *(const GAS f32x4*)(R + off + bj * HALF + n * 16), tv = *(const GAS f32x4*)(T2 + off + bj * HALF + n * 16);
                        const f32x4 a = acc[ai][bj][m][n]; f32x4 o;
#pragma unroll
                        for (int e = 0; e < 4; ++e) o[e] = rv[e] + DBG_PLE_S * sigmoidf_(a[e]) * tv[e];
                        *(GAS f32x4*)(Y + off + bj * HALF + n * 16) = o; } }
    }
};
}

__device__ __forceinline__ f32x16 mfma32(bf16x8 a, bf16x8 b, f32x16 c) { return __builtin_amdgcn_mfma_f32_32x32x16_bf16(a, b, c, 0, 0, 0); }
__device__ __forceinline__ void unpack8(const v4u a, float (&x)[8]) { x[0] = bflo(a.x); x[1] = bfhi(a.x); x[2] = bflo(a.y); x[3] = bfhi(a.y); x[4] = bflo(a.z); x[5] = bfhi(a.z); x[6] = bflo(a.w); x[7] = bfhi(a.w); }

__device__ __forceinline__ void gmlp_unit(Frame& F, int unit) {
    const int n = unit >> 3, g = unit & 7, row0 = n * 128;
    const bf16* gvb = (const bf16*)(F.ws + WS_GV); const bf16* gub = (const bf16*)(F.ws + WS_GU); bf16* gm = (bf16*)(F.ws + WS_GM);
    LAS float* st = (LAS float*)F.lds;
    LAS bf16* VT = (LAS bf16*)(F.lds + 1024);
    for (int i = 0; i < 16; ++i) { const int r = F.wave * 16 + i;
        const GAS v4u* rp = (const GAS v4u*)(gvb + (size_t)(row0 + r) * GW);
        const v4u a = rp[F.lane], b = rp[64 + F.lane];
        float x[16]; { float t0[8], t1[8]; unpack8(a, t0); unpack8(b, t1);
#pragma unroll
            for (int e = 0; e < 8; ++e) { x[e] = t0[e]; x[8 + e] = t1[e]; } }
        float s = 0.f;
#pragma unroll
        for (int e = 0; e < 16; ++e) s += x[e];
        const float mean = wave_sum(s) * (1.f / GW); float s2 = 0.f;
#pragma unroll
        for (int e = 0; e < 16; ++e) { const float d = x[e] - mean; s2 += d * d; }
        const float rstd = 1.f / sqrtf(wave_sum(s2) * (1.f / GW) + LN_EPS);
        if (F.lane == 0) { st[2 * r] = mean; st[2 * r + 1] = rstd; } }
    __syncthreads();
    const float* lg = F.in(7) + g * 128; const float* lb = F.in(8) + g * 128;
#pragma unroll
    for (int i = 0; i < 4; ++i) { const int id = F.tid + 512 * i, s = id >> 4, c8 = id & 15;
        const v4u a = *(const GAS v4u*)(gvb + (size_t)(row0 + s) * GW + g * 128 + c8 * 8);
        float x[8]; unpack8(a, x);
        const float mean = st[2 * s], rstd = st[2 * s + 1];
        const f32x4 g0 = *(const GAS f32x4*)(lg + c8 * 8), g1 = *(const GAS f32x4*)(lg + c8 * 8 + 4), b0 = *(const GAS f32x4*)(lb + c8 * 8), b1 = *(const GAS f32x4*)(lb + c8 * 8 + 4);
#pragma unroll
        for (int e = 0; e < 8; ++e) { const float gg = e < 4 ? g0[e & 3] : g1[e & 3], bb = e < 4 ? b0[e & 3] : b1[e & 3];
            VT[(c8 * 8 + e) * 136 + s] = (bf16)f2bf((x[e] - mean) * rstd * gg + bb); } }
    __syncthreads();
    const int r = F.lane & 31, hh = F.lane >> 5, tt = F.wave >> 1, ct0 = (F.wave & 1) * 2;
    f32x16 acc0, acc1;
#pragma unroll
    for (int e = 0; e < 16; ++e) { acc0[e] = 0.f; acc1[e] = 0.f; }
    const float* wsm = F.in(9) + (size_t)g * 128 * 128;
    const int t = tt * 32 + r;
    for (int ks = 0; ks < (tt + 1) * 2; ++ks) {
        const int k0 = ks * 16 + 8 * hh;
        const f32x4 w0 = *(const GAS f32x4*)(wsm + t * 128 + k0), w1 = *(const GAS f32x4*)(wsm + t * 128 + k0 + 4);
        float wv[8] = {w0.x, w0.y, w0.z, w0.w, w1.x, w1.y, w1.z, w1.w};
#pragma unroll
        for (int e = 0; e < 8; ++e) if (k0 + e > t) wv[e] = 0.f;
        v4u ap; ap.x = pk2(wv[0], wv[1]); ap.y = pk2(wv[2], wv[3]); ap.z = pk2(wv[4], wv[5]); ap.w = pk2(wv[6], wv[7]);
        const bf16x8 A = __builtin_bit_cast(bf16x8, ap);
        const bf16x8 B0 = *(const LAS bf16x8*)(VT + (ct0 * 32 + r) * 136 + k0), B1 = *(const LAS bf16x8*)(VT + ((ct0 + 1) * 32 + r) * 136 + k0);
        acc0 = mfma32(A, B0, acc0); acc1 = mfma32(A, B1, acc1);
    }
    const float* bs = F.in(10) + g * 128;
#pragma unroll
    for (int reg = 0; reg < 16; ++reg) { const int tr = tt * 32 + (reg & 3) + 8 * (reg >> 2) + 4 * hh; const float bsv = bs[tr];
        const size_t o0 = (size_t)(row0 + tr) * GW + g * 128 + ct0 * 32 + r;
#if DBG_GMLP_X2
        acc0[reg] *= 2.f; acc1[reg] *= 2.f;
#endif
#if DBG_NO_GMLP
        acc0[reg] = 0.f; acc1[reg] = 0.f;
#endif
        gm[o0] = (bf16)f2bf(bf2f(gub[o0]) * (acc0[reg] + bsv));
        gm[o0 + 32] = (bf16)f2bf(bf2f(gub[o0 + 32]) * (acc1[reg] + bsv)); }
    __syncthreads();
}

__device__ __constant__ unsigned char REL_BUCKET[128] = {0, 1, 2, 3, 4, 5, 6, 7, 8, 9, 10, 11, 12, 13, 14, 15, 16, 16, 16, 17, 17, 18, 18, 18, 19, 19, 19, 20, 20, 20, 20, 21, 21, 21, 21, 22, 22, 22, 22, 22, 23, 23, 23, 23, 23, 23, 24, 24, 24, 24, 24, 24, 25, 25, 25, 25, 25, 25, 25, 26, 26, 26, 26, 26, 26, 26, 26, 27, 27, 27, 27, 27, 27, 27, 27, 27, 27, 28, 28, 28, 28, 28, 28, 28, 28, 28, 28, 29, 29, 29, 29, 29, 29, 29, 29, 29, 29, 29, 29, 30, 30, 30, 30, 30, 30, 30, 30, 30, 30, 30, 30, 30, 30, 31, 31, 31, 31, 31, 31, 31, 31, 31, 31, 31, 31, 31, 31, 31};
constexpr int KI_PITCH = 144;
constexpr unsigned NEG_KEY = 0x007FFFFFu;
__device__ __forceinline__ int mbcnt64(unsigned long long m) { return __builtin_amdgcn_mbcnt_hi((unsigned)(m >> 32), __builtin_amdgcn_mbcnt_lo((unsigned)m, 0u)); }

#define IDX_LOAD_TILE(t_) do { _Pragma("unroll") for (int i_ = 0; i_ < 4; ++i_) { const int id_ = F.tid + 512 * i_; \
    stg[i_] = *(const GAS v4u*)(kiwi + (size_t)((t_) * 256 + (id_ >> 3)) * 256 + (id_ & 7) * 8); } } while (0)

__device__ __forceinline__ void idx_unit(Frame& F, int unit) {
    const int q0 = unit * 16;
    const int kend = ((q0 + 15) / 32 + 1) * 32;
    const int nkt = (kend + 255) >> 8;
    const bf16* qi = (const bf16*)(F.ws + WS_QI); const bf16* kiwi = (const bf16*)(F.ws + WS_KIWI);
    const int* pos = (const int*)F.in(2);
    float* scr = (F.bid < 128) ? F.out + (size_t)F.bid * (16 * 8192) : (float*)(F.ws + WS_SC) + (size_t)(F.bid - 128) * (16 * 8192);
    const int r = F.lane & 31, hh = F.lane >> 5;
    const int wq = q0 + 2 * F.wave;
    for (int repA = 0; repA < (DBG_REP_SUB == 1 ? 2 : 1); ++repA) {
        const int aq = wq + ((r >> 2) & 1), ah = (r & 3) + 4 * (r >> 3);
        bf16x8 Af[4];
#pragma unroll
        for (int s = 0; s < 4; ++s) Af[s] = *(const GAS bf16x8*)(qi + (size_t)aq * 1024 + ah * 64 + s * 16 + 8 * hh);
        float wgt[16];
        { const v4u a = *(const GAS v4u*)(kiwi + (size_t)(wq + hh) * 256 + 64), b = *(const GAS v4u*)(kiwi + (size_t)(wq + hh) * 256 + 72);
          float t0[8], t1[8]; unpack8(a, t0); unpack8(b, t1);
#pragma unroll
          for (int e = 0; e < 8; ++e) { wgt[e] = t0[e]; wgt[8 + e] = t1[e]; } }
        const int qpos = pos[wq + hh];
        float* srow = scr + (size_t)(2 * F.wave + hh) * 8192;
        v4u stg[4];
        IDX_LOAD_TILE(0);
        for (int t = 0; t < nkt; ++t) {
            __syncthreads();
#pragma unroll
            for (int i = 0; i < 4; ++i) { const int id = F.tid + 512 * i; *(LAS v4u*)(F.lds + (id >> 3) * KI_PITCH + (id & 7) * 16) = stg[i]; }
            __syncthreads();
            if (t + 1 < nkt) IDX_LOAD_TILE(t + 1);
            for (int sub = 0; sub < 8; ++sub) {
                const int key0 = t * 256 + sub * 32;
                if (key0 >= kend) break;
                f32x16 acc;
#pragma unroll
                for (int e = 0; e < 16; ++e) acc[e] = 0.f;
#pragma unroll
                for (int s = 0; s < 4; ++s) { const bf16x8 B = *(const LAS bf16x8*)(F.lds + (sub * 32 + r) * KI_PITCH + s * 32 + hh * 16); acc = mfma32(Af[s], B, acc); }
                float sc = 0.f;
#pragma unroll
                for (int e = 0; e < 16; ++e) sc += wgt[e] * fmaxf(acc[e], 0.f);
                const int key = key0 + r; const int kp = pos[key];
                srow[key] = (kp <= qpos) ? sc : -__builtin_inff();
            }
        }
    }
    __threadfence(); __syncthreads();
    unsigned long long* maskg = (unsigned long long*)(F.ws + WS_MASK);
    const int kw = 128 * ((q0 >> 7) + 1);
#pragma unroll 1
    for (int qq = 0; qq < (DBG_REP_SUB == 2 ? 4 : 2); ++qq) {
        const int qrow = wq + (qq & 1);
        const float* sr = scr + (size_t)(2 * F.wave + (qq & 1)) * 8192;
        unsigned key[128];
        int ln1 = F.lane; asm volatile("" : "+v"(ln1));
        int ke1 = kend; asm volatile("" : "+s"(ke1));
#pragma unroll
        for (int jb = 0; jb < 8; ++jb) {
#pragma unroll
            for (int jj = 0; jj < 16; ++jj) { const int j = jb * 16 + jj; key[j] = 0u; if (j * 64 < ke1) { const int idx = j * 64 + ln1; if (idx < ke1) key[j] = sortable(sr[idx]); } }
            __builtin_amdgcn_sched_barrier(0); }
        unsigned thr = 0u;
        for (int bit = 31; bit >= 0; --bit) { const unsigned cand = thr | (1u << bit); int c = 0;
            int ke = kend; asm volatile("" : "+s"(ke));
#pragma unroll
            for (int jb = 0; jb < 16; ++jb) { if (jb * 512 < ke) {
#pragma unroll
                    for (int jj = 0; jj < 8; ++jj) c += __builtin_popcountll(__ballot(key[jb * 8 + jj] >= cand)); }
                __builtin_amdgcn_sched_barrier(0); }
            if (c >= TOPK) thr = cand; }
        int ngt = 0;
        int ke3 = kend; asm volatile("" : "+s"(ke3));
#pragma unroll
        for (int jb = 0; jb < 16; ++jb) { if (jb * 512 < ke3) {
#pragma unroll
                for (int jj = 0; jj < 8; ++jj) ngt += __builtin_popcountll(__ballot(key[jb * 8 + jj] > thr && key[jb * 8 + jj] > NEG_KEY)); }
            __builtin_amdgcn_sched_barrier(0); }
        const int need = TOPK - ngt;
        int tie_seen = 0;
        int ke4 = kw; asm volatile("" : "+s"(ke4));
        unsigned long long mw0 = 0ull, mw1 = 0ull;
#pragma unroll
        for (int j = 0; j < 128; ++j) { if (j * 64 < ke4) {
            const bool valid = key[j] > NEG_KEY, gt = valid && key[j] > thr, eq = valid && key[j] == thr;
            const unsigned long long meq = __ballot(eq);
            const bool take = gt || (eq && (tie_seen + mbcnt64(meq)) < need);
            tie_seen += __builtin_popcountll(meq);
            const unsigned long long m = __ballot(take);
            if (F.lane == (j & 63)) { if (j < 64) mw0 = m; else mw1 = m; } }
            __builtin_amdgcn_sched_barrier(0); }
        if (F.lane * 64 < kw) maskg[(size_t)qrow * 128 + F.lane] = mw0;
        if ((64 + F.lane) * 64 < kw) maskg[(size_t)qrow * 128 + 64 + F.lane] = mw1;
    }
}

typedef short s16x4 __attribute__((ext_vector_type(4)));
__device__ __forceinline__ f32x4 mfma16(bf16x8 a, bf16x8 b, f32x4 c) { return __builtin_amdgcn_mfma_f32_16x16x32_bf16(a, b, c, 0, 0, 0); }
constexpr int ATT_KP = 272, ATT_VP = 288;
constexpr int ATT_KB = 64 * ATT_KP, ATT_VB = 64 * ATT_VP;
constexpr int ATT_VOFF = 2 * ATT_KB, ATT_TAB = ATT_VOFF + 2 * ATT_VB;

#define ATT_LOAD_TILE(t_) do { _Pragma("unroll") for (int i_ = 0; i_ < 2; ++i_) { const int c_ = F.tid + 512 * i_; \
    const bf16* gp_ = kvb + (size_t)((t_) * 64 + (c_ >> 4)) * 2048 + head * 128 + (c_ & 15) * 8; \
    kst[i_] = *(const GAS v4u*)gp_; vst[i_] = *(const GAS v4u*)(gp_ + 1024); } } while (0)

__device__ __forceinline__ void attn_unit(Frame& F, int qb, int head) {
    const bf16* qg = (const bf16*)(F.ws + WS_Q); const bf16* kvb = (const bf16*)(F.ws + WS_KV);
    const unsigned long long* maskg = (const unsigned long long*)(F.ws + WS_MASK);
    const int* pos = (const int*)F.in(2);
    const int qi = F.lane & 15, g = F.lane >> 4;
    const int qrow = qb * 128 + F.wave * 16 + qi;
    LAS float* tab = (LAS float*)(F.lds + ATT_TAB);
    __syncthreads();
    if (F.tid < 128) { const float* relb = F.in(5); tab[F.tid] = (relb[(int)REL_BUCKET[F.tid] * 8 + head] - relb[31 * 8 + head]) * 1.4426950408889634f; }
    bf16x8 Qf[4];
#pragma unroll
    for (int ks = 0; ks < 4; ++ks) Qf[ks] = *(const GAS bf16x8*)(qg + (size_t)qrow * 1024 + head * 128 + ks * 32 + 8 * g);
    const int qps = pos[qrow];
    const int qpmin = pos[qb * 128 + F.wave * 16];
    f32x4 O[8];
#pragma unroll
    for (int d = 0; d < 8; ++d) O[d] = (f32x4){0.f, 0.f, 0.f, 0.f};
    float m = -1e30f, lsum = 0.f;
    const int ntiles = 2 * (qb + 1);
    v4u kst[2], vst[2];
    ATT_LOAD_TILE(0);
    unsigned long long mw_next = maskg[(size_t)qrow * 128];
    for (int t = 0; t < ntiles; ++t) {
        LAS unsigned char* Kb = F.lds + (t & 1) * ATT_KB; LAS unsigned char* Vb = F.lds + ATT_VOFF + (t & 1) * ATT_VB;
#pragma unroll
        for (int i = 0; i < 2; ++i) { const int c = F.tid + 512 * i; *(LAS v4u*)(Kb + (c >> 4) * ATT_KP + (c & 15) * 16) = kst[i]; *(LAS v4u*)(Vb + (c >> 4) * ATT_VP + (c & 15) * 16) = vst[i]; }
        __syncthreads();
        const unsigned long long mw = mw_next;
        if (t + 1 < ntiles) { ATT_LOAD_TILE(t + 1); mw_next = maskg[(size_t)qrow * 128 + t + 1]; }
        f32x4 S[4];
#pragma unroll
        for (int st = 0; st < 4; ++st) { S[st] = (f32x4){0.f, 0.f, 0.f, 0.f};
#pragma unroll
            for (int ks = 0; ks < 4; ++ks) { const bf16x8 A = *(const LAS bf16x8*)(Kb + (16 * st + qi) * ATT_KP + (ks * 32 + 8 * g) * 2); S[st] = mfma16(A, Qf[ks], S[st]); } }
        const bool near_tile = (qpmin - pos[t * 64 + 63]) < 113;
        float rmax = -__builtin_inff();
        const unsigned long long mwg = mw >> (4 * g);
#pragma unroll
        for (int st = 0; st < 4; ++st)
#pragma unroll
            for (int r = 0; r < 4; ++r) { const int bit = 16 * st + 4 * g + r; float s = S[st][r];
                if (near_tile) { const int dist = qps - pos[t * 64 + bit]; if (dist >= 0 && dist < 128) s += tab[dist]; }
                s = ((mwg >> (16 * st + r)) & 1ull) ? s : -__builtin_inff();
                S[st][r] = s; rmax = fmaxf(rmax, s); }
        rmax = fmaxf(rmax, __shfl_xor(rmax, 16)); rmax = fmaxf(rmax, __shfl_xor(rmax, 32));
        const float mnew = fmaxf(m, rmax);
        const float alpha = __builtin_amdgcn_exp2f(m - mnew);
        m = mnew;
        float psum = 0.f;
#pragma unroll
        for (int st = 0; st < 4; ++st)
#pragma unroll
            for (int r = 0; r < 4; ++r) { const float p = __builtin_amdgcn_exp2f(S[st][r] - mnew); S[st][r] = p; psum += p; }
        lsum = lsum * alpha + psum;
        if (__any(alpha != 1.f)) {
#pragma unroll
            for (int d = 0; d < 8; ++d) O[d] = O[d] * alpha; }
        bf16x8 Pf[2];
#pragma unroll
        for (int kk = 0; kk < 2; ++kk) { v4u w; w.x = pk2(S[2 * kk][0], S[2 * kk][1]); w.y = pk2(S[2 * kk][2], S[2 * kk][3]); w.z = pk2(S[2 * kk + 1][0], S[2 * kk + 1][1]); w.w = pk2(S[2 * kk + 1][2], S[2 * kk + 1][3]);
            Pf[kk] = __builtin_bit_cast(bf16x8, w); }
#pragma unroll
        for (int dt = 0; dt < 8; ++dt)
#pragma unroll
            for (int kk = 0; kk < 2; ++kk) {
                LAS unsigned char* ap = Vb + (32 * kk + 4 * g + (qi >> 2)) * ATT_VP + (16 * dt + 4 * (qi & 3)) * 2;
                const s16x4 a0 = __builtin_amdgcn_ds_read_tr16_b64_v4i16((LAS s16x4*)ap), a1 = __builtin_amdgcn_ds_read_tr16_b64_v4i16((LAS s16x4*)(ap + 16 * ATT_VP));
                const bf16x8 A = (bf16x8){a0[0], a0[1], a0[2], a0[3], a1[0], a1[1], a1[2], a1[3]};
                O[dt] = mfma16(A, Pf[kk], O[dt]); }
    }
    lsum += __shfl_xor(lsum, 16); lsum += __shfl_xor(lsum, 32);
    const float inv = 1.f / lsum;
    bf16* op = (bf16*)(F.ws + WS_ATT) + (size_t)qrow * 1024 + head * 128 + 4 * g;
#pragma unroll
    for (int dt = 0; dt < 8; ++dt) { v2u w; w.x = pk2(O[dt][0] * inv, O[dt][1] * inv); w.y = pk2(O[dt][2] * inv, O[dt][3] * inv); *(GAS v2u*)(op + 16 * dt) = w; }
}

__device__ __forceinline__ float unsortable(unsigned k) { return __builtin_bit_cast(float, (k & 0x80000000u) ? (k & 0x7fffffffu) : ~k); }
#define DOT2(a, b, c) dot2bf((a), (b), (c))

__device__ __forceinline__ void peer_unit(Frame& F, int unit) {
    const int tok0 = unit * 32;
    const bf16* pq = (const bf16*)(F.ws + WS_PQ); const bf16* subk = (const bf16*)(F.ws + WS_SUBK);
    LAS float* topS = (LAS float*)F.lds; LAS int* topI = (LAS int*)(F.lds + 32768);
    LAS int* esel = (LAS int*)(F.lds + 65536); LAS float* ew = (LAS float*)(F.lds + 81920);
    const int r = F.lane & 31, hh = F.lane >> 5;
#ifndef NO_A
    {
        const int h = F.wave;
        for (int p = 0; p < 2; ++p) {
            const int hp = h * 2 + p;
            bf16x8 Bq[8];
#pragma unroll
            for (int ks = 0; ks < 8; ++ks) Bq[ks] = *(const GAS bf16x8*)(pq + (size_t)(tok0 + r) * 2048 + hp * 128 + ks * 16 + 8 * hh);
            unsigned key[64];
#pragma unroll
            for (int kt = 0; kt < 4; ++kt) { f32x16 acc;
#pragma unroll
                for (int e = 0; e < 16; ++e) acc[e] = 0.f;
#pragma unroll
                for (int ks = 0; ks < 8; ++ks) { const bf16x8 A = *(const GAS bf16x8*)(subk + ((size_t)hp * 128 + kt * 32 + r) * 128 + ks * 16 + 8 * hh); acc = mfma32(A, Bq[ks], acc); }
#pragma unroll
                for (int e = 0; e < 16; ++e) key[kt * 16 + e] = sortable(acc[e]);
                __builtin_amdgcn_sched_barrier(0); }
            unsigned thr = 0u;
            for (int bit = 31; bit >= 0; --bit) { const unsigned cand = thr | (1u << bit); int c = 0;
#pragma unroll
                for (int i = 0; i < 64; ++i) c += (key[i] >= cand) ? 1 : 0;
                c += __shfl_xor(c, 32);
                if (c >= PE_TOPK) thr = cand; }
            int ngt = 0, neq = 0;
#pragma unroll
            for (int i = 0; i < 64; ++i) { ngt += (key[i] > thr) ? 1 : 0; neq += (key[i] == thr) ? 1 : 0; }
            const int pgt = __shfl_xor(ngt, 32), peq = __shfl_xor(neq, 32);
            int pg = hh ? pgt : 0, pe = ngt + pgt + (hh ? peq : 0);
            LAS float* ls = topS + ((r * 8 + h) * 2 + p) * 16; LAS int* li = topI + ((r * 8 + h) * 2 + p) * 16;
            unsigned thr2 = thr; asm volatile("" : "+v"(thr2));
#pragma unroll
            for (int kt = 0; kt < 4; ++kt)
#pragma unroll
                for (int e = 0; e < 16; ++e) { const unsigned k = key[kt * 16 + e]; const int kidx = kt * 32 + (e & 3) + 8 * (e >> 2) + 4 * hh;
                    if (k > thr2) { ls[pg] = unsortable(k); li[pg] = kidx; ++pg; }
                    else if (k == thr2) { if (pe < PE_TOPK) { ls[pe] = unsortable(k); li[pe] = kidx; } ++pe; } }
        }
    }
#endif
    __syncthreads();
#ifndef NO_B
    if (F.wave < 4) {
        const int L = F.wave * 64 + F.lane, tk = L >> 3, hd = L & 7;
        const LAS float* S0 = topS + ((tk * 8 + hd) * 2 + 0) * 16; const LAS int* I0 = topI + ((tk * 8 + hd) * 2 + 0) * 16;
        float s1[16]; int i1[16];
#pragma unroll
        for (int b = 0; b < 16; ++b) { s1[b] = topS[((tk * 8 + hd) * 2 + 1) * 16 + b]; i1[b] = topI[((tk * 8 + hd) * 2 + 1) * 16 + b]; }
        const float NINF = -__builtin_inff();
        float prev = __builtin_inff(), thr = NINF, top = 0.f;
        for (int round = 0; round < 16; ++round) {
            float cur = NINF;
#pragma unroll 1
            for (int a = 0; a < 16; ++a) { const float sa = S0[a];
#pragma unroll
                for (int b = 0; b < 16; ++b) { const float v = sa + s1[b]; cur = fmaxf(cur, v < prev ? v : NINF); } }
            if (round == 0) top = cur;
            thr = cur; prev = cur;
        }
        int n = 0; float den = 0.f; const int ob = tk * 128 + hd * 16;
#pragma unroll 1
        for (int a = 0; a < 16; ++a) { const float sa = S0[a]; const int ia = I0[a] * PE_NK;
#pragma unroll
            for (int b = 0; b < 16; ++b) { const float v = sa + s1[b];
                if (v > thr && n < PE_TOPK) { const float w = __expf(v - top); esel[ob + n] = ia + i1[b]; ew[ob + n] = w; den += w; ++n; } } }
#pragma unroll 1
        for (int a = 0; a < 16; ++a) { const float sa = S0[a]; const int ia = I0[a] * PE_NK;
#pragma unroll
            for (int b = 0; b < 16; ++b) { const float v = sa + s1[b];
                if (v == thr && n < PE_TOPK) { const float w = __expf(v - top); esel[ob + n] = ia + i1[b]; ew[ob + n] = w; den += w; ++n; } } }
        const float inv = 1.f / den;
        for (int k = 0; k < PE_TOPK; ++k) ew[ob + k] *= inv;
    }
#endif
    __syncthreads();
#ifndef NO_C
    {
        const bf16* h1b = (const bf16*)(F.ws + WS_H1B); const float* h1f = (const float*)(F.ws + WS_H1F);
        const bf16* PU = (const bf16*)(F.ws + WS_PU); const bf16* PV = (const bf16*)(F.ws + WS_PV);
        float* rf = (float*)(F.ws + WS_RF); bf16* rb = (bf16*)(F.ws + WS_RB);
        for (int tt = 0; tt < 4; ++tt) {
            const int tl = F.wave * 4 + tt, tok = tok0 + tl;
            v4u xp[4];
#pragma unroll
            for (int i = 0; i < 4; ++i) xp[i] = *(const GAS v4u*)(h1b + (size_t)tok * DM + i * 512 + F.lane * 8);
            float o[32];
#pragma unroll
            for (int e = 0; e < 32; ++e) o[e] = 0.f;
            for (int e0 = 0; e0 < 128; e0 += 2) {
                const int id0 = __builtin_amdgcn_readfirstlane(esel[tl * 128 + e0]), id1 = __builtin_amdgcn_readfirstlane(esel[tl * 128 + e0 + 1]);
                const float g0 = ew[tl * 128 + e0], g1 = ew[tl * 128 + e0 + 1];
                v4u u0[4], u1[4], w0[4], w1[4];
#pragma unroll
                for (int i = 0; i < 4; ++i) { u0[i] = *(const GAS v4u*)(PU + (size_t)id0 * DM + i * 512 + F.lane * 8); u1[i] = *(const GAS v4u*)(PU + (size_t)id1 * DM + i * 512 + F.lane * 8); }
#pragma unroll
                for (int i = 0; i < 4; ++i) { w0[i] = *(const GAS v4u*)(PV + (size_t)id0 * DM + i * 512 + F.lane * 8); w1[i] = *(const GAS v4u*)(PV + (size_t)id1 * DM + i * 512 + F.lane * 8); }
                float d0 = 0.f, d1 = 0.f;
#pragma unroll
                for (int i = 0; i < 4; ++i) {
                    d0 = DOT2(xp[i].x, u0[i].x, d0); d0 = DOT2(xp[i].y, u0[i].y, d0); d0 = DOT2(xp[i].z, u0[i].z, d0); d0 = DOT2(xp[i].w, u0[i].w, d0);
                    d1 = DOT2(xp[i].x, u1[i].x, d1); d1 = DOT2(xp[i].y, u1[i].y, d1); d1 = DOT2(xp[i].z, u1[i].z, d1); d1 = DOT2(xp[i].w, u1[i].w, d1); }
                d0 = wave_sum(d0); d1 = wave_sum(d1);
                const float a0 = g0 * gelu_tanh(d0), a1 = g1 * gelu_tanh(d1);
#pragma unroll
                for (int i = 0; i < 4; ++i) {
                    o[8 * i + 0] += a0 * bflo(w0[i].x) + a1 * bflo(w1[i].x); o[8 * i + 1] += a0 * bfhi(w0[i].x) + a1 * bfhi(w1[i].x);
                    o[8 * i + 2] += a0 * bflo(w0[i].y) + a1 * bflo(w1[i].y); o[8 * i + 3] += a0 * bfhi(w0[i].y) + a1 * bfhi(w1[i].y);
                    o[8 * i + 4] += a0 * bflo(w0[i].z) + a1 * bflo(w1[i].z); o[8 * i + 5] += a0 * bfhi(w0[i].z) + a1 * bfhi(w1[i].z);
                    o[8 * i + 6] += a0 * bflo(w0[i].w) + a1 * bflo(w1[i].w); o[8 * i + 7] += a0 * bfhi(w0[i].w) + a1 * bfhi(w1[i].w); }
            }
#pragma unroll
            for (int i = 0; i < 4; ++i) { const size_t off = (size_t)tok * DM + i * 512 + F.lane * 8;
                const f32x4 ha = *(const GAS f32x4*)(h1f + off), hb = *(const GAS f32x4*)(h1f + off + 4);
#if DBG_PEER_X2
#pragma unroll
                for (int e = 0; e < 8; ++e) o[8 * i + e] *= 2.f;
#endif
#if DBG_NO_PEER
#pragma unroll
                for (int e = 0; e < 8; ++e) o[8 * i + e] = 0.f;
#endif
                f32x4 ra, rbv;
                ra.x = ALPHA * ha.x + o[8 * i + 0]; ra.y = ALPHA * ha.y + o[8 * i + 1]; ra.z = ALPHA * ha.z + o[8 * i + 2]; ra.w = ALPHA * ha.w + o[8 * i + 3];
                rbv.x = ALPHA * hb.x + o[8 * i + 4]; rbv.y = ALPHA * hb.y + o[8 * i + 5]; rbv.z = ALPHA * hb.z + o[8 * i + 6]; rbv.w = ALPHA * hb.w + o[8 * i + 7];
                *(GAS f32x4*)(rf + off) = ra; *(GAS f32x4*)(rf + off + 4) = rbv;
                v4u w; w.x = pk2(ra.x, ra.y); w.y = pk2(ra.z, ra.w); w.z = pk2(rbv.x, rbv.y); w.w = pk2(rbv.z, rbv.w);
                *(GAS v4u*)(rb + off) = w; }
        }
    }
#endif
    __syncthreads();
}

struct Args { const float* in[24]; float* out; unsigned char* ws; int ph_lo, ph_hi; };
constexpr int N_PHASES = 11;

__global__ void __launch_bounds__(NTHREADS, 2) mega_fwd(Args args) {
    extern __shared__ __attribute__((aligned(16))) unsigned char lds_raw[];
    const int lo = args.ph_lo, hi = args.ph_hi;
#if MK_COOP
    cg::grid_group grid = cg::this_grid();
    if (threadIdx.x < 2) ((LAS unsigned*)(lds_raw + LDS_BARST))[threadIdx.x] = 0u;
    __syncthreads();
    XcdBarrier xbar = xcd_barrier_post((unsigned*)(args.ws + WS_CTL) + 1024, (volatile LAS unsigned*)((LAS unsigned char*)lds_raw + LDS_BARST));
    int nbar_ = 0;
#if DBG_ALL_CG
#define GRID_BAR() grid.sync()
#else
#define GRID_BAR() do { if (nbar_++ == 0) grid.sync(); else xcd_barrier(xbar); } while (0)
#endif
#else
#define GRID_BAR() do {} while (0)
#endif
#define IN(k) (lo <= (k) && (k) < hi)
#define NREP(k) ((k) == DBG_REP_PHASE ? 2 : 1)
#define BOTH(k) (IN(k) && IN((k) + 1))

    if (IN(0)) for (int rep_ = 0; rep_ < NREP(0); ++rep_) { if (rep_) GRID_BAR(); MAKE_FRAME(F); p0_prologue(F); if (BOTH(0) && rep_ + 1 == NREP(0)) GRID_BAR(); }

    if (IN(1)) for (int rep_ = 0; rep_ < NREP(1); ++rep_) {
        if (rep_) GRID_BAR();
        MAKE_FRAME(F); unsigned char* ws = F.ws; LAS unsigned char* glds = F.lds;
        pg8::Gemm g{(const bf16*)(ws + WS_HB), (const bf16*)(ws + WS_WIN), SEQ, INW_PAD, DM}; asm volatile("" : "+s"(g.K), "+s"(g.N), "+s"(g.M)); pg8::StaticOrder S; S.init(SEQ, INW_PAD, F.G, F.bid);
        pg8::EpiWin E{(bf16*)(ws + WS_Q), (bf16*)(ws + WS_KV), (bf16*)(ws + WS_QI), (bf16*)(ws + WS_GU), (bf16*)(ws + WS_GV), (bf16*)(ws + WS_GA), (bf16*)(ws + WS_GG), (bf16*)(ws + WS_KIWI)};
        pg8::gemm_phase<pg8::EpiWin, pg8::StaticOrder, true, true>(glds, g, S, E);
        if (BOTH(1) && rep_ + 1 == NREP(1)) GRID_BAR();
    }

    if (IN(2)) for (int rep_ = 0; rep_ < NREP(2); ++rep_) {
        if (rep_) GRID_BAR();
        MAKE_FRAME(F); unsigned char* ws = F.ws; LAS unsigned char* glds = F.lds;
        for (int u = F.bid; u < 512; u += F.G) gmlp_unit(F, u);
#pragma unroll 1
        for (int k = F.bid, i = 0; k < 512; k += F.G, ++i) idx_unit(F, (F.G == 256 && i == 1) ? 511 - F.bid : k);
        if (BOTH(2) && rep_ + 1 == NREP(2)) GRID_BAR();
    }

    if (IN(3)) for (int rep_ = 0; rep_ < NREP(3); ++rep_) {
        if (rep_) GRID_BAR();
        MAKE_FRAME(F);
#pragma unroll 1
        for (int u = F.bid; u < 256; u += F.G) { const int head = u & 7, pair = u >> 3;
#pragma unroll 1
            for (int i = 0; i < 2; ++i) attn_unit(F, i ? 63 - pair : pair, head); }
        if (BOTH(3) && rep_ + 1 == NREP(3)) GRID_BAR();
    }

    if (IN(4)) for (int rep_ = 0; rep_ < NREP(4); ++rep_) {
        if (rep_) GRID_BAR();
        MAKE_FRAME(F); unsigned char* ws = F.ws; LAS unsigned char* glds = F.lds;
        { pg8::Gemm g{(const bf16*)(ws + WS_ATT), (const bf16*)(ws + WS_WA), SEQ, DM, AW}; asm volatile("" : "+s"(g.K), "+s"(g.N), "+s"(g.M)); pg8::StaticOrder S; S.init(SEQ, DM, F.G, F.bid);
          pg8::EpiGateF32 E{(const bf16*)(ws + WS_GA), (float*)(ws + WS_T), DM};
          pg8::gemm_phase<pg8::EpiGateF32, pg8::StaticOrder, true, true>(glds, g, S, E); }
        __syncthreads();
        { pg8::Gemm g{(const bf16*)(ws + WS_GM), (const bf16*)(ws + WS_WG), SEQ, DM, GW}; asm volatile("" : "+s"(g.K), "+s"(g.N), "+s"(g.M)); pg8::StaticOrder S; S.init(SEQ, DM, F.G, F.bid);
          pg8::EpiMerge E{(const bf16*)(ws + WS_GG), (const float*)(ws + WS_T), (bf16*)(ws + WS_MERGED), DM};
          pg8::gemm_phase<pg8::EpiMerge, pg8::StaticOrder, true, true>(glds, g, S, E); }
        if (BOTH(4) && rep_ + 1 == NREP(4)) GRID_BAR();
    }

    if (IN(5)) for (int rep_ = 0; rep_ < NREP(5); ++rep_) {
        if (rep_) GRID_BAR();
        MAKE_FRAME(F); unsigned char* ws = F.ws; LAS unsigned char* glds = F.lds;
        pg8::Gemm g{(const bf16*)(ws + WS_MERGED), (const bf16*)(ws + WS_WMIX), SEQ, DM, DM}; asm volatile("" : "+s"(g.K), "+s"(g.N), "+s"(g.M)); pg8::StaticOrder S; S.init(SEQ, DM, F.G, F.bid);
        pg8::EpiMix E{F.in(0), (const float*)(ws + WS_STATS), F.in(3), F.in(4), F.out, DM};
        pg8::gemm_phase<pg8::EpiMix, pg8::StaticOrder, true, true>(glds, g, S, E);
        if (BOTH(5) && rep_ + 1 == NREP(5)) GRID_BAR();
    }

    if (IN(6)) for (int rep_ = 0; rep_ < NREP(6); ++rep_) {
        if (rep_) GRID_BAR();
        MAKE_FRAME(F); unsigned char* ws = F.ws; LAS unsigned char* glds = F.lds;
        const int gw = F.bid * NWAVES + F.wave, NGW = F.G * NWAVES;
        for (int m = gw; m < SEQ; m += NGW) ln_row(F, F.out + (size_t)m * DM, F.in(14), F.in(15), (bf16*)(ws + WS_H1B) + (size_t)m * DM, (float*)(ws + WS_H1F) + (size_t)m * DM, nullptr);
        if (BOTH(6) && rep_ + 1 == NREP(6)) GRID_BAR();
    }

    if (IN(7)) for (int rep_ = 0; rep_ < NREP(7); ++rep_) {
        if (rep_) GRID_BAR();
        MAKE_FRAME(F); unsigned char* ws = F.ws; LAS unsigned char* glds = F.lds;
        pg8::Gemm g{(const bf16*)(ws + WS_H1B), (const bf16*)(ws + WS_WQ), SEQ, DM, DM}; asm volatile("" : "+s"(g.K), "+s"(g.N), "+s"(g.M)); pg8::StaticOrder S; S.init(SEQ, DM, F.G, F.bid);
        pg8::EpiBf16<0> E{(bf16*)(ws + WS_PQ), DM, nullptr, 0, 0, 1.f};
        pg8::gemm_phase<pg8::EpiBf16<0>, pg8::StaticOrder, true, true>(glds, g, S, E);
        if (BOTH(7) && rep_ + 1 == NREP(7)) GRID_BAR();
    }

    if (IN(8)) for (int rep_ = 0; rep_ < NREP(8); ++rep_) {
        if (rep_) GRID_BAR();
        MAKE_FRAME(F); unsigned char* ws = F.ws; LAS unsigned char* glds = F.lds;
        for (int u = F.bid; u < SEQ / 32; u += F.G) peer_unit(F, u);
        if (BOTH(8) && rep_ + 1 == NREP(8)) GRID_BAR();
    }

    if (IN(9)) for (int rep_ = 0; rep_ < NREP(9); ++rep_) {
        if (rep_) GRID_BAR();
        MAKE_FRAME(F); unsigned char* ws = F.ws; LAS unsigned char* glds = F.lds;
        { pg8::Gemm g{(const bf16*)(ws + WS_PB), (const bf16*)(ws + WS_WPP), SEQ, DM, PLE}; asm volatile("" : "+s"(g.K), "+s"(g.N), "+s"(g.M)); pg8::StaticOrder S; S.init(SEQ, DM, F.G, F.bid);
          pg8::EpiF32 E{(float*)(ws + WS_T2), DM};
          pg8::gemm_phase<pg8::EpiF32, pg8::StaticOrder, true, true>(glds, g, S, E); }
        __syncthreads();
        { pg8::Gemm g{(const bf16*)(ws + WS_RB), (const bf16*)(ws + WS_WPG), SEQ, DM, DM}; asm volatile("" : "+s"(g.K), "+s"(g.N), "+s"(g.M)); pg8::StaticOrder S; S.init(SEQ, DM, F.G, F.bid);
          pg8::EpiPle E{(const float*)(ws + WS_RF), (const float*)(ws + WS_T2), F.out, DM};
          pg8::gemm_phase<pg8::EpiPle, pg8::StaticOrder, true, true>(glds, g, S, E); }
        if (BOTH(9) && rep_ + 1 == NREP(9)) GRID_BAR();
    }

    if (IN(10)) for (int rep_ = 0; rep_ < NREP(10); ++rep_) {
        if (rep_) GRID_BAR();
        MAKE_FRAME(F); unsigned char* ws = F.ws; LAS unsigned char* glds = F.lds;
        const int gw = F.bid * NWAVES + F.wave, NGW = F.G * NWAVES;
        for (int m = gw; m < SEQ; m += NGW) ln_row(F, F.out + (size_t)m * DM, F.in(22), F.in(23), nullptr, F.out + (size_t)m * DM, nullptr);
    }
}

extern "C" void kernel_launch(void* const* d_in, const int* in_sizes, int n_in, void* d_out, int out_size, void* d_ws, size_t ws_size, hipStream_t stream) {
    static int grid = 0;
    if (grid == 0) {
        if (n_in != 24 || out_size != SEQ * DM || ws_size < WS_END) { fprintf(stderr, "kernel_launch: unexpected problem: n_in %d out %d ws %zu (need %zu)\n", n_in, out_size, ws_size, (size_t)WS_END); grid = -1; return; }
        int dev = 0, cus = 0, per_cu = 0;
        if (hipGetDevice(&dev) != hipSuccess || hipDeviceGetAttribute(&cus, hipDeviceAttributeMultiprocessorCount, dev) != hipSuccess) { grid = -1; return; }
        if (hipFuncSetAttribute((const void*)mega_fwd, hipFuncAttributeMaxDynamicSharedMemorySize, LDS_BYTES) != hipSuccess) { fprintf(stderr, "kernel_launch: hipFuncSetAttribute failed\n"); grid = -1; return; }
        if (hipOccupancyMaxActiveBlocksPerMultiprocessor(&per_cu, (const void*)mega_fwd, NTHREADS, LDS_BYTES) != hipSuccess || per_cu < 1) { fprintf(stderr, "kernel_launch: occupancy query says %d blocks per CU\n", per_cu); (void)hipGetLastError(); grid = -1; return; }
        grid = cus;
        fprintf(stderr, "kernel_launch: grid %d (per_cu %d), ws %zu\n", grid, per_cu, ws_size);
    }
    if (grid < 0) return;
    if (hipMemsetAsync((char*)d_ws + WS_CTL, 0, CTL_ZERO_BYTES, stream) != hipSuccess) { fprintf(stderr, "kernel_launch: memset of the barrier words failed\n"); return; }
    Args a{};
    for (int i = 0; i < 24; ++i) a.in[i] = (const float*)d_in[i];
    a.out = (float*)d_out; a.ws = (unsigned char*)d_ws;
#if MK_COOP
    a.ph_lo = 0; a.ph_hi = N_PHASES;
    void* kargs[] = {&a};
    hipError_t e = hipLaunchCooperativeKernel((const void*)mega_fwd, dim3(grid), dim3(NTHREADS), kargs, LDS_BYTES, stream);
    if (e != hipSuccess) fprintf(stderr, "kernel_launch: cooperative launch failed: %s\n", hipGetErrorString(e));
#else
    for (int ph = 0; ph < N_PHASES; ++ph) { a.ph_lo = ph; a.ph_hi = ph + 1; hipLaunchKernelGGL(mega_fwd, dim3(grid), dim3(NTHREADS), LDS_BYTES, stream, a); }
#endif
}
```

```cpp
#include <hip/hip_runtime.h>
#include <hip/hip_cooperative_groups.h>
#include <cstdio>
#include <cstdint>
namespace cg = cooperative_groups;
#ifndef MK_COOP
#define MK_COOP 1
#endif
#define DBG_NO_ATTN 0
#define DBG_ATTN_X2 0
#define DBG_PEER_X2 0
#define DBG_NO_PEER 0
#define DBG_NO_GMLP 0
#define DBG_GMLP_X2 0
#define DBG_PLE_S 1.0f
#define DBG_MIX_S 1.0f
#define DBG_ATTN_HI_S 1.0f
#define DBG_LOGIT_S 1.0f
#define DBG_NO_BIAS 0
#define DBG_REP_PHASE -1
#define DBG_REP_SUB 0
#define DBG_ALL_CG 0
#define DBG_PEER_NEXP 128
namespace pg8 {
#define PG8_LAS __attribute__((address_space(3)))
typedef unsigned short bf16_t;
typedef short bf16x8 __attribute__((ext_vector_type(8)));
typedef float f32x4 __attribute__((ext_vector_type(4)));
typedef unsigned u32x4 __attribute__((ext_vector_type(4)));
constexpr int BM = 256, BK = 64, HALF = 128, HTB = HALF * BK * 2  , STAGE_BYTES = 8 * HTB, NXCD = 8, WGM = 8;

__host__ __device__ __forceinline__ int lds_byte(int r, int c) { const int st = (r >> 4) * 2 + (c >> 5), rr = r & 15, cc = c & 31, ob = rr * 64 + cc * 2; return st * 1024 + (ob ^ (((ob >> 9) & 1) << 5)); }
__host__ __device__ __forceinline__ void stage_rc(int b, int& R, int& C) { const int st = b / 1024, sb = b % 1024, swz = sb ^ (((sb >> 9) & 1) << 5); R = (st >> 1) * 16 + swz / 64; C = (st & 1) * 32 + (swz % 64) / 2; }
__host__ __device__ __forceinline__ int perm32(int rho) { const int n = rho >> 4, i = rho & 15; return 8 * (i >> 2) + 4 * n + (i & 3); }

struct Unit { int pm, pn; };
struct Gemm { const bf16_t* A; const bf16_t* Bt; int M, N, K; };

struct StaticOrder {
    int nM, nN, nwg, G, c;
    __host__ __device__ void init(int M, int N, int G_, int c_) { nM = M / BM; nN = N / BM; nwg = nM * nN; G = G_; c = c_; }
    __host__ __device__ bool next(int i, Unit& u) const {
        const long L = (long)i * G + c; if (L >= nwg) return false;
        int wgid = (int)L; { const int q = nwg / NXCD, r = nwg % NXCD, xcd = wgid % NXCD, off = wgid / NXCD; wgid = (xcd < r ? xcd * (q + 1) : r * (q + 1) + (xcd - r) * q) + off; }
        const int nig = WGM * nN, gid = wgid / nig, fm = gid * WGM, gsz = (nM - fm) < WGM ? (nM - fm) : WGM;
        u.pm = fm + ((wgid % nig) % gsz); u.pn = (wgid % nig) / gsz; return true;
    }
    __device__ __forceinline__ void a_ready(const Unit&) const {}
    __device__ __forceinline__ void done(const Unit&) const {}
};

__device__ __forceinline__ unsigned cvt_pk_bf16(float lo, float hi) { unsigned r; asm volatile("v_cvt_pk_bf16_f32 %0, %1, %2" : "=v"(r) : "v"(lo), "v"(hi)); return r; }
typedef float f32x2 __attribute__((ext_vector_type(2)));
__device__ __forceinline__ f32x2 gelu_pk(f32x2 v) {
    const f32x2 av = __builtin_elementwise_abs(v), d = av * 0.2316418882f + 1.0f;
    f32x2 t; t.x = __builtin_amdgcn_rcpf(d.x); t.y = __builtin_amdgcn_rcpf(d.y);
    f32x2 q = t * 0.5307027145f + (-0.7265760135f); q = q * t + 0.7107068705f; q = q * t + (-0.142248368f); q = q * t + 0.127414796f; q = q * t;
    const f32x2 s = (v * v) * (-0.72134752044f);
    f32x2 e; e.x = __builtin_amdgcn_exp2f(s.x); e.y = __builtin_amdgcn_exp2f(s.y);
    const f32x2 m = v * (q * e), r = v - m;
    f32x2 o; o.x = v.x < 0.f ? m.x : r.x; o.y = v.y < 0.f ? m.y : r.y; return o;
}

template <int ACT  > struct EpiBf16 {
    static constexpr bool PERM = true, AFTER_DRAIN = false; static_assert(ACT == 0 || ACT == 1, "EpiBf16: ACT is 0 (none) or 1 (gelu_pk)");
    bf16_t* O; int ldc; const float* bias; int split_cols; size_t split_stride; float scale0;
    __device__ __forceinline__ void operator()(const f32x4 (&acc)[2][2][4][2], const Unit& u, int wr, int wc, int fr, int fq) const {
        const int row0 = u.pm * BM + wr * 64 + fr; int colt = u.pn * BM; bf16_t* base = O;
        float sc = 1.f; if (split_cols) { const int t = colt / split_cols; base += (size_t)t * split_stride; colt -= t * split_cols; if (t == 0) sc = scale0; }
        const int col0 = colt + wc * 32 + 8 * fq, bcol0 = u.pn * BM + wc * 32 + 8 * fq;
        f32x4 bv[2][2];
#pragma unroll
        for (int bj = 0; bj < 2; ++bj)
#pragma unroll
            for (int n = 0; n < 2; ++n) bv[bj][n] = bias ? *(const f32x4*)(bias + bcol0 + bj * HALF + 4 * n) : (f32x4){0.f, 0.f, 0.f, 0.f};
#pragma unroll
        for (int ai = 0; ai < 2; ++ai)
#pragma unroll
            for (int m = 0; m < 4; ++m) { bf16_t* rowp = base + (size_t)(row0 + ai * HALF + m * 16) * ldc + col0;
#pragma unroll
                for (int bj = 0; bj < 2; ++bj) { f32x4 v0 = acc[ai][bj][m][0] + bv[bj][0], v1 = acc[ai][bj][m][1] + bv[bj][1];
                    if (ACT == 1) { f32x2 a = gelu_pk((f32x2){v0[0], v0[1]}), b = gelu_pk((f32x2){v0[2], v0[3]}), c = gelu_pk((f32x2){v1[0], v1[1]}), d = gelu_pk((f32x2){v1[2], v1[3]});
                        v0 = (f32x4){a.x, a.y, b.x, b.y}; v1 = (f32x4){c.x, c.y, d.x, d.y}; }
                    v0 = v0 * sc; v1 = v1 * sc; u32x4 w; w.x = cvt_pk_bf16(v0[0], v0[1]); w.y = cvt_pk_bf16(v0[2], v0[3]); w.z = cvt_pk_bf16(v1[0], v1[1]); w.w = cvt_pk_bf16(v1[2], v1[3]);
                    *(u32x4*)(rowp + bj * HALF) = w; } }
    }
};
template <class Epi, class Sched, bool ALIGN_EPI = false, bool SP2 = false>
__device__ __forceinline__ void gemm_phase(PG8_LAS unsigned char* lds, const Gemm g, const Sched& S, const Epi& E) {
    const int tid = threadIdx.x, wid = __builtin_amdgcn_readfirstlane(tid >> 6), lane = tid & 63, wr = wid >> 2, wc = wid & 3, fr = lane & 15, fq = lane >> 4;
    const int K = g.K, nt = K / BK;
    unsigned voffA[2], voffB[2];
#pragma unroll
    for (int i = 0; i < 2; ++i) { int R, C; stage_rc(tid * 16 + i * 8192, R, C); const int Rb = Epi::PERM ? ((R & ~31) + perm32(R & 31)) : R;
        voffA[i] = (unsigned)(R * K + C) * 2u; voffB[i] = (unsigned)(Rb * K + C) * 2u; }
    const size_t kstep = (size_t)(BK * 2);
    const size_t hstep = (size_t)HALF * K * 2;
    const size_t tstep = 2 * hstep;
    const unsigned ldsw = (unsigned)wid * 1024u;
    const int aoff = lds_byte(wr * 64 + fr, fq * 8), boff = lds_byte(wc * 32 + fr, fq * 8);
#define PG8_SA(b, h) (((b) * 2 + (h)) * HTB)
#define PG8_SB(b, h) ((4 + (b) * 2 + (h)) * HTB)
#define PG8_STAGE(bufoff, gbase, voff) do { _Pragma("unroll") for (int _i = 0; _i < 2; ++_i) \
        __builtin_amdgcn_global_load_lds((const unsigned*)((const char*)(gbase) + (voff)[_i]), (PG8_LAS unsigned*)(lds + (bufoff) + ldsw + _i * 8192), 16, 0, 0); } while (0)
#define PG8_LDA(dst, b, h) do { _Pragma("unroll") for (int m = 0; m < 4; ++m) _Pragma("unroll") for (int k = 0; k < 2; ++k) dst[m][k] = *(const PG8_LAS bf16x8*)(lds + PG8_SA(b, h) + aoff + m * 2048 + k * 1024); } while (0)
#define PG8_LDB(dst, b, h) do { _Pragma("unroll") for (int n = 0; n < 2; ++n) _Pragma("unroll") for (int k = 0; k < 2; ++k) dst[n][k] = *(const PG8_LAS bf16x8*)(lds + PG8_SB(b, h) + boff + n * 2048 + k * 1024); } while (0)
#define PG8_MMA(ai, bj, At, Bt) do { __builtin_amdgcn_s_setprio(1); _Pragma("unroll") for (int m = 0; m < 4; ++m) _Pragma("unroll") for (int n = 0; n < 2; ++n) _Pragma("unroll") for (int k = 0; k < 2; ++k) \
        acc[ai][bj][m][n] = __builtin_amdgcn_mfma_f32_16x16x32_bf16(Bt[n][k], At[m][k], acc[ai][bj][m][n], 0, 0, 0); __builtin_amdgcn_s_setprio(0); } while (0)
#define PG8_WAIT_V(n) asm volatile("s_waitcnt vmcnt(" #n ")" ::: "memory")
#define PG8_WAIT_L(n) asm volatile("s_waitcnt lgkmcnt(" #n ")" ::: "memory")
#define PG8_BAR __builtin_amdgcn_s_barrier()
#define PG8_SCHED __builtin_amdgcn_sched_barrier(0)
    Unit cur, nxt; int ui = 0;
    if (!S.next(0, cur)) return;
    f32x4 acc[2][2][4][2];
#pragma unroll
    for (int a = 0; a < 2; ++a)
#pragma unroll
        for (int b = 0; b < 2; ++b)
#pragma unroll
            for (int m = 0; m < 4; ++m)
#pragma unroll
                for (int n = 0; n < 2; ++n) acc[a][b][m][n] = (f32x4){0.f, 0.f, 0.f, 0.f};
    bf16x8 At[4][2], B0[2][2], B1[2][2];
    const char* cA = (const char*)g.A + (size_t)cur.pm * tstep; const char* cB = (const char*)g.Bt + (size_t)cur.pn * tstep;
    S.a_ready(cur);
    if constexpr (SP2) {
        PG8_STAGE(PG8_SB(0, 0), cB, voffB); PG8_STAGE(PG8_SB(0, 1), cB + hstep, voffB); PG8_STAGE(PG8_SA(0, 0), cA, voffA); PG8_STAGE(PG8_SA(0, 1), cA + hstep, voffA);
        if (wr == 1) PG8_BAR;
        PG8_WAIT_V(2); PG8_BAR;
        PG8_STAGE(PG8_SB(1, 0), cB + kstep, voffB); PG8_STAGE(PG8_SA(1, 0), cA + kstep, voffA); PG8_STAGE(PG8_SB(1, 1), cB + hstep + kstep, voffB);
        PG8_WAIT_V(6); PG8_BAR;
    } else {
        PG8_STAGE(PG8_SB(0, 0), cB, voffB); PG8_STAGE(PG8_SA(0, 0), cA, voffA); PG8_STAGE(PG8_SB(0, 1), cB + hstep, voffB); PG8_STAGE(PG8_SA(0, 1), cA + hstep, voffA);
        if (wr == 1) PG8_BAR;
        PG8_WAIT_V(4); PG8_BAR;
        PG8_STAGE(PG8_SB(1, 0), cB + kstep, voffB); PG8_STAGE(PG8_SA(1, 0), cA + kstep, voffA); PG8_STAGE(PG8_SB(1, 1), cB + hstep + kstep, voffB);
        PG8_WAIT_V(6); PG8_BAR;
    }
    for (;;) {
        const bool has_next = S.next(ui + 1, nxt);
        const char* nA = has_next ? (const char*)g.A + (size_t)nxt.pm * tstep : cA; const char* nB = has_next ? (const char*)g.Bt + (size_t)nxt.pn * tstep : cB;
        for (int t = 0; t < nt; t += 2) {
            const bool last = (t == nt - 2);
            const char* a1 = cA + (size_t)(t + 1) * kstep;
            const char* a2 = last ? nA : cA + (size_t)(t + 2) * kstep; const char* b2 = last ? nB : cB + (size_t)(t + 2) * kstep;
            const char* a3 = a2 + kstep; const char* b3 = b2 + kstep;
            if (last && has_next) S.a_ready(nxt);
            if constexpr (SP2) {
            PG8_LDB(B0, 0, 0); PG8_LDB(B1, 0, 1); PG8_SCHED; PG8_LDA(At, 0, 0); PG8_STAGE(PG8_SA(1, 1), a1 + hstep, voffA);
            PG8_WAIT_V(8); PG8_WAIT_L(0); PG8_BAR; PG8_MMA(0, 0, At, B0); PG8_MMA(0, 1, At, B1); PG8_BAR; PG8_SCHED;
            PG8_LDA(At, 0, 1); PG8_STAGE(PG8_SB(0, 0), b2, voffB); PG8_STAGE(PG8_SB(0, 1), b2 + hstep, voffB); PG8_STAGE(PG8_SA(0, 0), a2, voffA);
            PG8_WAIT_V(8); PG8_WAIT_L(0); PG8_BAR; PG8_MMA(1, 0, At, B0); PG8_MMA(1, 1, At, B1); PG8_BAR; PG8_SCHED;
            PG8_LDB(B0, 1, 0); PG8_LDB(B1, 1, 1); PG8_SCHED; PG8_LDA(At, 1, 0); PG8_STAGE(PG8_SA(0, 1), a2 + hstep, voffA);
            PG8_WAIT_V(8); PG8_WAIT_L(0); PG8_BAR; PG8_MMA(0, 0, At, B0); PG8_MMA(0, 1, At, B1); PG8_BAR; PG8_SCHED;
            PG8_LDA(At, 1, 1); PG8_STAGE(PG8_SB(1, 0), b3, voffB); PG8_STAGE(PG8_SB(1, 1), b3 + hstep, voffB); PG8_STAGE(PG8_SA(1, 0), a3, voffA);
            PG8_WAIT_V(8); PG8_WAIT_L(0); PG8_BAR; PG8_MMA(1, 0, At, B0); PG8_MMA(1, 1, At, B1); PG8_BAR; PG8_SCHED;
            } else {
            PG8_LDB(B0, 0, 0); PG8_SCHED; PG8_LDA(At, 0, 0); PG8_STAGE(PG8_SA(1, 1), a1 + hstep, voffA);
            PG8_WAIT_L(8); PG8_BAR; PG8_WAIT_L(0); PG8_MMA(0, 0, At, B0); PG8_BAR; PG8_SCHED;
            PG8_LDB(B1, 0, 1); PG8_STAGE(PG8_SB(0, 0), b2, voffB);
            PG8_BAR; PG8_WAIT_L(0); PG8_MMA(0, 1, At, B1); PG8_BAR;
            PG8_LDA(At, 0, 1); PG8_STAGE(PG8_SA(0, 0), a2, voffA);
            PG8_BAR; PG8_WAIT_L(0); PG8_MMA(1, 0, At, B0); PG8_BAR; PG8_SCHED;
            PG8_STAGE(PG8_SB(0, 1), b2 + hstep, voffB);
            PG8_WAIT_V(6); PG8_BAR; PG8_MMA(1, 1, At, B1); PG8_BAR;
            PG8_LDB(B0, 1, 0); PG8_SCHED; PG8_LDA(At, 1, 0); PG8_STAGE(PG8_SA(0, 1), a2 + hstep, voffA);
            PG8_WAIT_L(8); PG8_BAR; PG8_WAIT_L(0); PG8_MMA(0, 0, At, B0); PG8_BAR; PG8_SCHED;
            PG8_LDB(B1, 1, 1); PG8_STAGE(PG8_SB(1, 0), b3, voffB);
            PG8_BAR; PG8_WAIT_L(0); PG8_MMA(0, 1, At, B1); PG8_BAR;
            PG8_LDA(At, 1, 1); PG8_STAGE(PG8_SA(1, 0), a3, voffA);
            PG8_BAR; PG8_WAIT_L(0); PG8_MMA(1, 0, At, B0); PG8_BAR; PG8_SCHED;
            PG8_STAGE(PG8_SB(1, 1), b3 + hstep, voffB);
            PG8_WAIT_V(6); PG8_BAR; PG8_MMA(1, 1, At, B1); PG8_BAR;
            }
        }
        if constexpr (ALIGN_EPI) { if (wr == 0) PG8_BAR; }
        if constexpr (!Epi::AFTER_DRAIN) { E(acc, cur, wr, wc, fr, fq); S.done(cur); }
        if (!has_next) break;
#pragma unroll
        for (int a = 0; a < 2; ++a)
#pragma unroll
            for (int b = 0; b < 2; ++b)
#pragma unroll
                for (int m = 0; m < 4; ++m)
#pragma unroll
                    for (int n = 0; n < 2; ++n) acc[a][b][m][n] = (f32x4){0.f, 0.f, 0.f, 0.f};
        cur = nxt; cA = nA; cB = nB; ++ui;
        if constexpr (ALIGN_EPI) { if (wr == 1) PG8_BAR; }
    }
    PG8_WAIT_V(0);
    if constexpr (!ALIGN_EPI) { if (wr == 0) PG8_BAR; }
    PG8_BAR;
    if constexpr (Epi::AFTER_DRAIN) { E.fused(acc, cur, wr, wc, fr, fq, lds, wid, lane); S.done(cur); }
#undef PG8_SA
#undef PG8_SB
#undef PG8_STAGE
#undef PG8_LDA
#undef PG8_LDB
#undef PG8_MMA
#undef PG8_WAIT_V
#undef PG8_WAIT_L
#undef PG8_BAR
#undef PG8_SCHED
}
}

constexpr int SEQ = 8192, DM = 2048, INW = 10320, INW_PAD = 10496;
constexpr int AW = 1024, NIH = 16, IHD = 64, TOPK = 256, GW = 1024;
constexpr int PE_H = 8, PE_NK = 128, PE_TOPK = 16, PE_NE = 16384, PLE = 256;
constexpr float LN_EPS = 1e-5f;
constexpr float ALPHA = 1.189207115002721f;
constexpr float QSCALE = 0.08838834764831845f * 1.4426950408889634f;
constexpr int NWAVES = 8, NTHREADS = 512;
constexpr int LDS_BYTES = 147456;
constexpr int LDS_BARST = LDS_BYTES - 64;

constexpr size_t MiB = 1u << 20;
constexpr size_t WS_CTL = 0, CTL_ZERO_BYTES = 65536;
constexpr size_t WS_WA = 1 * MiB, WS_WG = 5 * MiB, WS_WMIX = 9 * MiB, WS_WQ = 17 * MiB, WS_WPG = 25 * MiB, WS_WPP = 33 * MiB, WS_SUBK = 34 * MiB;
constexpr size_t WS_PU = 35 * MiB, WS_PV = 99 * MiB, WS_STATS = 163 * MiB;
constexpr size_t WS_WIN = 164 * MiB, WS_HB = 205 * MiB;
constexpr size_t WS_Q = 237 * MiB, WS_KV = 253 * MiB, WS_QI = 285 * MiB, WS_KIWI = 301 * MiB;
constexpr size_t WS_GU = 305 * MiB, WS_GV = 321 * MiB, WS_GA = 337 * MiB, WS_GG = 369 * MiB;
constexpr size_t WS_GM = 401 * MiB, WS_ATT = 417 * MiB, WS_SC = 433 * MiB, WS_PB = 497 * MiB;
constexpr size_t WS_T = 164 * MiB, WS_MERGED = 237 * MiB, WS_H1F = 269 * MiB, WS_H1B = 333 * MiB, WS_PQ = 365 * MiB;
constexpr size_t WS_RF = 164 * MiB, WS_RB = 228 * MiB, WS_T2 = 405 * MiB;
constexpr size_t WS_PSC = 163 * MiB + 131072;
constexpr size_t WS_MASK = 501 * MiB;
constexpr size_t WS_END = 512 * MiB;

#define GAS __attribute__((address_space(1)))
#define LAS __attribute__((address_space(3)))
typedef unsigned short bf16;
typedef unsigned v4u __attribute__((ext_vector_type(4)));
typedef unsigned v2u __attribute__((ext_vector_type(2)));
typedef float f32x4 __attribute__((ext_vector_type(4)));
typedef float f32x2 __attribute__((ext_vector_type(2)));
typedef float f32x16 __attribute__((ext_vector_type(16)));
typedef short bf16x8 __attribute__((ext_vector_type(8)));
typedef __attribute__((ext_vector_type(2))) __bf16 bf2v;
#define LDS_WAIT() asm volatile("s_waitcnt lgkmcnt(0)" ::: "memory")
#define VM_WAIT() asm volatile("s_waitcnt vmcnt(0)" ::: "memory")

__device__ __forceinline__ unsigned f2bf(float f) { unsigned u = __builtin_bit_cast(unsigned, f); return (u + 0x7fffu + ((u >> 16) & 1u)) >> 16; }
__device__ __forceinline__ unsigned pk2(float lo, float hi) { return f2bf(lo) | (f2bf(hi) << 16); }
__device__ __forceinline__ float bflo(unsigned u) { return __builtin_bit_cast(float, u << 16); }
__device__ __forceinline__ float bfhi(unsigned u) { return __builtin_bit_cast(float, u & 0xffff0000u); }
__device__ __forceinline__ float bf2f(bf16 h) { return __builtin_bit_cast(float, (unsigned)h << 16); }
__device__ __forceinline__ float fast_rcp(float x) { return __builtin_amdgcn_rcpf(x); }
__device__ __forceinline__ float sigmoidf_(float x) { return fast_rcp(1.f + __expf(-x)); }
__device__ __forceinline__ float gelu_tanh(float x) { const float u = 1.5957691216057308f * (x + 0.044715f * x * x * x); return x * fast_rcp(1.f + __expf(-u)); }
__device__ __forceinline__ float wave_sum(float v) {
#pragma unroll
    for (int o = 1; o < 64; o <<= 1) v += __shfl_xor(v, o);
    return v;
}
__device__ __forceinline__ float dot2bf(unsigned a, unsigned b, float c) { return __builtin_amdgcn_fdot2_f32_bf16(__builtin_bit_cast(bf2v, a), __builtin_bit_cast(bf2v, b), c, false); }
__device__ __forceinline__ unsigned sortable(float f) { const unsigned u = __builtin_bit_cast(unsigned, f); return (u & 0x80000000u) ? ~u : (u | 0x80000000u); }

typedef const __attribute__((address_space(4))) unsigned char* kargp_t;
__device__ __forceinline__ unsigned long long karg_u64(int byte_off) {
    kargp_t ka = (kargp_t)__builtin_amdgcn_kernarg_segment_ptr();
    asm volatile("" : "+s"(ka));
    return *(const __attribute__((address_space(4))) unsigned long long*)(ka + byte_off);
}
struct Frame {
    LAS unsigned char* lds;
    int tid, lane, wave, G, bid;
    float* out; unsigned char* ws;
    __device__ __forceinline__ const float* in(int k) const { return (const float*)karg_u64(8 * k); }
};
#define MAKE_FRAME(F) Frame F; { int t_ = threadIdx.x; asm volatile("" : "+v"(t_)); F.tid = t_; F.lane = t_ & 63; F.wave = __builtin_amdgcn_readfirstlane(t_ >> 6); \
    F.G = gridDim.x; F.bid = blockIdx.x; F.lds = (LAS unsigned char*)lds_raw; F.out = (float*)karg_u64(192); F.ws = (unsigned char*)karg_u64(200); }

__device__ __forceinline__ int win_dest(int n) { return n < 4096 ? n : (n < 4176 ? n + 6144 : n - 80); }
template <bool MAP>
__device__ __forceinline__ void p0_transpose_item(const float* W, int K, int N, bf16* WT, LAS float* scr, int item, int lane) {
    const int nblk = (N + 31) / 32, kb = item / nblk, nb = item % nblk, k0 = 64 * kb, n0 = 32 * nb;
    const int nn = n0 + (lane & 31); const bool ok = nn < N;
#pragma unroll 8
    for (int i = 0; i < 32; ++i) { const int kk = 2 * i + (lane >> 5); scr[kk * 33 + (lane & 31)] = ok ? W[(size_t)(k0 + kk) * N + nn] : 0.f; }
    LDS_WAIT(); asm volatile("" ::: "memory");
    const int c = lane & 7;
#pragma unroll
    for (int j = 0; j < 4; ++j) { const int n = (lane >> 3) + 8 * j; const LAS float* s = scr + (8 * c) * 33 + n;
        v4u o; o.x = pk2(s[0 * 33], s[1 * 33]); o.y = pk2(s[2 * 33], s[3 * 33]); o.z = pk2(s[4 * 33], s[5 * 33]); o.w = pk2(s[6 * 33], s[7 * 33]);
        if (n0 + n < N) { const int drow = MAP ? win_dest(n0 + n) : (n0 + n); *(GAS v4u*)(WT + (size_t)drow * K + k0 + 8 * c) = o; } }
    LDS_WAIT(); asm volatile("" ::: "memory");
}
__device__ __forceinline__ void p0_convert(Frame& F, const float* src, bf16* dst, size_t n) {
    const size_t nth = (size_t)F.G * NTHREADS, n8 = n / 8;
    for (size_t i = (size_t)F.bid * NTHREADS + F.tid; i < n8; i += nth) {
        const f32x4 a = ((const GAS f32x4*)src)[2 * i], b = ((const GAS f32x4*)src)[2 * i + 1];
        v4u o; o.x = pk2(a.x, a.y); o.y = pk2(a.z, a.w); o.z = pk2(b.x, b.y); o.w = pk2(b.z, b.w);
        ((GAS v4u*)dst)[i] = o; }
}
__device__ __forceinline__ void ln_row(Frame& F, const float* xrow, const float* g, const float* b, bf16* ob, float* of, float* stats) {
    const GAS f32x4* xr = (const GAS f32x4*)xrow + F.lane;
    f32x4 v[8]; float s = 0.f;
#pragma unroll
    for (int j = 0; j < 8; ++j) { v[j] = xr[64 * j]; s += (v[j].x + v[j].y) + (v[j].z + v[j].w); }
    const float mean = wave_sum(s) * (1.f / DM); float s2 = 0.f;
#pragma unroll
    for (int j = 0; j < 8; ++j) { v[j] = v[j] - mean; s2 += (v[j].x * v[j].x + v[j].y * v[j].y) + (v[j].z * v[j].z + v[j].w * v[j].w); }
    const float rstd = 1.f / sqrtf(wave_sum(s2) * (1.f / DM) + LN_EPS);
    if (stats && F.lane == 0) { stats[0] = mean; stats[1] = rstd; }
#pragma unroll
    for (int j = 0; j < 8; ++j) {
        const f32x4 gg = ((const GAS f32x4*)g)[64 * j + F.lane], bb = ((const GAS f32x4*)b)[64 * j + F.lane];
        const f32x4 y = v[j] * rstd * gg + bb;
        if (ob) { v2u o; o.x = pk2(y.x, y.y); o.y = pk2(y.z, y.w); ((GAS v2u*)ob)[64 * j + F.lane] = o; }
        if (of) ((GAS f32x4*)of)[64 * j + F.lane] = y;
    }
}
__device__ __forceinline__ void p0_prologue(Frame& F) {
    LAS float* scr = (LAS float*)(F.lds + F.wave * 16384);
    const int gw = F.bid * NWAVES + F.wave, NGW = F.G * NWAVES;
    unsigned char* ws = F.ws;
    constexpr int I_IN = (DM / 64) * ((INW + 31) / 32), I_A = (AW / 64) * (DM / 32), I_G = (GW / 64) * (DM / 32), I_SQ = (DM / 64) * (DM / 32), I_PP = (PLE / 64) * (DM / 32);
    constexpr int NITEMS = I_IN + I_A + I_G + 3 * I_SQ + I_PP;
    for (int it = gw; it < NITEMS; it += NGW) {
        int r = it;
        if (r < I_IN) { p0_transpose_item<true>(F.in(6), DM, INW, (bf16*)(ws + WS_WIN), scr, r, F.lane); continue; } r -= I_IN;
        if (r < I_A) { p0_transpose_item<false>(F.in(11), AW, DM, (bf16*)(ws + WS_WA), scr, r, F.lane); continue; } r -= I_A;
        if (r < I_G) { p0_transpose_item<false>(F.in(12), GW, DM, (bf16*)(ws + WS_WG), scr, r, F.lane); continue; } r -= I_G;
        if (r < I_SQ) { p0_transpose_item<false>(F.in(13), DM, DM, (bf16*)(ws + WS_WMIX), scr, r, F.lane); continue; } r -= I_SQ;
        if (r < I_SQ) { p0_transpose_item<false>(F.in(16), DM, DM, (bf16*)(ws + WS_WQ), scr, r, F.lane); continue; } r -= I_SQ;
        if (r < I_SQ) { p0_transpose_item<false>(F.in(21), DM, DM, (bf16*)(ws + WS_WPG), scr, r, F.lane); continue; } r -= I_SQ;
        p0_transpose_item<false>(F.in(20), PLE, DM, (bf16*)(ws + WS_WPP), scr, r, F.lane);
    }
    { const size_t n16 = (size_t)(INW_PAD - INW) * DM * 2 / 16; GAS v4u* z = (GAS v4u*)(ws + WS_WIN + (size_t)INW * DM * 2);
      for (size_t i = (size_t)F.bid * NTHREADS + F.tid; i < n16; i += (size_t)F.G * NTHREADS) z[i] = (v4u){0u, 0u, 0u, 0u}; }
    for (int row = gw; row < 2 * PE_NE; row += NGW) { const int tb = row >= PE_NE ? 1 : 0, r = row - tb * PE_NE;
        const GAS f32x4* src = (const GAS f32x4*)((tb ? F.in(19) : F.in(18)) + (size_t)r * DM) + F.lane;
        f32x4 v[8]; float mx = 0.f;
#pragma unroll
        for (int j = 0; j < 8; ++j) { v[j] = src[64 * j]; mx = fmaxf(mx, fmaxf(fmaxf(fabsf(v[j].x), fabsf(v[j].y)), fmaxf(fabsf(v[j].z), fabsf(v[j].w)))); }
#pragma unroll
        for (int o = 1; o < 64; o <<= 1) mx = fmaxf(mx, __shfl_xor(mx, o));
        float sc = 1.f;
        if (mx > 1e-30f) sc = __builtin_bit_cast(float, __builtin_bit_cast(unsigned, 224.f / mx) & 0x7f800000u);
        if (F.lane == 0) ((float*)(ws + WS_PSC))[row] = 1.f / sc;
        GAS unsigned* dst = (GAS unsigned*)(ws + (tb ? WS_PV : WS_PU) + (size_t)r * DM) + F.lane;
#pragma unroll
        for (int j = 0; j < 8; ++j) { int w = __builtin_amdgcn_cvt_pk_fp8_f32(v[j].x * sc, v[j].y * sc, 0, false); w = __builtin_amdgcn_cvt_pk_fp8_f32(v[j].z * sc, v[j].w * sc, w, true); dst[64 * j] = (unsigned)w; }
    }
    p0_convert(F, F.in(17), (bf16*)(ws + WS_SUBK), (size_t)PE_H * 2 * PE_NK * 128);
    p0_convert(F, F.in(1), (bf16*)(ws + WS_PB), (size_t)SEQ * PLE);
    for (int m = gw; m < SEQ; m += NGW) ln_row(F, F.in(0) + (size_t)m * DM, F.in(3), F.in(4), (bf16*)(ws + WS_HB) + (size_t)m * DM, nullptr, (float*)(ws + WS_STATS) + 2 * m);
}

typedef GAS unsigned gu32;
#define XB_TMO      128
#define XB_XCNT(j)  (256  + 64 * (j))
#define XB_XSUB(j)  (1280 + 64 * (j))
#define XB_XGEN(j)  (2304 + 64 * (j))
#define XB_TOP      3328
#define XB_TOPGEN   3392
#define XCD_BAR_WORDS 3456
#define XB_SPIN_CAP (1u << 18)

__device__ __forceinline__ unsigned xb_ld(unsigned* p)              { return __hip_atomic_load(p, __ATOMIC_RELAXED, __HIP_MEMORY_SCOPE_AGENT); }
__device__ __forceinline__ unsigned xb_add(unsigned* p, unsigned v) { return __hip_atomic_fetch_add(p, v, __ATOMIC_RELAXED, __HIP_MEMORY_SCOPE_AGENT); }
__device__ __forceinline__ unsigned xb_xcc_id() { return (unsigned)__builtin_amdgcn_s_getreg((3 << 11) | 20) & 0xFu; }
#define XB_SPIN(cond, bar) do { unsigned _sp = 0; while (cond) { __builtin_amdgcn_s_sleep(1); \
    if ((++_sp & 255u) == 0u) { if (xb_ld(&(bar)[XB_TMO])) break; if (_sp > XB_SPIN_CAP) { atomicAdd(&(bar)[XB_TMO], 1u); break; } } } } while (0)

struct XcdBarrier {
    unsigned* bar; unsigned x;
    volatile LAS unsigned* st;
};

__device__ __forceinline__ XcdBarrier xcd_barrier_post(unsigned* bar, volatile LAS unsigned* st) {
    XcdBarrier b; b.bar = bar; b.x = xb_xcc_id(); b.st = st;
    if (threadIdx.x == 0) (void)xb_add(&bar[XB_XCNT(b.x)], 1u);
    return b;
}
__device__ __forceinline__ void xcd_barrier_complete(unsigned* bar, unsigned x, unsigned& nloc, unsigned& nx) {
    const unsigned G = gridDim.x * gridDim.y * gridDim.z;
    unsigned sum, cnt, mine, sp = 0u;
    for (;;) {
        sum = 0u; cnt = 0u; mine = 0u;
#pragma unroll
        for (unsigned j = 0; j < 16; ++j) { const unsigned c = xb_ld(&bar[XB_XCNT(j)]); sum += c; cnt += (c > 0u) ? 1u : 0u; mine = (j == x) ? c : mine; }
        if (sum == G) break;
        __builtin_amdgcn_s_sleep(1);
        if ((++sp & 255u) == 0u) { if (xb_ld(&bar[XB_TMO])) break; if (sp > XB_SPIN_CAP) { atomicAdd(&bar[XB_TMO], 1u); break; } }
    }
    nloc = mine > 0u ? mine : 1u; nx = cnt > 0u ? cnt : 1u;
}

__device__ __forceinline__ void xcd_barrier(const XcdBarrier& b) {
    asm volatile("s_waitcnt vmcnt(0)" ::: "memory");
    __syncthreads();
    if (threadIdx.x == 0) {
        unsigned* bar = b.bar;
        __builtin_amdgcn_s_waitcnt(0);
        unsigned nloc = b.st[0], nx = b.st[1];
        if (nloc == 0u) { xcd_barrier_complete(bar, b.x, nloc, nx); b.st[0] = nloc; b.st[1] = nx; }
        const unsigned old = xb_add(&bar[XB_XSUB(b.x)], 1u);
        const unsigned gen = old / nloc;
        if (old + 1u == (gen + 1u) * nloc) {
            __builtin_amdgcn_fence(__ATOMIC_RELEASE, "agent");
            asm volatile("s_waitcnt vmcnt(0)" ::: "memory");
            const unsigned og = xb_add(&bar[XB_TOP], 1u);
            const unsigned tg = og / nx;
            if (og + 1u == (tg + 1u) * nx) xb_add(&bar[XB_TOPGEN], 1u);
            else XB_SPIN(xb_ld(&bar[XB_TOPGEN]) == tg, bar);
            __builtin_amdgcn_fence(__ATOMIC_ACQUIRE, "agent");
            xb_add(&bar[XB_XGEN(b.x)], 1u);
            asm volatile("s_waitcnt vmcnt(0)" ::: "memory");
        } else {
            XB_SPIN(xb_ld(&bar[XB_XGEN(b.x)]) == gen, bar);
            __builtin_amdgcn_fence(__ATOMIC_ACQUIRE, "agent");
            asm volatile("s_waitcnt vmcnt(0)" ::: "memory");
        }
    }
    __syncthreads();
}

namespace pg8 {
struct EpiWin {
    static constexpr bool PERM = true, AFTER_DRAIN = false;
    bf16 *q, *kv, *qi, *gu, *gv, *ga, *gg, *kiwi;
    __device__ __forceinline__ void operator()(const f32x4 (&acc)[2][2][4][2], const Unit& u, int wr, int wc, int fr, int fq) const {
        const int pn = u.pn; bf16* base; int ld, colt, act = 0; float sc = 1.f;
        if (pn < 4) { base = q; ld = 1024; colt = pn * 256; sc = QSCALE; }
        else if (pn < 12) { base = kv; ld = 2048; colt = (pn - 4) * 256; }
        else if (pn < 16) { base = qi; ld = 1024; colt = (pn - 12) * 256; }
        else if (pn < 20) { base = gu; ld = 1024; colt = (pn - 16) * 256; act = 1; }
        else if (pn < 24) { base = gv; ld = 1024; colt = (pn - 20) * 256; act = 1; }
        else if (pn < 32) { base = ga; ld = 2048; colt = (pn - 24) * 256; act = 2; }
        else if (pn < 40) { base = gg; ld = 2048; colt = (pn - 32) * 256; act = 2; }
        else { base = kiwi; ld = 256; colt = 0; }
        const int row0 = u.pm * BM + wr * 64 + fr, col0 = colt + wc * 32 + 8 * fq;
#pragma unroll
        for (int ai = 0; ai < 2; ++ai)
#pragma unroll
            for (int m = 0; m < 4; ++m) { bf16* rowp = base + (size_t)(row0 + ai * HALF + m * 16) * ld + col0;
#pragma unroll
                for (int bj = 0; bj < 2; ++bj) { f32x4 v0 = acc[ai][bj][m][0], v1 = acc[ai][bj][m][1];
                    if (act == 1) {
#pragma unroll
                        for (int e = 0; e < 4; ++e) { v0[e] = gelu_tanh(v0[e]); v1[e] = gelu_tanh(v1[e]); } }
                    else if (act == 2) {
#pragma unroll
                        for (int e = 0; e < 4; ++e) { v0[e] = sigmoidf_(v0[e]); v1[e] = sigmoidf_(v1[e]); } }
                    else { v0 = v0 * sc; v1 = v1 * sc; }
                    v4u w; w.x = pk2(v0[0], v0[1]); w.y = pk2(v0[2], v0[3]); w.z = pk2(v1[0], v1[1]); w.w = pk2(v1[2], v1[3]);
                    *(GAS v4u*)(rowp + bj * HALF) = w; } }
    }
};
struct EpiGateF32 {
    static constexpr bool PERM = true, AFTER_DRAIN = false;
    const bf16* gate; float* T; int ldc;
    __device__ __forceinline__ void operator()(const f32x4 (&acc)[2][2][4][2], const Unit& u, int wr, int wc, int fr, int fq) const {
        const int row0 = u.pm * BM + wr * 64 + fr, col0 = u.pn * BM + wc * 32 + 8 * fq;
#pragma unroll
        for (int ai = 0; ai < 2; ++ai)
#pragma unroll
            for (int m = 0; m < 4; ++m) { const size_t off = (size_t)(row0 + ai * HALF + m * 16) * ldc + col0;
#pragma unroll
                for (int bj = 0; bj < 2; ++bj) { const v4u g = *(const GAS v4u*)(gate + off + bj * HALF);
                    f32x4 v0 = acc[ai][bj][m][0], v1 = acc[ai][bj][m][1];
                    v0[0] *= bflo(g.x); v0[1] *= bfhi(g.x); v0[2] *= bflo(g.y); v0[3] *= bfhi(g.y);
                    v1[0] *= bflo(g.z); v1[1] *= bfhi(g.z); v1[2] *= bflo(g.w); v1[3] *= bfhi(g.w);
                    *(GAS f32x4*)(T + off + bj * HALF) = v0; *(GAS f32x4*)(T + off + bj * HALF + 4) = v1; } }
    }
};
struct EpiMerge {
    static constexpr bool PERM = true, AFTER_DRAIN = false;
    const bf16* gate; const float* T; bf16* O; int ldc;
    __device__ __forceinline__ void operator()(const f32x4 (&acc)[2][2][4][2], const Unit& u, int wr, int wc, int fr, int fq) const {
        const int row0 = u.pm * BM + wr * 64 + fr, col0 = u.pn * BM + wc * 32 + 8 * fq;
#pragma unroll
        for (int ai = 0; ai < 2; ++ai)
#pragma unroll
            for (int m = 0; m < 4; ++m) { const size_t off = (size_t)(row0 + ai * HALF + m * 16) * ldc + col0;
#pragma unroll
                for (int bj = 0; bj < 2; ++bj) { const v4u g = *(const GAS v4u*)(gate + off + bj * HALF);
                    const f32x4 t0 = *(const GAS f32x4*)(T + off + bj * HALF), t1 = *(const GAS f32x4*)(T + off + bj * HALF + 4);
                    f32x4 v0 = acc[ai][bj][m][0], v1 = acc[ai][bj][m][1];
                    v0[0] = t0[0] + v0[0] * bflo(g.x); v0[1] = t0[1] + v0[1] * bfhi(g.x); v0[2] = t0[2] + v0[2] * bflo(g.y); v0[3] = t0[3] + v0[3] * bfhi(g.y);
                    v1[0] = t1[0] + v1[0] * bflo(g.z); v1[1] = t1[1] + v1[1] * bfhi(g.z); v1[2] = t1[2] + v1[2] * bflo(g.w); v1[3] = t1[3] + v1[3] * bfhi(g.w);
                    v4u w; w.x = pk2(v0[0], v0[1]); w.y = pk2(v0[2], v0[3]); w.z = pk2(v1[0], v1[1]); w.w = pk2(v1[2], v1[3]);
                    *(GAS v4u*)(O + off + bj * HALF) = w; } }
    }
};
struct EpiMix {
    static constexpr bool PERM = false, AFTER_DRAIN = false;
    const float* x; const float* stats; const float* g; const float* b; float* Y; int ldc;
    __device__ __forceinline__ void operator()(const f32x4 (&acc)[2][2][4][2], const Unit& u, int wr, int wc, int fr, int fq) const {
        const int row0 = u.pm * BM + wr * 64 + fr, col0 = u.pn * BM + wc * 32 + 4 * fq;
        f32x4 gv[2][2], bv[2][2];
#pragma unroll
        for (int bj = 0; bj < 2; ++bj)
#pragma unroll
            for (int n = 0; n < 2; ++n) { gv[bj][n] = *(const GAS f32x4*)(g + col0 + bj * HALF + n * 16); bv[bj][n] = *(const GAS f32x4*)(b + col0 + bj * HALF + n * 16); }
#pragma unroll
        for (int ai = 0; ai < 2; ++ai)
#pragma unroll
            for (int m = 0; m < 4; ++m) { const int r = row0 + ai * HALF + m * 16; const size_t off = (size_t)r * ldc + col0;
                const float mean = stats[2 * r], rstd = stats[2 * r + 1];
#pragma unroll
                for (int bj = 0; bj < 2; ++bj)
#pragma unroll
                    for (int n = 0; n < 2; ++n) { const f32x4 xv = *(const GAS f32x4*)(x + off + bj * HALF + n * 16);
                        const f32x4 h = (xv - mean) * rstd * gv[bj][n] + bv[bj][n];
                        *(GAS f32x4*)(Y + off + bj * HALF + n * 16) = h * ALPHA + acc[ai][bj][m][n] * DBG_MIX_S; } }
    }
};
struct EpiF32 {
    static constexpr bool PERM = false, AFTER_DRAIN = false;
    float* Y; int ldc;
    __device__ __forceinline__ void operator()(const f32x4 (&acc)[2][2][4][2], const Unit& u, int wr, int wc, int fr, int fq) const {
        const int row0 = u.pm * BM + wr * 64 + fr, col0 = u.pn * BM + wc * 32 + 4 * fq;
#pragma unroll
        for (int ai = 0; ai < 2; ++ai)
#pragma unroll
            for (int m = 0; m < 4; ++m) { const size_t off = (size_t)(row0 + ai * HALF + m * 16) * ldc + col0;
#pragma unroll
                for (int bj = 0; bj < 2; ++bj)
#pragma unroll
                    for (int n = 0; n < 2; ++n) *(GAS f32x4*)(Y + off + bj * HALF + n * 16) = acc[ai][bj][m][n]; }
    }
};
struct EpiPle {
    static constexpr bool PERM = false, AFTER_DRAIN = false;
    const float* R; const float* T2; float* Y; int ldc;
    __device__ __forceinline__ void operator()(const f32x4 (&acc)[2][2][4][2], const Unit& u, int wr, int wc, int fr, int fq) const {
        const int row0 = u.pm * BM + wr * 64 + fr, col0 = u.pn * BM + wc * 32 + 4 * fq;
#pragma unroll
        for (int ai = 0; ai < 2; ++ai)
#pragma unroll
            for (int m = 0; m < 4; ++m) { const size_t off = (size_t)(row0 + ai * HALF + m * 16) * ldc + col0;
#pragma unroll
                for (int bj = 0; bj < 2; ++bj)
#pragma unroll
                    for (int n = 0; n < 2; ++n) { const f32x4 rv = *(const GAS f32x4*)(R + off + bj * HALF + n * 16), tv = *(const GAS f32x4*)(T2 + off + bj * HALF + n * 16);
                        const f32x4 a = acc[ai][bj][m][n]; f32x4 o;
#pragma unroll
                        for (int e = 0; e < 4; ++e) o[e] = rv[e] + DBG_PLE_S * sigmoidf_(a[e]) * tv[e];
                        *(GAS f32x4*)(Y + off + bj * HALF + n * 16) = o; } }
    }
};
}

__device__ __forceinline__ f32x16 mfma32(bf16x8 a, bf16x8 b, f32x16 c) { return __builtin_amdgcn_mfma_f32_32x32x16_bf16(a, b, c, 0, 0, 0); }
__device__ __forceinline__ void unpack8(const v4u a, float (&x)[8]) { x[0] = bflo(a.x); x[1] = bfhi(a.x); x[2] = bflo(a.y); x[3] = bfhi(a.y); x[4] = bflo(a.z); x[5] = bfhi(a.z); x[6] = bflo(a.w); x[7] = bfhi(a.w); }

__device__ __forceinline__ void gmlp_unit(Frame& F, int unit) {
    const int n = unit >> 3, g = unit & 7, row0 = n * 128;
    const bf16* gvb = (const bf16*)(F.ws + WS_GV); const bf16* gub = (const bf16*)(F.ws + WS_GU); bf16* gm = (bf16*)(F.ws + WS_GM);
    LAS float* st = (LAS float*)F.lds;
    LAS bf16* VT = (LAS bf16*)(F.lds + 1024);
    for (int i = 0; i < 16; ++i) { const int r = F.wave * 16 + i;
        const GAS v4u* rp = (const GAS v4u*)(gvb + (size_t)(row0 + r) * GW);
        const v4u a = rp[F.lane], b = rp[64 + F.lane];
        float x[16]; { float t0[8], t1[8]; unpack8(a, t0); unpack8(b, t1);
#pragma unroll
            for (int e = 0; e < 8; ++e) { x[e] = t0[e]; x[8 + e] = t1[e]; } }
        float s = 0.f;
#pragma unroll
        for (int e = 0; e < 16; ++e) s += x[e];
        const float mean = wave_sum(s) * (1.f / GW); float s2 = 0.f;
#pragma unroll
        for (int e = 0; e < 16; ++e) { const float d = x[e] - mean; s2 += d * d; }
        const float rstd = 1.f / sqrtf(wave_sum(s2) * (1.f / GW) + LN_EPS);
        if (F.lane == 0) { st[2 * r] = mean; st[2 * r + 1] = rstd; } }
    __syncthreads();
    const float* lg = F.in(7) + g * 128; const float* lb = F.in(8) + g * 128;
#pragma unroll
    for (int i = 0; i < 4; ++i) { const int id = F.tid + 512 * i, s = id >> 4, c8 = id & 15;
        const v4u a = *(const GAS v4u*)(gvb + (size_t)(row0 + s) * GW + g * 128 + c8 * 8);
        float x[8]; unpack8(a, x);
        const float mean = st[2 * s], rstd = st[2 * s + 1];
        const f32x4 g0 = *(const GAS f32x4*)(lg + c8 * 8), g1 = *(const GAS f32x4*)(lg + c8 * 8 + 4), b0 = *(const GAS f32x4*)(lb + c8 * 8), b1 = *(const GAS f32x4*)(lb + c8 * 8 + 4);
#pragma unroll
        for (int e = 0; e < 8; ++e) { const float gg = e < 4 ? g0[e & 3] : g1[e & 3], bb = e < 4 ? b0[e & 3] : b1[e & 3];
            VT[(c8 * 8 + e) * 136 + s] = (bf16)f2bf((x[e] - mean) * rstd * gg + bb); } }
    __syncthreads();
    const int r = F.lane & 31, hh = F.lane >> 5, tt = F.wave >> 1, ct0 = (F.wave & 1) * 2;
    f32x16 acc0, acc1;
#pragma unroll
    for (int e = 0; e < 16; ++e) { acc0[e] = 0.f; acc1[e] = 0.f; }
    const float* wsm = F.in(9) + (size_t)g * 128 * 128;
    const int t = tt * 32 + r;
    for (int ks = 0; ks < (tt + 1) * 2; ++ks) {
        const int k0 = ks * 16 + 8 * hh;
        const f32x4 w0 = *(const GAS f32x4*)(wsm + t * 128 + k0), w1 = *(const GAS f32x4*)(wsm + t * 128 + k0 + 4);
        float wv[8] = {w0.x, w0.y, w0.z, w0.w, w1.x, w1.y, w1.z, w1.w};
#pragma unroll
        for (int e = 0; e < 8; ++e) if (k0 + e > t) wv[e] = 0.f;
        v4u ap; ap.x = pk2(wv[0], wv[1]); ap.y = pk2(wv[2], wv[3]); ap.z = pk2(wv[4], wv[5]); ap.w = pk2(wv[6], wv[7]);
        const bf16x8 A = __builtin_bit_cast(bf16x8, ap);
        const bf16x8 B0 = *(const LAS bf16x8*)(VT + (ct0 * 32 + r) * 136 + k0), B1 = *(const LAS bf16x8*)(VT + ((ct0 + 1) * 32 + r) * 136 + k0);
        acc0 = mfma32(A, B0, acc0); acc1 = mfma32(A, B1, acc1);
    }
    const float* bs = F.in(10) + g * 128;
#pragma unroll
    for (int reg = 0; reg < 16; ++reg) { const int tr = tt * 32 + (reg & 3) + 8 * (reg >> 2) + 4 * hh; const float bsv = bs[tr];
        const size_t o0 = (size_t)(row0 + tr) * GW + g * 128 + ct0 * 32 + r;
#if DBG_GMLP_X2
        acc0[reg] *= 2.f; acc1[reg] *= 2.f;
#endif
#if DBG_NO_GMLP
        acc0[reg] = 0.f; acc1[reg] = 0.f;
#endif
        gm[o0] = (bf16)f2bf(bf2f(gub[o0]) * (acc0[reg] + bsv));
        gm[o0 + 32] = (bf16)f2bf(bf2f(gub[o0 + 32]) * (acc1[reg] + bsv)); }
    __syncthreads();
}

__device__ __constant__ unsigned char REL_BUCKET[128] = {0, 1, 2, 3, 4, 5, 6, 7, 8, 9, 10, 11, 12, 13, 14, 15, 16, 16, 16, 17, 17, 18, 18, 18, 19, 19, 19, 20, 20, 20, 20, 21, 21, 21, 21, 22, 22, 22, 22, 22, 23, 23, 23, 23, 23, 23, 24, 24, 24, 24, 24, 24, 25, 25, 25, 25, 25, 25, 25, 26, 26, 26, 26, 26, 26, 26, 26, 27, 27, 27, 27, 27, 27, 27, 27, 27, 27, 28, 28, 28, 28, 28, 28, 28, 28, 28, 28, 29, 29, 29, 29, 29, 29, 29, 29, 29, 29, 29, 29, 30, 30, 30, 30, 30, 30, 30, 30, 30, 30, 30, 30, 30, 30, 31, 31, 31, 31, 31, 31, 31, 31, 31, 31, 31, 31, 31, 31, 31};
constexpr int KI_PITCH = 144;
constexpr unsigned NEG_KEY = 0x007FFFFFu;
__device__ __forceinline__ int mbcnt64(unsigned long long m) { return __builtin_amdgcn_mbcnt_hi((unsigned)(m >> 32), __builtin_amdgcn_mbcnt_lo((unsigned)m, 0u)); }

#define IDX_LOAD_TILE(t_) do { _Pragma("unroll") for (int i_ = 0; i_ < 4; ++i_) { const int id_ = F.tid + 512 * i_; \
    stg[i_] = *(const GAS v4u*)(kiwi + (size_t)((t_) * 256 + (id_ >> 3)) * 256 + (id_ & 7) * 8); } } while (0)

__device__ __forceinline__ void idx_unit(Frame& F, int unit) {
    const int q0 = unit * 16;
    const int kend = ((q0 + 15) / 32 + 1) * 32;
    const int nkt = (kend + 255) >> 8;
    const bf16* qi = (const bf16*)(F.ws + WS_QI); const bf16* kiwi = (const bf16*)(F.ws + WS_KIWI);
    const int* pos = (const int*)F.in(2);
    float* scr = (F.bid < 128) ? F.out + (size_t)F.bid * (16 * 8192) : (float*)(F.ws + WS_SC) + (size_t)(F.bid - 128) * (16 * 8192);
    const int r = F.lane & 31, hh = F.lane >> 5;
    const int wq = q0 + 2 * F.wave;
    for (int repA = 0; repA < (DBG_REP_SUB == 1 ? 2 : 1); ++repA) {
        const int aq = wq + ((r >> 2) & 1), ah = (r & 3) + 4 * (r >> 3);
        bf16x8 Af[4];
#pragma unroll
        for (int s = 0; s < 4; ++s) Af[s] = *(const GAS bf16x8*)(qi + (size_t)aq * 1024 + ah * 64 + s * 16 + 8 * hh);
        float wgt[16];
        { const v4u a = *(const GAS v4u*)(kiwi + (size_t)(wq + hh) * 256 + 64), b = *(const GAS v4u*)(kiwi + (size_t)(wq + hh) * 256 + 72);
          float t0[8], t1[8]; unpack8(a, t0); unpack8(b, t1);
#pragma unroll
          for (int e = 0; e < 8; ++e) { wgt[e] = t0[e]; wgt[8 + e] = t1[e]; } }
        const int qpos = pos[wq + hh];
        float* srow = scr + (size_t)(2 * F.wave + hh) * 8192;
        v4u stg[4];
        IDX_LOAD_TILE(0);
        for (int t = 0; t < nkt; ++t) {
            __syncthreads();
#pragma unroll
            for (int i = 0; i < 4; ++i) { const int id = F.tid + 512 * i; *(LAS v4u*)(F.lds + (id >> 3) * KI_PITCH + (id & 7) * 16) = stg[i]; }
            __syncthreads();
            if (t + 1 < nkt) IDX_LOAD_TILE(t + 1);
            for (int sub = 0; sub < 8; ++sub) {
                const int key0 = t * 256 + sub * 32;
                if (key0 >= kend) break;
                f32x16 acc;
#pragma unroll
                for (int e = 0; e < 16; ++e) acc[e] = 0.f;
#pragma unroll
                for (int s = 0; s < 4; ++s) { const bf16x8 B = *(const LAS bf16x8*)(F.lds + (sub * 32 + r) * KI_PITCH + s * 32 + hh * 16); acc = mfma32(Af[s], B, acc); }
                float sc = 0.f;
#pragma unroll
                for (int e = 0; e < 16; ++e) sc += wgt[e] * fmaxf(acc[e], 0.f);
                const int key = key0 + r; const int kp = pos[key];
                srow[key] = (kp <= qpos) ? sc : -__builtin_inff();
            }
        }
    }
    __threadfence(); __syncthreads();
    unsigned long long* maskg = (unsigned long long*)(F.ws + WS_MASK);
    const int kw = 128 * ((q0 >> 7) + 1);
#pragma unroll 1
    for (int qq = 0; qq < (DBG_REP_SUB == 2 ? 4 : 2); ++qq) {
        const int qrow = wq + (qq & 1);
        const float* sr = scr + (size_t)(2 * F.wave + (qq & 1)) * 8192;
        unsigned key[128];
        int ln1 = F.lane; asm volatile("" : "+v"(ln1));
        int ke1 = kend; asm volatile("" : "+s"(ke1));
#pragma unroll
        for (int jb = 0; jb < 8; ++jb) {
#pragma unroll
            for (int jj = 0; jj < 16; ++jj) { const int j = jb * 16 + jj; key[j] = 0u; if (j * 64 < ke1) { const int idx = j * 64 + ln1; if (idx < ke1) key[j] = sortable(sr[idx]); } }
            __builtin_amdgcn_sched_barrier(0); }
        unsigned thr = 0u;
        for (int bit = 31; bit >= 0; --bit) { const unsigned cand = thr | (1u << bit); int c = 0;
            int ke = kend; asm volatile("" : "+s"(ke));
#pragma unroll
            for (int jb = 0; jb < 16; ++jb) { if (jb * 512 < ke) {
#pragma unroll
                    for (int jj = 0; jj < 8; ++jj) c += __builtin_popcountll(__ballot(key[jb * 8 + jj] >= cand)); }
                __builtin_amdgcn_sched_barrier(0); }
            if (c >= TOPK) thr = cand; }
        int ngt = 0;
        int ke3 = kend; asm volatile("" : "+s"(ke3));
#pragma unroll
        for (int jb = 0; jb < 16; ++jb) { if (jb * 512 < ke3) {
#pragma unroll
                for (int jj = 0; jj < 8; ++jj) ngt += __builtin_popcountll(__ballot(key[jb * 8 + jj] > thr && key[jb * 8 + jj] > NEG_KEY)); }
            __builtin_amdgcn_sched_barrier(0); }
        const int need = TOPK - ngt;
        int tie_seen = 0;
        int ke4 = kw; asm volatile("" : "+s"(ke4));
        unsigned long long mw0 = 0ull, mw1 = 0ull;
#pragma unroll
        for (int j = 0; j < 128; ++j) { if (j * 64 < ke4) {
            const bool valid = key[j] > NEG_KEY, gt = valid && key[j] > thr, eq = valid && key[j] == thr;
            const unsigned long long meq = __ballot(eq);
            const bool take = gt || (eq && (tie_seen + mbcnt64(meq)) < need);
            tie_seen += __builtin_popcountll(meq);
            const unsigned long long m = __ballot(take);
            if (F.lane == (j & 63)) { if (j < 64) mw0 = m; else mw1 = m; } }
            __builtin_amdgcn_sched_barrier(0); }
        if (F.lane * 64 < kw) maskg[(size_t)qrow * 128 + F.lane] = mw0;
        if ((64 + F.lane) * 64 < kw) maskg[(size_t)qrow * 128 + 64 + F.lane] = mw1;
    }
}

typedef short s16x4 __attribute__((ext_vector_type(4)));
__device__ __forceinline__ f32x4 mfma16(bf16x8 a, bf16x8 b, f32x4 c) { return __builtin_amdgcn_mfma_f32_16x16x32_bf16(a, b, c, 0, 0, 0); }
constexpr int ATT_KP = 272, ATT_VP = 288;
constexpr int ATT_KB = 64 * ATT_KP, ATT_VB = 64 * ATT_VP;
constexpr int ATT_VOFF = 2 * ATT_KB, ATT_TAB = ATT_VOFF + 2 * ATT_VB;

#define ATT_LOAD_TILE(t_) do { _Pragma("unroll") for (int i_ = 0; i_ < 2; ++i_) { const int c_ = F.tid + 512 * i_; \
    const bf16* gp_ = kvb + (size_t)((t_) * 64 + (c_ >> 4)) * 2048 + head * 128 + (c_ & 15) * 8; \
    kst[i_] = *(const GAS v4u*)gp_; vst[i_] = *(const GAS v4u*)(gp_ + 1024); } } while (0)

__device__ __forceinline__ void attn_unit(Frame& F, int qb, int head) {
    const bf16* qg = (const bf16*)(F.ws + WS_Q); const bf16* kvb = (const bf16*)(F.ws + WS_KV);
    const unsigned long long* maskg = (const unsigned long long*)(F.ws + WS_MASK);
    const int* pos = (const int*)F.in(2);
    const int qi = F.lane & 15, g = F.lane >> 4;
    const int qrow = qb * 128 + F.wave * 16 + qi;
    LAS float* tab = (LAS float*)(F.lds + ATT_TAB);
    __syncthreads();
    if (F.tid < 128) { const float* relb = F.in(5); tab[F.tid] = (relb[(int)REL_BUCKET[F.tid] * 8 + head] - relb[31 * 8 + head]) * 1.4426950408889634f; }
    bf16x8 Qf[4];
#pragma unroll
    for (int ks = 0; ks < 4; ++ks) Qf[ks] = *(const GAS bf16x8*)(qg + (size_t)qrow * 1024 + head * 128 + ks * 32 + 8 * g);
    const int qps = pos[qrow];
    const int qpmin = pos[qb * 128 + F.wave * 16];
    f32x4 O[8];
#pragma unroll
    for (int d = 0; d < 8; ++d) O[d] = (f32x4){0.f, 0.f, 0.f, 0.f};
    float m = -1e30f, lsum = 0.f;
    const int ntiles = 2 * (qb + 1);
    v4u kst[2], vst[2];
    ATT_LOAD_TILE(0);
    unsigned long long mw_next = maskg[(size_t)qrow * 128];
    for (int t = 0; t < ntiles; ++t) {
        LAS unsigned char* Kb = F.lds + (t & 1) * ATT_KB; LAS unsigned char* Vb = F.lds + ATT_VOFF + (t & 1) * ATT_VB;
#pragma unroll
        for (int i = 0; i < 2; ++i) { const int c = F.tid + 512 * i; *(LAS v4u*)(Kb + (c >> 4) * ATT_KP + (c & 15) * 16) = kst[i]; *(LAS v4u*)(Vb + (c >> 4) * ATT_VP + (c & 15) * 16) = vst[i]; }
        __syncthreads();
        const unsigned long long mw = mw_next;
        if (t + 1 < ntiles) { ATT_LOAD_TILE(t + 1); mw_next = maskg[(size_t)qrow * 128 + t + 1]; }
        f32x4 S[4];
#pragma unroll
        for (int st = 0; st < 4; ++st) { S[st] = (f32x4){0.f, 0.f, 0.f, 0.f};
#pragma unroll
            for (int ks = 0; ks < 4; ++ks) { const bf16x8 A = *(const LAS bf16x8*)(Kb + (16 * st + qi) * ATT_KP + (ks * 32 + 8 * g) * 2); S[st] = mfma16(A, Qf[ks], S[st]); } }
        const bool near_tile = (qpmin - pos[t * 64 + 63]) < 113;
        float rmax = -__builtin_inff();
        const unsigned long long mwg = mw >> (4 * g);
#pragma unroll
        for (int st = 0; st < 4; ++st)
#pragma unroll
            for (int r = 0; r < 4; ++r) { const int bit = 16 * st + 4 * g + r; float s = S[st][r];
                if (near_tile) { const int dist = qps - pos[t * 64 + bit]; if (dist >= 0 && dist < 128) s += tab[dist]; }
                s = ((mwg >> (16 * st + r)) & 1ull) ? s : -__builtin_inff();
                S[st][r] = s; rmax = fmaxf(rmax, s); }
        rmax = fmaxf(rmax, __shfl_xor(rmax, 16)); rmax = fmaxf(rmax, __shfl_xor(rmax, 32));
        const float mnew = fmaxf(m, rmax);
        const float alpha = __builtin_amdgcn_exp2f(m - mnew);
        m = mnew;
        float psum = 0.f;
#pragma unroll
        for (int st = 0; st < 4; ++st)
#pragma unroll
            for (int r = 0; r < 4; ++r) { const float p = __builtin_amdgcn_exp2f(S[st][r] - mnew); S[st][r] = p; psum += p; }
        lsum = lsum * alpha + psum;
        if (__any(alpha != 1.f)) {
#pragma unroll
            for (int d = 0; d < 8; ++d) O[d] = O[d] * alpha; }
        bf16x8 Pf[2];
#pragma unroll
        for (int kk = 0; kk < 2; ++kk) { v4u w; w.x = pk2(S[2 * kk][0], S[2 * kk][1]); w.y = pk2(S[2 * kk][2], S[2 * kk][3]); w.z = pk2(S[2 * kk + 1][0], S[2 * kk + 1][1]); w.w = pk2(S[2 * kk + 1][2], S[2 * kk + 1][3]);
            Pf[kk] = __builtin_bit_cast(bf16x8, w); }
#pragma unroll
        for (int dt = 0; dt < 8; ++dt)
#pragma unroll
            for (int kk = 0; kk < 2; ++kk) {
                LAS unsigned char* ap = Vb + (32 * kk + 4 * g + (qi >> 2)) * ATT_VP + (16 * dt + 4 * (qi & 3)) * 2;
                const s16x4 a0 = __builtin_amdgcn_ds_read_tr16_b64_v4i16((LAS s16x4*)ap), a1 = __builtin_amdgcn_ds_read_tr16_b64_v4i16((LAS s16x4*)(ap + 16 * ATT_VP));
                const bf16x8 A = (bf16x8){a0[0], a0[1], a0[2], a0[3], a1[0], a1[1], a1[2], a1[3]};
                O[dt] = mfma16(A, Pf[kk], O[dt]); }
    }
    lsum += __shfl_xor(lsum, 16); lsum += __shfl_xor(lsum, 32);
    const float inv = 1.f / lsum;
    bf16* op = (bf16*)(F.ws + WS_ATT) + (size_t)qrow * 1024 + head * 128 + 4 * g;
#pragma unroll
    for (int dt = 0; dt < 8; ++dt) { v2u w; w.x = pk2(O[dt][0] * inv, O[dt][1] * inv); w.y = pk2(O[dt][2] * inv, O[dt][3] * inv); *(GAS v2u*)(op + 16 * dt) = w; }
}

__device__ __forceinline__ float unsortable(unsigned k) { return __builtin_bit_cast(float, (k & 0x80000000u) ? (k & 0x7fffffffu) : ~k); }
#define DOT2(a, b, c) dot2bf((a), (b), (c))

__device__ __forceinline__ void peer_unit(Frame& F, int unit) {
    const int tok0 = unit * 32;
    const bf16* pq = (const bf16*)(F.ws + WS_PQ); const bf16* subk = (const bf16*)(F.ws + WS_SUBK);
    LAS float* topS = (LAS float*)F.lds; LAS int* topI = (LAS int*)(F.lds + 32768);
    LAS int* esel = (LAS int*)(F.lds + 65536); LAS float* ew = (LAS float*)(F.lds + 81920); LAS float* eu = (LAS float*)(F.lds + 98304);
    const int r = F.lane & 31, hh = F.lane >> 5;
#ifndef NO_A
    {
        const int h = F.wave;
        for (int p = 0; p < 2; ++p) {
            const int hp = h * 2 + p;
            bf16x8 Bq[8];
#pragma unroll
            for (int ks = 0; ks < 8; ++ks) Bq[ks] = *(const GAS bf16x8*)(pq + (size_t)(tok0 + r) * 2048 + hp * 128 + ks * 16 + 8 * hh);
            unsigned key[64];
#pragma unroll
            for (int kt = 0; kt < 4; ++kt) { f32x16 acc;
#pragma unroll
                for (int e = 0; e < 16; ++e) acc[e] = 0.f;
#pragma unroll
                for (int ks = 0; ks < 8; ++ks) { const bf16x8 A = *(const GAS bf16x8*)(subk + ((size_t)hp * 128 + kt * 32 + r) * 128 + ks * 16 + 8 * hh); acc = mfma32(A, Bq[ks], acc); }
#pragma unroll
                for (int e = 0; e < 16; ++e) key[kt * 16 + e] = sortable(acc[e]);
                __builtin_amdgcn_sched_barrier(0); }
            unsigned thr = 0u;
            for (int bit = 31; bit >= 0; --bit) { const unsigned cand = thr | (1u << bit); int c = 0;
#pragma unroll
                for (int i = 0; i < 64; ++i) c += (key[i] >= cand) ? 1 : 0;
                c += __shfl_xor(c, 32);
                if (c >= PE_TOPK) thr = cand; }
            int ngt = 0, neq = 0;
#pragma unroll
            for (int i = 0; i < 64; ++i) { ngt += (key[i] > thr) ? 1 : 0; neq += (key[i] == thr) ? 1 : 0; }
            const int pgt = __shfl_xor(ngt, 32), peq = __shfl_xor(neq, 32);
            int pg = hh ? pgt : 0, pe = ngt + pgt + (hh ? peq : 0);
            LAS float* ls = topS + ((r * 8 + h) * 2 + p) * 16; LAS int* li = topI + ((r * 8 + h) * 2 + p) * 16;
            unsigned thr2 = thr; asm volatile("" : "+v"(thr2));
#pragma unroll
            for (int kt = 0; kt < 4; ++kt)
#pragma unroll
                for (int e = 0; e < 16; ++e) { const unsigned k = key[kt * 16 + e]; const int kidx = kt * 32 + (e & 3) + 8 * (e >> 2) + 4 * hh;
                    if (k > thr2) { ls[pg] = unsortable(k); li[pg] = kidx; ++pg; }
                    else if (k == thr2) { if (pe < PE_TOPK) { ls[pe] = unsortable(k); li[pe] = kidx; } ++pe; } }
        }
    }
#endif
    __syncthreads();
#ifndef NO_B
    if (F.wave < 4) {
        int lnB = F.lane; asm volatile("" : "+v"(lnB));
        const int L = F.wave * 64 + lnB, tk = L >> 3, hd = L & 7;
        const LAS float* S0 = topS + ((tk * 8 + hd) * 2 + 0) * 16; const LAS int* I0 = topI + ((tk * 8 + hd) * 2 + 0) * 16;
        float s1[16]; int i1[16];
#pragma unroll
        for (int b = 0; b < 16; ++b) { s1[b] = topS[((tk * 8 + hd) * 2 + 1) * 16 + b]; i1[b] = topI[((tk * 8 + hd) * 2 + 1) * 16 + b]; }
        const float NINF = -__builtin_inff();
        float prev = __builtin_inff(), thr = NINF, top = 0.f;
        for (int round = 0; round < 16; ++round) {
            float cur = NINF;
#pragma unroll 1
            for (int a = 0; a < 16; ++a) { const float sa = S0[a];
#pragma unroll
                for (int b = 0; b < 16; ++b) { const float v = sa + s1[b]; cur = fmaxf(cur, v < prev ? v : NINF); } }
            if (round == 0) top = cur;
            thr = cur; prev = cur;
        }
        int n = 0; float den = 0.f; const int ob = tk * 128 + hd * 16;
#pragma unroll 1
        for (int a = 0; a < 16; ++a) { const float sa = S0[a]; const int ia = I0[a] * PE_NK;
#pragma unroll
            for (int b = 0; b < 16; ++b) { const float v = sa + s1[b];
                if (v > thr && n < PE_TOPK) { const float w = __expf(v - top); esel[ob + n] = ia + i1[b]; ew[ob + n] = w; den += w; ++n; } } }
#pragma unroll 1
        for (int a = 0; a < 16; ++a) { const float sa = S0[a]; const int ia = I0[a] * PE_NK;
#pragma unroll
            for (int b = 0; b < 16; ++b) { const float v = sa + s1[b];
                if (v == thr && n < PE_TOPK) { const float w = __expf(v - top); esel[ob + n] = ia + i1[b]; ew[ob + n] = w; den += w; ++n; } } }
        const float inv = 1.f / den;
        const float* psc = (const float*)(F.ws + WS_PSC);
        for (int k = 0; k < PE_TOPK; ++k) { const int e = esel[ob + k]; ew[ob + k] *= inv * psc[PE_NE + e]; eu[ob + k] = psc[e]; }
    }
#endif
    __syncthreads();
#ifndef NO_C
    {
        int lnC = F.lane; asm volatile("" : "+v"(lnC));
        const float* h1f = (const float*)(F.ws + WS_H1F);
        const unsigned char* PU = (const unsigned char*)(F.ws + WS_PU); const unsigned char* PV = (const unsigned char*)(F.ws + WS_PV);
        float* rf = (float*)(F.ws + WS_RF); bf16* rb = (bf16*)(F.ws + WS_RB);
#pragma unroll 1
        for (int tt = 0; tt < 4; ++tt) {
            const int tl = F.wave * 4 + tt, tok = tok0 + tl;
            f32x2 xv[16], o[16];
#pragma unroll
            for (int i = 0; i < 2; ++i)
#pragma unroll
                for (int c = 0; c < 4; ++c) { const f32x4 hv = *(const GAS f32x4*)(h1f + (size_t)tok * DM + i * 1024 + lnC * 16 + c * 4);
                    xv[i * 8 + c * 2] = (f32x2){hv.x, hv.y}; xv[i * 8 + c * 2 + 1] = (f32x2){hv.z, hv.w}; }
#pragma unroll
            for (int e = 0; e < 16; ++e) o[e] = (f32x2){0.f, 0.f};
#pragma unroll 1
            for (int e0 = 0; e0 < DBG_PEER_NEXP; e0 += 4) {
                v4u uq[4][2], vq[4][2]; float gv[4], su[4];
#pragma unroll
                for (int k = 0; k < 4; ++k) { const int id = __builtin_amdgcn_readfirstlane(esel[tl * 128 + e0 + k]); gv[k] = ew[tl * 128 + e0 + k]; su[k] = eu[tl * 128 + e0 + k];
                    const GAS v4u* up = (const GAS v4u*)(PU + (size_t)id * DM) + lnC; const GAS v4u* vp = (const GAS v4u*)(PV + (size_t)id * DM) + lnC;
                    uq[k][0] = up[0]; uq[k][1] = up[64]; vq[k][0] = vp[0]; vq[k][1] = vp[64]; }
                float av[4];
#pragma unroll
                for (int k = 0; k < 4; ++k) { f32x2 acc = (f32x2){0.f, 0.f};
#pragma unroll
                    for (int i = 0; i < 2; ++i)
#pragma unroll
                        for (int c = 0; c < 4; ++c) { const int w = (int)uq[k][i][c];
                            acc = __builtin_amdgcn_cvt_pk_f32_fp8(w, false) * xv[i * 8 + c * 2] + acc; acc = __builtin_amdgcn_cvt_pk_f32_fp8(w, true) * xv[i * 8 + c * 2 + 1] + acc; }
                    av[k] = acc.x + acc.y; }
#pragma unroll
                for (int k = 0; k < 4; ++k) av[k] = wave_sum(av[k]);
#pragma unroll
                for (int k = 0; k < 4; ++k) { const float a = gv[k] * gelu_tanh(av[k] * su[k]); const f32x2 a2 = (f32x2){a, a};
#pragma unroll
                    for (int i = 0; i < 2; ++i)
#pragma unroll
                        for (int c = 0; c < 4; ++c) { const int w = (int)vq[k][i][c];
                            o[i * 8 + c * 2] = __builtin_amdgcn_cvt_pk_f32_fp8(w, false) * a2 + o[i * 8 + c * 2]; o[i * 8 + c * 2 + 1] = __builtin_amdgcn_cvt_pk_f32_fp8(w, true) * a2 + o[i * 8 + c * 2 + 1]; } }
            }
#pragma unroll
            for (int i = 0; i < 2; ++i)
#pragma unroll
                for (int c = 0; c < 4; ++c) { const size_t off = (size_t)tok * DM + i * 1024 + lnC * 16 + c * 4;
                    f32x2 ra = xv[i * 8 + c * 2] * ALPHA + o[i * 8 + c * 2], rbv = xv[i * 8 + c * 2 + 1] * ALPHA + o[i * 8 + c * 2 + 1];
#if DBG_NO_PEER
                    ra = xv[i * 8 + c * 2] * ALPHA; rbv = xv[i * 8 + c * 2 + 1] * ALPHA;
#endif
                    *(GAS f32x4*)(rf + off) = (f32x4){ra.x, ra.y, rbv.x, rbv.y};
                    v2u w; w.x = pk2(ra.x, ra.y); w.y = pk2(rbv.x, rbv.y); *(GAS v2u*)(rb + off) = w; }
        }
    }
#endif
    __syncthreads();
}

struct Args { const float* in[24]; float* out; unsigned char* ws; int ph_lo, ph_hi; };
constexpr int N_PHASES = 11;

__global__ void __launch_bounds__(NTHREADS, 2) mega_fwd(Args args) {
    extern __shared__ __attribute__((aligned(16))) unsigned char lds_raw[];
    const int lo = args.ph_lo, hi = args.ph_hi;
#if MK_COOP
    cg::grid_group grid = cg::this_grid();
    if (threadIdx.x < 2) ((LAS unsigned*)(lds_raw + LDS_BARST))[threadIdx.x] = 0u;
    __syncthreads();
    XcdBarrier xbar = xcd_barrier_post((unsigned*)(args.ws + WS_CTL) + 1024, (volatile LAS unsigned*)((LAS unsigned char*)lds_raw + LDS_BARST));
    int nbar_ = 0;
#if DBG_ALL_CG
#define GRID_BAR() grid.sync()
#else
#define GRID_BAR() do { if (nbar_++ == 0) grid.sync(); else xcd_barrier(xbar); } while (0)
#endif
#else
#define GRID_BAR() do {} while (0)
#endif
#define IN(k) (lo <= (k) && (k) < hi)
#define NREP(k) ((k) == DBG_REP_PHASE ? 2 : 1)
#define BOTH(k) (IN(k) && IN((k) + 1))

    if (IN(0)) for (int rep_ = 0; rep_ < NREP(0); ++rep_) { if (rep_) GRID_BAR(); MAKE_FRAME(F); p0_prologue(F); if (BOTH(0) && rep_ + 1 == NREP(0)) GRID_BAR(); }

    if (IN(1)) for (int rep_ = 0; rep_ < NREP(1); ++rep_) {
        if (rep_) GRID_BAR();
        MAKE_FRAME(F); unsigned char* ws = F.ws; LAS unsigned char* glds = F.lds;
        pg8::Gemm g{(const bf16*)(ws + WS_HB), (const bf16*)(ws + WS_WIN), SEQ, INW_PAD, DM}; asm volatile("" : "+s"(g.K), "+s"(g.N), "+s"(g.M)); pg8::StaticOrder S; S.init(SEQ, INW_PAD, F.G, F.bid);
        pg8::EpiWin E{(bf16*)(ws + WS_Q), (bf16*)(ws + WS_KV), (bf16*)(ws + WS_QI), (bf16*)(ws + WS_GU), (bf16*)(ws + WS_GV), (bf16*)(ws + WS_GA), (bf16*)(ws + WS_GG), (bf16*)(ws + WS_KIWI)};
        pg8::gemm_phase<pg8::EpiWin, pg8::StaticOrder, true, true>(glds, g, S, E);
        if (BOTH(1) && rep_ + 1 == NREP(1)) GRID_BAR();
    }

    if (IN(2)) for (int rep_ = 0; rep_ < NREP(2); ++rep_) {
        if (rep_) GRID_BAR();
        MAKE_FRAME(F); unsigned char* ws = F.ws; LAS unsigned char* glds = F.lds;
        for (int u = F.bid; u < 512; u += F.G) gmlp_unit(F, u);
#pragma unroll 1
        for (int k = F.bid, i = 0; k < 512; k += F.G, ++i) idx_unit(F, (F.G == 256 && i == 1) ? 511 - F.bid : k);
        if (BOTH(2) && rep_ + 1 == NREP(2)) GRID_BAR();
    }

    if (IN(3)) for (int rep_ = 0; rep_ < NREP(3); ++rep_) {
        if (rep_) GRID_BAR();
        MAKE_FRAME(F);
#pragma unroll 1
        for (int u = F.bid; u < 256; u += F.G) { const int head = u & 7, pair = u >> 3;
#pragma unroll 1
            for (int i = 0; i < 2; ++i) attn_unit(F, i ? 63 - pair : pair, head); }
        if (BOTH(3) && rep_ + 1 == NREP(3)) GRID_BAR();
    }

    if (IN(4)) for (int rep_ = 0; rep_ < NREP(4); ++rep_) {
        if (rep_) GRID_BAR();
        MAKE_FRAME(F); unsigned char* ws = F.ws; LAS unsigned char* glds = F.lds;
        { pg8::Gemm g{(const bf16*)(ws + WS_ATT), (const bf16*)(ws + WS_WA), SEQ, DM, AW}; asm volatile("" : "+s"(g.K), "+s"(g.N), "+s"(g.M)); pg8::StaticOrder S; S.init(SEQ, DM, F.G, F.bid);
          pg8::EpiGateF32 E{(const bf16*)(ws + WS_GA), (float*)(ws + WS_T), DM};
          pg8::gemm_phase<pg8::EpiGateF32, pg8::StaticOrder, true, true>(glds, g, S, E); }
        __syncthreads();
        { pg8::Gemm g{(const bf16*)(ws + WS_GM), (const bf16*)(ws + WS_WG), SEQ, DM, GW}; asm volatile("" : "+s"(g.K), "+s"(g.N), "+s"(g.M)); pg8::StaticOrder S; S.init(SEQ, DM, F.G, F.bid);
          pg8::EpiMerge E{(const bf16*)(ws + WS_GG), (const float*)(ws + WS_T), (bf16*)(ws + WS_MERGED), DM};
          pg8::gemm_phase<pg8::EpiMerge, pg8::StaticOrder, true, true>(glds, g, S, E); }
        if (BOTH(4) && rep_ + 1 == NREP(4)) GRID_BAR();
    }

    if (IN(5)) for (int rep_ = 0; rep_ < NREP(5); ++rep_) {
        if (rep_) GRID_BAR();
        MAKE_FRAME(F); unsigned char* ws = F.ws; LAS unsigned char* glds = F.lds;
        pg8::Gemm g{(const bf16*)(ws + WS_MERGED), (const bf16*)(ws + WS_WMIX), SEQ, DM, DM}; asm volatile("" : "+s"(g.K), "+s"(g.N), "+s"(g.M)); pg8::StaticOrder S; S.init(SEQ, DM, F.G, F.bid);
        pg8::EpiMix E{F.in(0), (const float*)(ws + WS_STATS), F.in(3), F.in(4), F.out, DM};
        pg8::gemm_phase<pg8::EpiMix, pg8::StaticOrder, true, true>(glds, g, S, E);
        if (BOTH(5) && rep_ + 1 == NREP(5)) GRID_BAR();
    }

    if (IN(6)) for (int rep_ = 0; rep_ < NREP(6); ++rep_) {
        if (rep_) GRID_BAR();
        MAKE_FRAME(F); unsigned char* ws = F.ws; LAS unsigned char* glds = F.lds;
        const int gw = F.bid * NWAVES + F.wave, NGW = F.G * NWAVES;
        for (int m = gw; m < SEQ; m += NGW) ln_row(F, F.out + (size_t)m * DM, F.in(14), F.in(15), (bf16*)(ws + WS_H1B) + (size_t)m * DM, (float*)(ws + WS_H1F) + (size_t)m * DM, nullptr);
        if (BOTH(6) && rep_ + 1 == NREP(6)) GRID_BAR();
    }

    if (IN(7)) for (int rep_ = 0; rep_ < NREP(7); ++rep_) {
        if (rep_) GRID_BAR();
        MAKE_FRAME(F); unsigned char* ws = F.ws; LAS unsigned char* glds = F.lds;
        pg8::Gemm g{(const bf16*)(ws + WS_H1B), (const bf16*)(ws + WS_WQ), SEQ, DM, DM}; asm volatile("" : "+s"(g.K), "+s"(g.N), "+s"(g.M)); pg8::StaticOrder S; S.init(SEQ, DM, F.G, F.bid);
        pg8::EpiBf16<0> E{(bf16*)(ws + WS_PQ), DM, nullptr, 0, 0, 1.f};
        pg8::gemm_phase<pg8::EpiBf16<0>, pg8::StaticOrder, true, true>(glds, g, S, E);
        if (BOTH(7) && rep_ + 1 == NREP(7)) GRID_BAR();
    }

    if (IN(8)) for (int rep_ = 0; rep_ < NREP(8); ++rep_) {
        if (rep_) GRID_BAR();
        MAKE_FRAME(F); unsigned char* ws = F.ws; LAS unsigned char* glds = F.lds;
        for (int u = F.bid; u < SEQ / 32; u += F.G) peer_unit(F, u);
        if (BOTH(8) && rep_ + 1 == NREP(8)) GRID_BAR();
    }

    if (IN(9)) for (int rep_ = 0; rep_ < NREP(9); ++rep_) {
        if (rep_) GRID_BAR();
        MAKE_FRAME(F); unsigned char* ws = F.ws; LAS unsigned char* glds = F.lds;
        { pg8::Gemm g{(const bf16*)(ws + WS_PB), (const bf16*)(ws + WS_WPP), SEQ, DM, PLE}; asm volatile("" : "+s"(g.K), "+s"(g.N), "+s"(g.M)); pg8::StaticOrder S; S.init(SEQ, DM, F.G, F.bid);
          pg8::EpiF32 E{(float*)(ws + WS_T2), DM};
          pg8::gemm_phase<pg8::EpiF32, pg8::StaticOrder, true, true>(glds, g, S, E); }
        __syncthreads();
        { pg8::Gemm g{(const bf16*)(ws + WS_RB), (const bf16*)(ws + WS_WPG), SEQ, DM, DM}; asm volatile("" : "+s"(g.K), "+s"(g.N), "+s"(g.M)); pg8::StaticOrder S; S.init(SEQ, DM, F.G, F.bid);
          pg8::EpiPle E{(const float*)(ws + WS_RF), (const float*)(ws + WS_T2), F.out, DM};
          pg8::gemm_phase<pg8::EpiPle, pg8::StaticOrder, true, true>(glds, g, S, E); }
        if (BOTH(9) && rep_ + 1 == NREP(9)) GRID_BAR();
    }

    if (IN(10)) for (int rep_ = 0; rep_ < NREP(10); ++rep_) {
        if (rep_) GRID_BAR();
        MAKE_FRAME(F); unsigned char* ws = F.ws; LAS unsigned char* glds = F.lds;
        const int gw = F.bid * NWAVES + F.wave, NGW = F.G * NWAVES;
        for (int m = gw; m < SEQ; m += NGW) ln_row(F, F.out + (size_t)m * DM, F.in(22), F.in(23), nullptr, F.out + (size_t)m * DM, nullptr);
    }
}

extern "C" void kernel_launch(void* const* d_in, const int* in_sizes, int n_in, void* d_out, int out_size, void* d_ws, size_t ws_size, hipStream_t stream) {
    static int grid = 0;
    if (grid == 0) {
        if (n_in != 24 || out_size != SEQ * DM || ws_size < WS_END) { fprintf(stderr, "kernel_launch: unexpected problem: n_in %d out %d ws %zu (need %zu)\n", n_in, out_size, ws_size, (size_t)WS_END); grid = -1; return; }
        int dev = 0, cus = 0, per_cu = 0;
        if (hipGetDevice(&dev) != hipSuccess || hipDeviceGetAttribute(&cus, hipDeviceAttributeMultiprocessorCount, dev) != hipSuccess) { grid = -1; return; }
        if (hipFuncSetAttribute((const void*)mega_fwd, hipFuncAttributeMaxDynamicSharedMemorySize, LDS_BYTES) != hipSuccess) { fprintf(stderr, "kernel_launch: hipFuncSetAttribute failed\n"); grid = -1; return; }
        if (hipOccupancyMaxActiveBlocksPerMultiprocessor(&per_cu, (const void*)mega_fwd, NTHREADS, LDS_BYTES) != hipSuccess || per_cu < 1) { fprintf(stderr, "kernel_launch: occupancy query says %d blocks per CU\n", per_cu); (void)hipGetLastError(); grid = -1; return; }
        grid = cus;
        fprintf(stderr, "kernel_launch: grid %d (per_cu %d), ws %zu\n", grid, per_cu, ws_size);
    }
    if (grid < 0) return;
    if (hipMemsetAsync((char*)d_ws + WS_CTL, 0, CTL_ZERO_BYTES, stream) != hipSuccess) { fprintf(stderr, "kernel_launch: memset of the barrier words failed\n"); return; }
    Args a{};
    for (int i = 0; i < 24; ++i) a.in[i] = (const float*)d_in[i];
    a.out = (float*)d_out; a.ws = (unsigned char*)d_ws;
#if MK_COOP
    a.ph_lo = 0; a.ph_hi = N_PHASES;
    void* kargs[] = {&a};
    hipError_t e = hipLaunchCooperativeKernel((const void*)mega_fwd, dim3(grid), dim3(NTHREADS), kargs, LDS_BYTES, stream);
    if (e != hipSuccess) fprintf(stderr, "kernel_launch: cooperative launch failed: %s\n", hipGetErrorString(e));
#else
    for (int ph = 0; ph < N_PHASES; ++ph) { a.ph_lo = ph; a.ph_hi = ph + 1; hipLaunchKernelGGL(mega_fwd, dim3(grid), dim3(NTHREADS), LDS_BYTES, stream, a); }
#endif
}
```

```cpp
#include <hip/hip_runtime.h>
#include <hip/hip_cooperative_groups.h>
#include <cstdio>
#include <cstdint>
namespace cg = cooperative_groups;
#ifndef MK_COOP
#define MK_COOP 1
#endif
#define DBG_NO_ATTN 0
#define DBG_ATTN_X2 0
#define DBG_PEER_X2 0
#define DBG_NO_PEER 0
#define DBG_NO_GMLP 0
#define DBG_GMLP_X2 0
#define DBG_PLE_S 1.0f
#define DBG_MIX_S 1.0f
#define DBG_ATTN_HI_S 1.0f
#define DBG_LOGIT_S 1.0f
#define DBG_NO_BIAS 0
#define DBG_REP_PHASE -1
#define DBG_REP_SUB 0
#define DBG_ALL_CG 0
#define DBG_PEER_NEXP 128
namespace pg8 {
#define PG8_LAS __attribute__((address_space(3)))
typedef unsigned short bf16_t;
typedef short bf16x8 __attribute__((ext_vector_type(8)));
typedef float f32x4 __attribute__((ext_vector_type(4)));
typedef unsigned u32x4 __attribute__((ext_vector_type(4)));
constexpr int BM = 256, BK = 64, HALF = 128, HTB = HALF * BK * 2  , STAGE_BYTES = 8 * HTB, NXCD = 8, WGM = 8;

__host__ __device__ __forceinline__ int lds_byte(int r, int c) { const int st = (r >> 4) * 2 + (c >> 5), rr = r & 15, cc = c & 31, ob = rr * 64 + cc * 2; return st * 1024 + (ob ^ (((ob >> 9) & 1) << 5)); }
__host__ __device__ __forceinline__ void stage_rc(int b, int& R, int& C) { const int st = b / 1024, sb = b % 1024, swz = sb ^ (((sb >> 9) & 1) << 5); R = (st >> 1) * 16 + swz / 64; C = (st & 1) * 32 + (swz % 64) / 2; }
__host__ __device__ __forceinline__ int perm32(int rho) { const int n = rho >> 4, i = rho & 15; return 8 * (i >> 2) + 4 * n + (i & 3); }

struct Unit { int pm, pn; };
struct Gemm { const bf16_t* A; const bf16_t* Bt; int M, N, K; };

struct StaticOrder {
    int nM, nN, nwg, G, c;
    __host__ __device__ void init(int M, int N, int G_, int c_) { nM = M / BM; nN = N / BM; nwg = nM * nN; G = G_; c = c_; }
    __host__ __device__ bool next(int i, Unit& u) const {
        const long L = (long)i * G + c; if (L >= nwg) return false;
        int wgid = (int)L; { const int q = nwg / NXCD, r = nwg % NXCD, xcd = wgid % NXCD, off = wgid / NXCD; wgid = (xcd < r ? xcd * (q + 1) : r * (q + 1) + (xcd - r) * q) + off; }
        const int nig = WGM * nN, gid = wgid / nig, fm = gid * WGM, gsz = (nM - fm) < WGM ? (nM - fm) : WGM;
        u.pm = fm + ((wgid % nig) % gsz); u.pn = (wgid % nig) / gsz; return true;
    }
    __device__ __forceinline__ void a_ready(const Unit&) const {}
    __device__ __forceinline__ void done(const Unit&) const {}
};

__device__ __forceinline__ unsigned cvt_pk_bf16(float lo, float hi) { unsigned r; asm volatile("v_cvt_pk_bf16_f32 %0, %1, %2" : "=v"(r) : "v"(lo), "v"(hi)); return r; }
typedef float f32x2 __attribute__((ext_vector_type(2)));
__device__ __forceinline__ f32x2 gelu_pk(f32x2 v) {
    const f32x2 av = __builtin_elementwise_abs(v), d = av * 0.2316418882f + 1.0f;
    f32x2 t; t.x = __builtin_amdgcn_rcpf(d.x); t.y = __builtin_amdgcn_rcpf(d.y);
    f32x2 q = t * 0.5307027145f + (-0.7265760135f); q = q * t + 0.7107068705f; q = q * t + (-0.142248368f); q = q * t + 0.127414796f; q = q * t;
    const f32x2 s = (v * v) * (-0.72134752044f);
    f32x2 e; e.x = __builtin_amdgcn_exp2f(s.x); e.y = __builtin_amdgcn_exp2f(s.y);
    const f32x2 m = v * (q * e), r = v - m;
    f32x2 o; o.x = v.x < 0.f ? m.x : r.x; o.y = v.y < 0.f ? m.y : r.y; return o;
}

template <int ACT  > struct EpiBf16 {
    static constexpr bool PERM = true, AFTER_DRAIN = false; static_assert(ACT == 0 || ACT == 1, "EpiBf16: ACT is 0 (none) or 1 (gelu_pk)");
    bf16_t* O; int ldc; const float* bias; int split_cols; size_t split_stride; float scale0;
    __device__ __forceinline__ void operator()(const f32x4 (&acc)[2][2][4][2], const Unit& u, int wr, int wc, int fr, int fq) const {
        const int row0 = u.pm * BM + wr * 64 + fr; int colt = u.pn * BM; bf16_t* base = O;
        float sc = 1.f; if (split_cols) { const int t = colt / split_cols; base += (size_t)t * split_stride; colt -= t * split_cols; if (t == 0) sc = scale0; }
        const int col0 = colt + wc * 32 + 8 * fq, bcol0 = u.pn * BM + wc * 32 + 8 * fq;
        f32x4 bv[2][2];
#pragma unroll
        for (int bj = 0; bj < 2; ++bj)
#pragma unroll
            for (int n = 0; n < 2; ++n) bv[bj][n] = bias ? *(const f32x4*)(bias + bcol0 + bj * HALF + 4 * n) : (f32x4){0.f, 0.f, 0.f, 0.f};
#pragma unroll
        for (int ai = 0; ai < 2; ++ai)
#pragma unroll
            for (int m = 0; m < 4; ++m) { bf16_t* rowp = base + (size_t)(row0 + ai * HALF + m * 16) * ldc + col0;
#pragma unroll
                for (int bj = 0; bj < 2; ++bj) { f32x4 v0 = acc[ai][bj][m][0] + bv[bj][0], v1 = acc[ai][bj][m][1] + bv[bj][1];
                    if (ACT == 1) { f32x2 a = gelu_pk((f32x2){v0[0], v0[1]}), b = gelu_pk((f32x2){v0[2], v0[3]}), c = gelu_pk((f32x2){v1[0], v1[1]}), d = gelu_pk((f32x2){v1[2], v1[3]});
                        v0 = (f32x4){a.x, a.y, b.x, b.y}; v1 = (f32x4){c.x, c.y, d.x, d.y}; }
                    v0 = v0 * sc; v1 = v1 * sc; u32x4 w; w.x = cvt_pk_bf16(v0[0], v0[1]); w.y = cvt_pk_bf16(v0[2], v0[3]); w.z = cvt_pk_bf16(v1[0], v1[1]); w.w = cvt_pk_bf16(v1[2], v1[3]);
                    *(u32x4*)(rowp + bj * HALF) = w; } }
    }
};
template <class Epi, class Sched, bool ALIGN_EPI = false, bool SP2 = false>
__device__ __forceinline__ void gemm_phase(PG8_LAS unsigned char* lds, const Gemm g, const Sched& S, const Epi& E) {
    const int tid = threadIdx.x, wid = __builtin_amdgcn_readfirstlane(tid >> 6), lane = tid & 63, wr = wid >> 2, wc = wid & 3, fr = lane & 15, fq = lane >> 4;
    const int K = g.K, nt = K / BK;
    unsigned voffA[2], voffB[2];
#pragma unroll
    for (int i = 0; i < 2; ++i) { int R, C; stage_rc(tid * 16 + i * 8192, R, C); const int Rb = Epi::PERM ? ((R & ~31) + perm32(R & 31)) : R;
        voffA[i] = (unsigned)(R * K + C) * 2u; voffB[i] = (unsigned)(Rb * K + C) * 2u; }
    const size_t kstep = (size_t)(BK * 2);
    const size_t hstep = (size_t)HALF * K * 2;
    const size_t tstep = 2 * hstep;
    const unsigned ldsw = (unsigned)wid * 1024u;
    const int aoff = lds_byte(wr * 64 + fr, fq * 8), boff = lds_byte(wc * 32 + fr, fq * 8);
#define PG8_SA(b, h) (((b) * 2 + (h)) * HTB)
#define PG8_SB(b, h) ((4 + (b) * 2 + (h)) * HTB)
#define PG8_STAGE(bufoff, gbase, voff) do { _Pragma("unroll") for (int _i = 0; _i < 2; ++_i) \
        __builtin_amdgcn_global_load_lds((const unsigned*)((const char*)(gbase) + (voff)[_i]), (PG8_LAS unsigned*)(lds + (bufoff) + ldsw + _i * 8192), 16, 0, 0); } while (0)
#define PG8_LDA(dst, b, h) do { _Pragma("unroll") for (int m = 0; m < 4; ++m) _Pragma("unroll") for (int k = 0; k < 2; ++k) dst[m][k] = *(const PG8_LAS bf16x8*)(lds + PG8_SA(b, h) + aoff + m * 2048 + k * 1024); } while (0)
#define PG8_LDB(dst, b, h) do { _Pragma("unroll") for (int n = 0; n < 2; ++n) _Pragma("unroll") for (int k = 0; k < 2; ++k) dst[n][k] = *(const PG8_LAS bf16x8*)(lds + PG8_SB(b, h) + boff + n * 2048 + k * 1024); } while (0)
#define PG8_MMA(ai, bj, At, Bt) do { __builtin_amdgcn_s_setprio(1); _Pragma("unroll") for (int m = 0; m < 4; ++m) _Pragma("unroll") for (int n = 0; n < 2; ++n) _Pragma("unroll") for (int k = 0; k < 2; ++k) \
        acc[ai][bj][m][n] = __builtin_amdgcn_mfma_f32_16x16x32_bf16(Bt[n][k], At[m][k], acc[ai][bj][m][n], 0, 0, 0); __builtin_amdgcn_s_setprio(0); } while (0)
#define PG8_WAIT_V(n) asm volatile("s_waitcnt vmcnt(" #n ")" ::: "memory")
#define PG8_WAIT_L(n) asm volatile("s_waitcnt lgkmcnt(" #n ")" ::: "memory")
#define PG8_BAR __builtin_amdgcn_s_barrier()
#define PG8_SCHED __builtin_amdgcn_sched_barrier(0)
    Unit cur, nxt; int ui = 0;
    if (!S.next(0, cur)) return;
    f32x4 acc[2][2][4][2];
#pragma unroll
    for (int a = 0; a < 2; ++a)
#pragma unroll
        for (int b = 0; b < 2; ++b)
#pragma unroll
            for (int m = 0; m < 4; ++m)
#pragma unroll
                for (int n = 0; n < 2; ++n) acc[a][b][m][n] = (f32x4){0.f, 0.f, 0.f, 0.f};
    bf16x8 At[4][2], B0[2][2], B1[2][2];
    const char* cA = (const char*)g.A + (size_t)cur.pm * tstep; const char* cB = (const char*)g.Bt + (size_t)cur.pn * tstep;
    S.a_ready(cur);
    if constexpr (SP2) {
        PG8_STAGE(PG8_SB(0, 0), cB, voffB); PG8_STAGE(PG8_SB(0, 1), cB + hstep, voffB); PG8_STAGE(PG8_SA(0, 0), cA, voffA); PG8_STAGE(PG8_SA(0, 1), cA + hstep, voffA);
        if (wr == 1) PG8_BAR;
        PG8_WAIT_V(2); PG8_BAR;
        PG8_STAGE(PG8_SB(1, 0), cB + kstep, voffB); PG8_STAGE(PG8_SA(1, 0), cA + kstep, voffA); PG8_STAGE(PG8_SB(1, 1), cB + hstep + kstep, voffB);
        PG8_WAIT_V(6); PG8_BAR;
    } else {
        PG8_STAGE(PG8_SB(0, 0), cB, voffB); PG8_STAGE(PG8_SA(0, 0), cA, voffA); PG8_STAGE(PG8_SB(0, 1), cB + hstep, voffB); PG8_STAGE(PG8_SA(0, 1), cA + hstep, voffA);
        if (wr == 1) PG8_BAR;
        PG8_WAIT_V(4); PG8_BAR;
        PG8_STAGE(PG8_SB(1, 0), cB + kstep, voffB); PG8_STAGE(PG8_SA(1, 0), cA + kstep, voffA); PG8_STAGE(PG8_SB(1, 1), cB + hstep + kstep, voffB);
        PG8_WAIT_V(6); PG8_BAR;
    }
    for (;;) {
        const bool has_next = S.next(ui + 1, nxt);
        const char* nA = has_next ? (const char*)g.A + (size_t)nxt.pm * tstep : cA; const char* nB = has_next ? (const char*)g.Bt + (size_t)nxt.pn * tstep : cB;
        for (int t = 0; t < nt; t += 2) {
            const bool last = (t == nt - 2);
            const char* a1 = cA + (size_t)(t + 1) * kstep;
            const char* a2 = last ? nA : cA + (size_t)(t + 2) * kstep; const char* b2 = last ? nB : cB + (size_t)(t + 2) * kstep;
            const char* a3 = a2 + kstep; const char* b3 = b2 + kstep;
            if (last && has_next) S.a_ready(nxt);
            if constexpr (SP2) {
            PG8_LDB(B0, 0, 0); PG8_LDB(B1, 0, 1); PG8_SCHED; PG8_LDA(At, 0, 0); PG8_STAGE(PG8_SA(1, 1), a1 + hstep, voffA);
            PG8_WAIT_V(8); PG8_WAIT_L(0); PG8_BAR; PG8_MMA(0, 0, At, B0); PG8_MMA(0, 1, At, B1); PG8_BAR; PG8_SCHED;
            PG8_LDA(At, 0, 1); PG8_STAGE(PG8_SB(0, 0), b2, voffB); PG8_STAGE(PG8_SB(0, 1), b2 + hstep, voffB); PG8_STAGE(PG8_SA(0, 0), a2, voffA);
            PG8_WAIT_V(8); PG8_WAIT_L(0); PG8_BAR; PG8_MMA(1, 0, At, B0); PG8_MMA(1, 1, At, B1); PG8_BAR; PG8_SCHED;
            PG8_LDB(B0, 1, 0); PG8_LDB(B1, 1, 1); PG8_SCHED; PG8_LDA(At, 1, 0); PG8_STAGE(PG8_SA(0, 1), a2 + hstep, voffA);
            PG8_WAIT_V(8); PG8_WAIT_L(0); PG8_BAR; PG8_MMA(0, 0, At, B0); PG8_MMA(0, 1, At, B1); PG8_BAR; PG8_SCHED;
            PG8_LDA(At, 1, 1); PG8_STAGE(PG8_SB(1, 0), b3, voffB); PG8_STAGE(PG8_SB(1, 1), b3 + hstep, voffB); PG8_STAGE(PG8_SA(1, 0), a3, voffA);
            PG8_WAIT_V(8); PG8_WAIT_L(0); PG8_BAR; PG8_MMA(1, 0, At, B0); PG8_MMA(1, 1, At, B1); PG8_BAR; PG8_SCHED;
            } else {
            PG8_LDB(B0, 0, 0); PG8_SCHED; PG8_LDA(At, 0, 0); PG8_STAGE(PG8_SA(1, 1), a1 + hstep, voffA);
            PG8_WAIT_L(8); PG8_BAR; PG8_WAIT_L(0); PG8_MMA(0, 0, At, B0); PG8_BAR; PG8_SCHED;
            PG8_LDB(B1, 0, 1); PG8_STAGE(PG8_SB(0, 0), b2, voffB);
            PG8_BAR; PG8_WAIT_L(0); PG8_MMA(0, 1, At, B1); PG8_BAR;
            PG8_LDA(At, 0, 1); PG8_STAGE(PG8_SA(0, 0), a2, voffA);
            PG8_BAR; PG8_WAIT_L(0); PG8_MMA(1, 0, At, B0); PG8_BAR; PG8_SCHED;
            PG8_STAGE(PG8_SB(0, 1), b2 + hstep, voffB);
            PG8_WAIT_V(6); PG8_BAR; PG8_MMA(1, 1, At, B1); PG8_BAR;
            PG8_LDB(B0, 1, 0); PG8_SCHED; PG8_LDA(At, 1, 0); PG8_STAGE(PG8_SA(0, 1), a2 + hstep, voffA);
            PG8_WAIT_L(8); PG8_BAR; PG8_WAIT_L(0); PG8_MMA(0, 0, At, B0); PG8_BAR; PG8_SCHED;
            PG8_LDB(B1, 1, 1); PG8_STAGE(PG8_SB(1, 0), b3, voffB);
            PG8_BAR; PG8_WAIT_L(0); PG8_MMA(0, 1, At, B1); PG8_BAR;
            PG8_LDA(At, 1, 1); PG8_STAGE(PG8_SA(1, 0), a3, voffA);
            PG8_BAR; PG8_WAIT_L(0); PG8_MMA(1, 0, At, B0); PG8_BAR; PG8_SCHED;
            PG8_STAGE(PG8_SB(1, 1), b3 + hstep, voffB);
            PG8_WAIT_V(6); PG8_BAR; PG8_MMA(1, 1, At, B1); PG8_BAR;
            }
        }
        if constexpr (ALIGN_EPI) { if (wr == 0) PG8_BAR; }
        if constexpr (!Epi::AFTER_DRAIN) { E(acc, cur, wr, wc, fr, fq); S.done(cur); }
        if (!has_next) break;
#pragma unroll
        for (int a = 0; a < 2; ++a)
#pragma unroll
            for (int b = 0; b < 2; ++b)
#pragma unroll
                for (int m = 0; m < 4; ++m)
#pragma unroll
                    for (int n = 0; n < 2; ++n) acc[a][b][m][n] = (f32x4){0.f, 0.f, 0.f, 0.f};
        cur = nxt; cA = nA; cB = nB; ++ui;
        if constexpr (ALIGN_EPI) { if (wr == 1) PG8_BAR; }
    }
    PG8_WAIT_V(0);
    if constexpr (!ALIGN_EPI) { if (wr == 0) PG8_BAR; }
    PG8_BAR;
    if constexpr (Epi::AFTER_DRAIN) { E.fused(acc, cur, wr, wc, fr, fq, lds, wid, lane); S.done(cur); }
#undef PG8_SA
#undef PG8_SB
#undef PG8_STAGE
#undef PG8_LDA
#undef PG8_LDB
#undef PG8_MMA
#undef PG8_WAIT_V
#undef PG8_WAIT_L
#undef PG8_BAR
#undef PG8_SCHED
}
}

constexpr int SEQ = 8192, DM = 2048, INW = 10320, INW_PAD = 10496;
constexpr int AW = 1024, NIH = 16, IHD = 64, TOPK = 256, GW = 1024;
constexpr int PE_H = 8, PE_NK = 128, PE_TOPK = 16, PE_NE = 16384, PLE = 256;
constexpr float LN_EPS = 1e-5f;
constexpr float ALPHA = 1.189207115002721f;
constexpr float QSCALE = 0.08838834764831845f * 1.4426950408889634f;
constexpr int NWAVES = 8, NTHREADS = 512;
constexpr int LDS_BYTES = 147456;
constexpr int LDS_BARST = LDS_BYTES - 64;

constexpr size_t MiB = 1u << 20;
constexpr size_t WS_CTL = 0, CTL_ZERO_BYTES = 65536;
constexpr size_t WS_WA = 1 * MiB, WS_WG = 5 * MiB, WS_WMIX = 9 * MiB, WS_WQ = 17 * MiB, WS_WPG = 25 * MiB, WS_WPP = 33 * MiB, WS_SUBK = 34 * MiB;
constexpr size_t WS_PU = 35 * MiB, WS_PV = 99 * MiB, WS_STATS = 163 * MiB;
constexpr size_t WS_WIN = 164 * MiB, WS_HB = 205 * MiB;
constexpr size_t WS_Q = 237 * MiB, WS_KV = 253 * MiB, WS_QI = 285 * MiB, WS_KIWI = 301 * MiB;
constexpr size_t WS_GU = 305 * MiB, WS_GV = 321 * MiB, WS_GA = 337 * MiB, WS_GG = 369 * MiB;
constexpr size_t WS_GM = 401 * MiB, WS_ATT = 417 * MiB, WS_SC = 433 * MiB, WS_PB = 497 * MiB;
constexpr size_t WS_T = 164 * MiB, WS_MERGED = 237 * MiB, WS_H1F = 269 * MiB, WS_H1B = 333 * MiB, WS_PQ = 365 * MiB;
constexpr size_t WS_RF = 164 * MiB, WS_RB = 228 * MiB, WS_T2 = 405 * MiB;
constexpr size_t WS_PSC = 163 * MiB + 131072;
constexpr size_t WS_MASK = 501 * MiB;
constexpr size_t WS_END = 512 * MiB;

#define GAS __attribute__((address_space(1)))
#define LAS __attribute__((address_space(3)))
typedef unsigned short bf16;
typedef unsigned v4u __attribute__((ext_vector_type(4)));
typedef unsigned v2u __attribute__((ext_vector_type(2)));
typedef float f32x4 __attribute__((ext_vector_type(4)));
typedef float f32x2 __attribute__((ext_vector_type(2)));
typedef float f32x16 __attribute__((ext_vector_type(16)));
typedef short bf16x8 __attribute__((ext_vector_type(8)));
typedef __attribute__((ext_vector_type(2))) __bf16 bf2v;
#define LDS_WAIT() asm volatile("s_waitcnt lgkmcnt(0)" ::: "memory")
#define VM_WAIT() asm volatile("s_waitcnt vmcnt(0)" ::: "memory")

__device__ __forceinline__ unsigned f2bf(float f) { unsigned u = __builtin_bit_cast(unsigned, f); return (u + 0x7fffu + ((u >> 16) & 1u)) >> 16; }
typedef __bf16 bf16x2_t __attribute__((ext_vector_type(2)));
__device__ __forceinline__ unsigned pk2(float lo, float hi) { const f32x2 v = {lo, hi}; return __builtin_bit_cast(unsigned, __builtin_convertvector(v, bf16x2_t)); }
__device__ __forceinline__ float bflo(unsigned u) { return __builtin_bit_cast(float, u << 16); }
__device__ __forceinline__ float bfhi(unsigned u) { return __builtin_bit_cast(float, u & 0xffff0000u); }
__device__ __forceinline__ float bf2f(bf16 h) { return __builtin_bit_cast(float, (unsigned)h << 16); }
__device__ __forceinline__ float fast_rcp(float x) { return __builtin_amdgcn_rcpf(x); }
__device__ __forceinline__ float sigmoidf_(float x) { return fast_rcp(1.f + __expf(-x)); }
__device__ __forceinline__ float gelu_tanh(float x) { const float u = 1.5957691216057308f * (x + 0.044715f * x * x * x); return x * fast_rcp(1.f + __expf(-u)); }
__device__ __forceinline__ float wave_sum(float v) {
#pragma unroll
    for (int o = 1; o < 64; o <<= 1) v += __shfl_xor(v, o);
    return v;
}
__device__ __forceinline__ float dot2bf(unsigned a, unsigned b, float c) { return __builtin_amdgcn_fdot2_f32_bf16(__builtin_bit_cast(bf2v, a), __builtin_bit_cast(bf2v, b), c, false); }
__device__ __forceinline__ unsigned sortable(float f) { const unsigned u = __builtin_bit_cast(unsigned, f); return (u & 0x80000000u) ? ~u : (u | 0x80000000u); }

typedef const __attribute__((address_space(4))) unsigned char* kargp_t;
__device__ __forceinline__ unsigned long long karg_u64(int byte_off) {
    kargp_t ka = (kargp_t)__builtin_amdgcn_kernarg_segment_ptr();
    asm volatile("" : "+s"(ka));
    return *(const __attribute__((address_space(4))) unsigned long long*)(ka + byte_off);
}
struct Frame {
    LAS unsigned char* lds;
    int tid, lane, wave, G, bid;
    float* out; unsigned char* ws;
    __device__ __forceinline__ const float* in(int k) const { return (const float*)karg_u64(8 * k); }
};
#define MAKE_FRAME(F) Frame F; { int t_ = threadIdx.x; asm volatile("" : "+v"(t_)); F.tid = t_; F.lane = t_ & 63; F.wave = __builtin_amdgcn_readfirstlane(t_ >> 6); \
    F.G = gridDim.x; F.bid = blockIdx.x; F.lds = (LAS unsigned char*)lds_raw; F.out = (float*)karg_u64(192); F.ws = (unsigned char*)karg_u64(200); }

__device__ __forceinline__ int win_dest(int n) { return n < 4096 ? n : (n < 4176 ? n + 6144 : n - 80); }
template <bool MAP>
__device__ __forceinline__ void p0_transpose_item(const float* W, int K, int N, bf16* WT, LAS float* scr, int item, int lane) {
    const int nblk = (N + 31) / 32, kb = item / nblk, nb = item % nblk, k0 = 64 * kb, n0 = 32 * nb;
    const int nn = n0 + (lane & 31); const bool ok = nn < N;
#pragma unroll 8
    for (int i = 0; i < 32; ++i) { const int kk = 2 * i + (lane >> 5); scr[kk * 33 + (lane & 31)] = ok ? W[(size_t)(k0 + kk) * N + nn] : 0.f; }
    LDS_WAIT(); asm volatile("" ::: "memory");
    const int c = lane & 7;
#pragma unroll
    for (int j = 0; j < 4; ++j) { const int n = (lane >> 3) + 8 * j; const LAS float* s = scr + (8 * c) * 33 + n;
        v4u o; o.x = pk2(s[0 * 33], s[1 * 33]); o.y = pk2(s[2 * 33], s[3 * 33]); o.z = pk2(s[4 * 33], s[5 * 33]); o.w = pk2(s[6 * 33], s[7 * 33]);
        if (n0 + n < N) { const int drow = MAP ? win_dest(n0 + n) : (n0 + n); *(GAS v4u*)(WT + (size_t)drow * K + k0 + 8 * c) = o; } }
    LDS_WAIT(); asm volatile("" ::: "memory");
}
__device__ __forceinline__ void p0_convert(Frame& F, const float* src, bf16* dst, size_t n) {
    const size_t nth = (size_t)F.G * NTHREADS, n8 = n / 8;
    for (size_t i = (size_t)F.bid * NTHREADS + F.tid; i < n8; i += nth) {
        const f32x4 a = ((const GAS f32x4*)src)[2 * i], b = ((const GAS f32x4*)src)[2 * i + 1];
        v4u o; o.x = pk2(a.x, a.y); o.y = pk2(a.z, a.w); o.z = pk2(b.x, b.y); o.w = pk2(b.z, b.w);
        ((GAS v4u*)dst)[i] = o; }
}
__device__ __forceinline__ void ln_row(Frame& F, const float* xrow, const float* g, const float* b, bf16* ob, float* of, float* stats) {
    const GAS f32x4* xr = (const GAS f32x4*)xrow + F.lane;
    f32x4 v[8]; float s = 0.f;
#pragma unroll
    for (int j = 0; j < 8; ++j) { v[j] = xr[64 * j]; s += (v[j].x + v[j].y) + (v[j].z + v[j].w); }
    const float mean = wave_sum(s) * (1.f / DM); float s2 = 0.f;
#pragma unroll
    for (int j = 0; j < 8; ++j) { v[j] = v[j] - mean; s2 += (v[j].x * v[j].x + v[j].y * v[j].y) + (v[j].z * v[j].z + v[j].w * v[j].w); }
    const float rstd = 1.f / sqrtf(wave_sum(s2) * (1.f / DM) + LN_EPS);
    if (stats && F.lane == 0) { stats[0] = mean; stats[1] = rstd; }
#pragma unroll
    for (int j = 0; j < 8; ++j) {
        const f32x4 gg = ((const GAS f32x4*)g)[64 * j + F.lane], bb = ((const GAS f32x4*)b)[64 * j + F.lane];
        const f32x4 y = v[j] * rstd * gg + bb;
        if (ob) { v2u o; o.x = pk2(y.x, y.y); o.y = pk2(y.z, y.w); ((GAS v2u*)ob)[64 * j + F.lane] = o; }
        if (of) ((GAS f32x4*)of)[64 * j + F.lane] = y;
    }
}
__device__ __forceinline__ void p0_prologue(Frame& F) {
    LAS float* scr = (LAS float*)(F.lds + F.wave * 16384);
    const int gw = F.bid * NWAVES + F.wave, NGW = F.G * NWAVES;
    unsigned char* ws = F.ws;
    constexpr int I_IN = (DM / 64) * ((INW + 31) / 32), I_A = (AW / 64) * (DM / 32), I_G = (GW / 64) * (DM / 32), I_SQ = (DM / 64) * (DM / 32), I_PP = (PLE / 64) * (DM / 32);
    constexpr int NITEMS = I_IN + I_A + I_G + 3 * I_SQ + I_PP;
    for (int it = gw; it < NITEMS; it += NGW) {
        int r = it;
        if (r < I_IN) { p0_transpose_item<true>(F.in(6), DM, INW, (bf16*)(ws + WS_WIN), scr, r, F.lane); continue; } r -= I_IN;
        if (r < I_A) { p0_transpose_item<false>(F.in(11), AW, DM, (bf16*)(ws + WS_WA), scr, r, F.lane); continue; } r -= I_A;
        if (r < I_G) { p0_transpose_item<false>(F.in(12), GW, DM, (bf16*)(ws + WS_WG), scr, r, F.lane); continue; } r -= I_G;
        if (r < I_SQ) { p0_transpose_item<false>(F.in(13), DM, DM, (bf16*)(ws + WS_WMIX), scr, r, F.lane); continue; } r -= I_SQ;
        if (r < I_SQ) { p0_transpose_item<false>(F.in(16), DM, DM, (bf16*)(ws + WS_WQ), scr, r, F.lane); continue; } r -= I_SQ;
        if (r < I_SQ) { p0_transpose_item<false>(F.in(21), DM, DM, (bf16*)(ws + WS_WPG), scr, r, F.lane); continue; } r -= I_SQ;
        p0_transpose_item<false>(F.in(20), PLE, DM, (bf16*)(ws + WS_WPP), scr, r, F.lane);
    }
    { const size_t n16 = (size_t)(INW_PAD - INW) * DM * 2 / 16; GAS v4u* z = (GAS v4u*)(ws + WS_WIN + (size_t)INW * DM * 2);
      for (size_t i = (size_t)F.bid * NTHREADS + F.tid; i < n16; i += (size_t)F.G * NTHREADS) z[i] = (v4u){0u, 0u, 0u, 0u}; }
    for (int row = gw; row < 2 * PE_NE; row += NGW) { const int tb = row >= PE_NE ? 1 : 0, r = row - tb * PE_NE;
        const GAS f32x4* src = (const GAS f32x4*)((tb ? F.in(19) : F.in(18)) + (size_t)r * DM) + F.lane;
        f32x4 v[8]; float mx = 0.f;
#pragma unroll
        for (int j = 0; j < 8; ++j) { v[j] = src[64 * j]; mx = fmaxf(mx, fmaxf(fmaxf(fabsf(v[j].x), fabsf(v[j].y)), fmaxf(fabsf(v[j].z), fabsf(v[j].w)))); }
#pragma unroll
        for (int o = 1; o < 64; o <<= 1) mx = fmaxf(mx, __shfl_xor(mx, o));
        float sc = 1.f;
        if (mx > 1e-30f) sc = __builtin_bit_cast(float, __builtin_bit_cast(unsigned, 224.f / mx) & 0x7f800000u);
        if (F.lane == 0) ((float*)(ws + WS_PSC))[row] = 1.f / sc;
        GAS unsigned* dst = (GAS unsigned*)(ws + (tb ? WS_PV : WS_PU) + (size_t)r * DM) + F.lane;
#pragma unroll
        for (int j = 0; j < 8; ++j) { int w = __builtin_amdgcn_cvt_pk_fp8_f32(v[j].x * sc, v[j].y * sc, 0, false); w = __builtin_amdgcn_cvt_pk_fp8_f32(v[j].z * sc, v[j].w * sc, w, true); dst[64 * j] = (unsigned)w; }
    }
    p0_convert(F, F.in(17), (bf16*)(ws + WS_SUBK), (size_t)PE_H * 2 * PE_NK * 128);
    p0_convert(F, F.in(1), (bf16*)(ws + WS_PB), (size_t)SEQ * PLE);
    for (int m = gw; m < SEQ; m += NGW) ln_row(F, F.in(0) + (size_t)m * DM, F.in(3), F.in(4), (bf16*)(ws + WS_HB) + (size_t)m * DM, nullptr, (float*)(ws + WS_STATS) + 2 * m);
}

typedef GAS unsigned gu32;
#define XB_TMO      128
#define XB_XCNT(j)  (256  + 64 * (j))
#define XB_XSUB(j)  (1280 + 64 * (j))
#define XB_XGEN(j)  (2304 + 64 * (j))
#define XB_TOP      3328
#define XB_TOPGEN   3392
#define XCD_BAR_WORDS 3456
#define XB_SPIN_CAP (1u << 18)

__device__ __forceinline__ unsigned xb_ld(unsigned* p)              { return __hip_atomic_load(p, __ATOMIC_RELAXED, __HIP_MEMORY_SCOPE_AGENT); }
__device__ __forceinline__ unsigned xb_add(unsigned* p, unsigned v) { return __hip_atomic_fetch_add(p, v, __ATOMIC_RELAXED, __HIP_MEMORY_SCOPE_AGENT); }
__device__ __forceinline__ unsigned xb_xcc_id() { return (unsigned)__builtin_amdgcn_s_getreg((3 << 11) | 20) & 0xFu; }
#define XB_SPIN(cond, bar) do { unsigned _sp = 0; while (cond) { __builtin_amdgcn_s_sleep(1); \
    if ((++_sp & 255u) == 0u) { if (xb_ld(&(bar)[XB_TMO])) break; if (_sp > XB_SPIN_CAP) { atomicAdd(&(bar)[XB_TMO], 1u); break; } } } } while (0)

struct XcdBarrier {
    unsigned* bar; unsigned x;
    volatile LAS unsigned* st;
};

__device__ __forceinline__ XcdBarrier xcd_barrier_post(unsigned* bar, volatile LAS unsigned* st) {
    XcdBarrier b; b.bar = bar; b.x = xb_xcc_id(); b.st = st;
    if (threadIdx.x == 0) (void)xb_add(&bar[XB_XCNT(b.x)], 1u);
    return b;
}
__device__ __forceinline__ void xcd_barrier_complete(unsigned* bar, unsigned x, unsigned& nloc, unsigned& nx) {
    const unsigned G = gridDim.x * gridDim.y * gridDim.z;
    unsigned sum, cnt, mine, sp = 0u;
    for (;;) {
        sum = 0u; cnt = 0u; mine = 0u;
#pragma unroll
        for (unsigned j = 0; j < 16; ++j) { const unsigned c = xb_ld(&bar[XB_XCNT(j)]); sum += c; cnt += (c > 0u) ? 1u : 0u; mine = (j == x) ? c : mine; }
        if (sum == G) break;
        __builtin_amdgcn_s_sleep(1);
        if ((++sp & 255u) == 0u) { if (xb_ld(&bar[XB_TMO])) break; if (sp > XB_SPIN_CAP) { atomicAdd(&bar[XB_TMO], 1u); break; } }
    }
    nloc = mine > 0u ? mine : 1u; nx = cnt > 0u ? cnt : 1u;
}

__device__ __forceinline__ void xcd_barrier(const XcdBarrier& b) {
    asm volatile("s_waitcnt vmcnt(0)" ::: "memory");
    __syncthreads();
    if (threadIdx.x == 0) {
        unsigned* bar = b.bar;
        __builtin_amdgcn_s_waitcnt(0);
        unsigned nloc = b.st[0], nx = b.st[1];
        if (nloc == 0u) { xcd_barrier_complete(bar, b.x, nloc, nx); b.st[0] = nloc; b.st[1] = nx; }
        const unsigned old = xb_add(&bar[XB_XSUB(b.x)], 1u);
        const unsigned gen = old / nloc;
        if (old + 1u == (gen + 1u) * nloc) {
            __builtin_amdgcn_fence(__ATOMIC_RELEASE, "agent");
            asm volatile("s_waitcnt vmcnt(0)" ::: "memory");
            const unsigned og = xb_add(&bar[XB_TOP], 1u);
            const unsigned tg = og / nx;
            if (og + 1u == (tg + 1u) * nx) xb_add(&bar[XB_TOPGEN], 1u);
            else XB_SPIN(xb_ld(&bar[XB_TOPGEN]) == tg, bar);
            __builtin_amdgcn_fence(__ATOMIC_ACQUIRE, "agent");
            xb_add(&bar[XB_XGEN(b.x)], 1u);
            asm volatile("s_waitcnt vmcnt(0)" ::: "memory");
        } else {
            XB_SPIN(xb_ld(&bar[XB_XGEN(b.x)]) == gen, bar);
            __builtin_amdgcn_fence(__ATOMIC_ACQUIRE, "agent");
            asm volatile("s_waitcnt vmcnt(0)" ::: "memory");
        }
    }
    __syncthreads();
}

namespace pg8 {
struct EpiWin {
    static constexpr bool PERM = true, AFTER_DRAIN = false;
    bf16 *q, *kv, *qi, *gu, *gv, *ga, *gg, *kiwi;
    __device__ __forceinline__ void operator()(const f32x4 (&acc)[2][2][4][2], const Unit& u, int wr, int wc, int fr, int fq) const {
        const int pn = u.pn; bf16* base; int ld, colt, act = 0; float sc = 1.f;
        if (pn < 4) { base = q; ld = 1024; colt = pn * 256; sc = QSCALE; }
        else if (pn < 12) { base = kv; ld = 2048; colt = (pn - 4) * 256; }
        else if (pn < 16) { base = qi; ld = 1024; colt = (pn - 12) * 256; }
        else if (pn < 20) { base = gu; ld = 1024; colt = (pn - 16) * 256; act = 1; }
        else if (pn < 24) { base = gv; ld = 1024; colt = (pn - 20) * 256; act = 1; }
        else if (pn < 32) { base = ga; ld = 2048; colt = (pn - 24) * 256; act = 2; }
        else if (pn < 40) { base = gg; ld = 2048; colt = (pn - 32) * 256; act = 2; }
        else { base = kiwi; ld = 256; colt = 0; }
        const int row0 = u.pm * BM + wr * 64 + fr, col0 = colt + wc * 32 + 8 * fq;
#pragma unroll
        for (int ai = 0; ai < 2; ++ai)
#pragma unroll
            for (int m = 0; m < 4; ++m) { bf16* rowp = base + (size_t)(row0 + ai * HALF + m * 16) * ld + col0;
#pragma unroll
                for (int bj = 0; bj < 2; ++bj) { f32x4 v0 = acc[ai][bj][m][0], v1 = acc[ai][bj][m][1];
                    if (act == 1) {
#pragma unroll
                        for (int e = 0; e < 4; ++e) { v0[e] = gelu_tanh(v0[e]); v1[e] = gelu_tanh(v1[e]); } }
                    else if (act == 2) {
#pragma unroll
                        for (int e = 0; e < 4; ++e) { v0[e] = sigmoidf_(v0[e]); v1[e] = sigmoidf_(v1[e]); } }
                    else { v0 = v0 * sc; v1 = v1 * sc; }
                    v4u w; w.x = pk2(v0[0], v0[1]); w.y = pk2(v0[2], v0[3]); w.z = pk2(v1[0], v1[1]); w.w = pk2(v1[2], v1[3]);
                    *(GAS v4u*)(rowp + bj * HALF) = w; } }
    }
};
struct EpiGateF32 {
    static constexpr bool PERM = true, AFTER_DRAIN = false;
    const bf16* gate; float* T; int ldc;
    __device__ __forceinline__ void operator()(const f32x4 (&acc)[2][2][4][2], const Unit& u, int wr, int wc, int fr, int fq) const {
        const int row0 = u.pm * BM + wr * 64 + fr, col0 = u.pn * BM + wc * 32 + 8 * fq;
#pragma unroll
        for (int ai = 0; ai < 2; ++ai)
#pragma unroll
            for (int m = 0; m < 4; ++m) { const size_t off = (size_t)(row0 + ai * HALF + m * 16) * ldc + col0;
#pragma unroll
                for (int bj = 0; bj < 2; ++bj) { const v4u g = *(const GAS v4u*)(gate + off + bj * HALF);
                    f32x4 v0 = acc[ai][bj][m][0], v1 = acc[ai][bj][m][1];
                    v0[0] *= bflo(g.x); v0[1] *= bfhi(g.x); v0[2] *= bflo(g.y); v0[3] *= bfhi(g.y);
                    v1[0] *= bflo(g.z); v1[1] *= bfhi(g.z); v1[2] *= bflo(g.w); v1[3] *= bfhi(g.w);
                    *(GAS f32x4*)(T + off + bj * HALF) = v0; *(GAS f32x4*)(T + off + bj * HALF + 4) = v1; } }
    }
};
struct EpiMerge {
    static constexpr bool PERM = true, AFTER_DRAIN = false;
    const bf16* gate; const float* T; bf16* O; int ldc;
    __device__ __forceinline__ void operator()(const f32x4 (&acc)[2][2][4][2], const Unit& u, int wr, int wc, int fr, int fq) const {
        const int row0 = u.pm * BM + wr * 64 + fr, col0 = u.pn * BM + wc * 32 + 8 * fq;
#pragma unroll
        for (int ai = 0; ai < 2; ++ai)
#pragma unroll
            for (int m = 0; m < 4; ++m) { const size_t off = (size_t)(row0 + ai * HALF + m * 16) * ldc + col0;
#pragma unroll
                for (int bj = 0; bj < 2; ++bj) { const v4u g = *(const GAS v4u*)(gate + off + bj * HALF);
                    const f32x4 t0 = *(const GAS f32x4*)(T + off + bj * HALF), t1 = *(const GAS f32x4*)(T + off + bj * HALF + 4);
                    f32x4 v0 = acc[ai][bj][m][0], v1 = acc[ai][bj][m][1];
                    v0[0] = t0[0] + v0[0] * bflo(g.x); v0[1] = t0[1] + v0[1] * bfhi(g.x); v0[2] = t0[2] + v0[2] * bflo(g.y); v0[3] = t0[3] + v0[3] * bfhi(g.y);
                    v1[0] = t1[0] + v1[0] * bflo(g.z); v1[1] = t1[1] + v1[1] * bfhi(g.z); v1[2] = t1[2] + v1[2] * bflo(g.w); v1[3] = t1[3] + v1[3] * bfhi(g.w);
                    v4u w; w.x = pk2(v0[0], v0[1]); w.y = pk2(v0[2], v0[3]); w.z = pk2(v1[0], v1[1]); w.w = pk2(v1[2], v1[3]);
                    *(GAS v4u*)(O + off + bj * HALF) = w; } }
    }
};
struct EpiMix {
    static constexpr bool PERM = false, AFTER_DRAIN = false;
    const float* x; const float* stats; const float* g; const float* b; float* Y; int ldc;
    __device__ __forceinline__ void operator()(const f32x4 (&acc)[2][2][4][2], const Unit& u, int wr, int wc, int fr, int fq) const {
        const int row0 = u.pm * BM + wr * 64 + fr, col0 = u.pn * BM + wc * 32 + 4 * fq;
        f32x4 gv[2][2], bv[2][2];
#pragma unroll
        for (int bj = 0; bj < 2; ++bj)
#pragma unroll
            for (int n = 0; n < 2; ++n) { gv[bj][n] = *(const GAS f32x4*)(g + col0 + bj * HALF + n * 16); bv[bj][n] = *(const GAS f32x4*)(b + col0 + bj * HALF + n * 16); }
#pragma unroll
        for (int ai = 0; ai < 2; ++ai)
#pragma unroll
            for (int m = 0; m < 4; ++m) { const int r = row0 + ai * HALF + m * 16; const size_t off = (size_t)r * ldc + col0;
                const float mean = stats[2 * r], rstd = stats[2 * r + 1];
#pragma unroll
                for (int bj = 0; bj < 2; ++bj)
#pragma unroll
                    for (int n = 0; n < 2; ++n) { const f32x4 xv = *(const GAS f32x4*)(x + off + bj * HALF + n * 16);
                        const f32x4 h = (xv - mean) * rstd * gv[bj][n] + bv[bj][n];
                        *(GAS f32x4*)(Y + off + bj * HALF + n * 16) = h * ALPHA + acc[ai][bj][m][n] * DBG_MIX_S; } }
    }
};
struct EpiF32 {
    static constexpr bool PERM = false, AFTER_DRAIN = false;
    float* Y; int ldc;
    __device__ __forceinline__ void operator()(const f32x4 (&acc)[2][2][4][2], const Unit& u, int wr, int wc, int fr, int fq) const {
        const int row0 = u.pm * BM + wr * 64 + fr, col0 = u.pn * BM + wc * 32 + 4 * fq;
#pragma unroll
        for (int ai = 0; ai < 2; ++ai)
#pragma unroll
            for (int m = 0; m < 4; ++m) { const size_t off = (size_t)(row0 + ai * HALF + m * 16) * ldc + col0;
#pragma unroll
                for (int bj = 0; bj < 2; ++bj)
#pragma unroll
                    for (int n = 0; n < 2; ++n) *(GAS f32x4*)(Y + off + bj * HALF + n * 16) = acc[ai][bj][m][n]; }
    }
};
struct EpiPle {
    static constexpr bool PERM = false, AFTER_DRAIN = false;
    const float* R; const float* T2; float* Y; int ldc;
    __device__ __forceinline__ void operator()(const f32x4 (&acc)[2][2][4][2], const Unit& u, int wr, int wc, int fr, int fq) const {
        const int row0 = u.pm * BM + wr * 64 + fr, col0 = u.pn * BM + wc * 32 + 4 * fq;
#pragma unroll
        for (int ai = 0; ai < 2; ++ai)
#pragma unroll
            for (int m = 0; m < 4; ++m) { const size_t off = (size_t)(row0 + ai * HALF + m * 16) * ldc + col0;
#pragma unroll
                for (int bj = 0; bj < 2; ++bj)
#pragma unroll
                    for (int n = 0; n < 2; ++n) { const f32x4 rv = *(const GAS f32x4*)(R + off + bj * HALF + n * 16), tv = *(const GAS f32x4*)(T2 + off + bj * HALF + n * 16);
                        const f32x4 a = acc[ai][bj][m][n]; f32x4 o;
#pragma unroll
                        for (int e = 0; e < 4; ++e) o[e] = rv[e] + DBG_PLE_S * sigmoidf_(a[e]) * tv[e];
                        *(GAS f32x4*)(Y + off + bj * HALF + n * 16) = o; } }
    }
};
}

__device__ __forceinline__ f32x16 mfma32(bf16x8 a, bf16x8 b, f32x16 c) { return __builtin_amdgcn_mfma_f32_32x32x16_bf16(a, b, c, 0, 0, 0); }
__device__ __forceinline__ void unpack8(const v4u a, float (&x)[8]) { x[0] = bflo(a.x); x[1] = bfhi(a.x); x[2] = bflo(a.y); x[3] = bfhi(a.y); x[4] = bflo(a.z); x[5] = bfhi(a.z); x[6] = bflo(a.w); x[7] = bfhi(a.w); }

__device__ __forceinline__ void gmlp_unit(Frame& F, int unit) {
    const int n = unit >> 3, g = unit & 7, row0 = n * 128;
    const bf16* gvb = (const bf16*)(F.ws + WS_GV); const bf16* gub = (const bf16*)(F.ws + WS_GU); bf16* gm = (bf16*)(F.ws + WS_GM);
    LAS float* st = (LAS float*)F.lds;
    LAS bf16* VT = (LAS bf16*)(F.lds + 1024);
    for (int i = 0; i < 16; ++i) { const int r = F.wave * 16 + i;
        const GAS v4u* rp = (const GAS v4u*)(gvb + (size_t)(row0 + r) * GW);
        const v4u a = rp[F.lane], b = rp[64 + F.lane];
        float x[16]; { float t0[8], t1[8]; unpack8(a, t0); unpack8(b, t1);
#pragma unroll
            for (int e = 0; e < 8; ++e) { x[e] = t0[e]; x[8 + e] = t1[e]; } }
        float s = 0.f;
#pragma unroll
        for (int e = 0; e < 16; ++e) s += x[e];
        const float mean = wave_sum(s) * (1.f / GW); float s2 = 0.f;
#pragma unroll
        for (int e = 0; e < 16; ++e) { const float d = x[e] - mean; s2 += d * d; }
        const float rstd = 1.f / sqrtf(wave_sum(s2) * (1.f / GW) + LN_EPS);
        if (F.lane == 0) { st[2 * r] = mean; st[2 * r + 1] = rstd; } }
    __syncthreads();
    const float* lg = F.in(7) + g * 128; const float* lb = F.in(8) + g * 128;
#pragma unroll
    for (int i = 0; i < 4; ++i) { const int id = F.tid + 512 * i, s = id >> 4, c8 = id & 15;
        const v4u a = *(const GAS v4u*)(gvb + (size_t)(row0 + s) * GW + g * 128 + c8 * 8);
        float x[8]; unpack8(a, x);
        const float mean = st[2 * s], rstd = st[2 * s + 1];
        const f32x4 g0 = *(const GAS f32x4*)(lg + c8 * 8), g1 = *(const GAS f32x4*)(lg + c8 * 8 + 4), b0 = *(const GAS f32x4*)(lb + c8 * 8), b1 = *(const GAS f32x4*)(lb + c8 * 8 + 4);
#pragma unroll
        for (int e = 0; e < 8; ++e) { const float gg = e < 4 ? g0[e & 3] : g1[e & 3], bb = e < 4 ? b0[e & 3] : b1[e & 3];
            VT[(c8 * 8 + e) * 136 + s] = (bf16)f2bf((x[e] - mean) * rstd * gg + bb); } }
    __syncthreads();
    const int r = F.lane & 31, hh = F.lane >> 5, tt = F.wave >> 1, ct0 = (F.wave & 1) * 2;
    f32x16 acc0, acc1;
#pragma unroll
    for (int e = 0; e < 16; ++e) { acc0[e] = 0.f; acc1[e] = 0.f; }
    const float* wsm = F.in(9) + (size_t)g * 128 * 128;
    const int t = tt * 32 + r;
    for (int ks = 0; ks < (tt + 1) * 2; ++ks) {
        const int k0 = ks * 16 + 8 * hh;
        const f32x4 w0 = *(const GAS f32x4*)(wsm + t * 128 + k0), w1 = *(const GAS f32x4*)(wsm + t * 128 + k0 + 4);
        float wv[8] = {w0.x, w0.y, w0.z, w0.w, w1.x, w1.y, w1.z, w1.w};
#pragma unroll
        for (int e = 0; e < 8; ++e) if (k0 + e > t) wv[e] = 0.f;
        v4u ap; ap.x = pk2(wv[0], wv[1]); ap.y = pk2(wv[2], wv[3]); ap.z = pk2(wv[4], wv[5]); ap.w = pk2(wv[6], wv[7]);
        const bf16x8 A = __builtin_bit_cast(bf16x8, ap);
        const bf16x8 B0 = *(const LAS bf16x8*)(VT + (ct0 * 32 + r) * 136 + k0), B1 = *(const LAS bf16x8*)(VT + ((ct0 + 1) * 32 + r) * 136 + k0);
        acc0 = mfma32(A, B0, acc0); acc1 = mfma32(A, B1, acc1);
    }
    const float* bs = F.in(10) + g * 128;
#pragma unroll
    for (int reg = 0; reg < 16; ++reg) { const int tr = tt * 32 + (reg & 3) + 8 * (reg >> 2) + 4 * hh; const float bsv = bs[tr];
        const size_t o0 = (size_t)(row0 + tr) * GW + g * 128 + ct0 * 32 + r;
#if DBG_GMLP_X2
        acc0[reg] *= 2.f; acc1[reg] *= 2.f;
#endif
#if DBG_NO_GMLP
        acc0[reg] = 0.f; acc1[reg] = 0.f;
#endif
        gm[o0] = (bf16)f2bf(bf2f(gub[o0]) * (acc0[reg] + bsv));
        gm[o0 + 32] = (bf16)f2bf(bf2f(gub[o0 + 32]) * (acc1[reg] + bsv)); }
    __syncthreads();
}

__device__ __constant__ unsigned char REL_BUCKET[128] = {0, 1, 2, 3, 4, 5, 6, 7, 8, 9, 10, 11, 12, 13, 14, 15, 16, 16, 16, 17, 17, 18, 18, 18, 19, 19, 19, 20, 20, 20, 20, 21, 21, 21, 21, 22, 22, 22, 22, 22, 23, 23, 23, 23, 23, 23, 24, 24, 24, 24, 24, 24, 25, 25, 25, 25, 25, 25, 25, 26, 26, 26, 26, 26, 26, 26, 26, 27, 27, 27, 27, 27, 27, 27, 27, 27, 27, 28, 28, 28, 28, 28, 28, 28, 28, 28, 28, 29, 29, 29, 29, 29, 29, 29, 29, 29, 29, 29, 29, 30, 30, 30, 30, 30, 30, 30, 30, 30, 30, 30, 30, 30, 30, 31, 31, 31, 31, 31, 31, 31, 31, 31, 31, 31, 31, 31, 31, 31};
constexpr int KI_PITCH = 144;
constexpr unsigned NEG_KEY = 0x007FFFFFu;
__device__ __forceinline__ int mbcnt64(unsigned long long m) { return __builtin_amdgcn_mbcnt_hi((unsigned)(m >> 32), __builtin_amdgcn_mbcnt_lo((unsigned)m, 0u)); }

#define IDX_LOAD_TILE(t_) do { _Pragma("unroll") for (int i_ = 0; i_ < 4; ++i_) { const int id_ = F.tid + 512 * i_; \
    stg[i_] = *(const GAS v4u*)(kiwi + (size_t)((t_) * 256 + (id_ >> 3)) * 256 + (id_ & 7) * 8); } } while (0)

__device__ __forceinline__ void idx_unit(Frame& F, int unit) {
    const int q0 = unit * 16;
    const int kend = ((q0 + 15) / 32 + 1) * 32;
    const int nkt = (kend + 255) >> 8;
    const bf16* qi = (const bf16*)(F.ws + WS_QI); const bf16* kiwi = (const bf16*)(F.ws + WS_KIWI);
    const int* pos = (const int*)F.in(2);
    float* scr = (F.bid < 128) ? F.out + (size_t)F.bid * (16 * 8192) : (float*)(F.ws + WS_SC) + (size_t)(F.bid - 128) * (16 * 8192);
    const int r = F.lane & 31, hh = F.lane >> 5;
    const int wq = q0 + 2 * F.wave;
    for (int repA = 0; repA < (DBG_REP_SUB == 1 ? 2 : 1); ++repA) {
        const int aq = wq + ((r >> 2) & 1), ah = (r & 3) + 4 * (r >> 3);
        bf16x8 Af[4];
#pragma unroll
        for (int s = 0; s < 4; ++s) Af[s] = *(const GAS bf16x8*)(qi + (size_t)aq * 1024 + ah * 64 + s * 16 + 8 * hh);
        float wgt[16];
        { const v4u a = *(const GAS v4u*)(kiwi + (size_t)(wq + hh) * 256 + 64), b = *(const GAS v4u*)(kiwi + (size_t)(wq + hh) * 256 + 72);
          float t0[8], t1[8]; unpack8(a, t0); unpack8(b, t1);
#pragma unroll
          for (int e = 0; e < 8; ++e) { wgt[e] = t0[e]; wgt[8 + e] = t1[e]; } }
        const int qpos = pos[wq + hh];
        float* srow = scr + (size_t)(2 * F.wave + hh) * 8192;
        v4u stg[4];
        IDX_LOAD_TILE(0);
        for (int t = 0; t < nkt; ++t) {
            __syncthreads();
#pragma unroll
            for (int i = 0; i < 4; ++i) { const int id = F.tid + 512 * i; *(LAS v4u*)(F.lds + (id >> 3) * KI_PITCH + (id & 7) * 16) = stg[i]; }
            __syncthreads();
            if (t + 1 < nkt) IDX_LOAD_TILE(t + 1);
            for (int sub = 0; sub < 8; ++sub) {
                const int key0 = t * 256 + sub * 32;
                if (key0 >= kend) break;
                f32x16 acc;
#pragma unroll
                for (int e = 0; e < 16; ++e) acc[e] = 0.f;
#pragma unroll
                for (int s = 0; s < 4; ++s) { const bf16x8 B = *(const LAS bf16x8*)(F.lds + (sub * 32 + r) * KI_PITCH + s * 32 + hh * 16); acc = mfma32(Af[s], B, acc); }
                float sc = 0.f;
#pragma unroll
                for (int e = 0; e < 16; ++e) sc += wgt[e] * fmaxf(acc[e], 0.f);
                const int key = key0 + r; const int kp = pos[key];
                srow[key] = (kp <= qpos) ? sc : -__builtin_inff();
            }
        }
    }
    __threadfence(); __syncthreads();
    unsigned long long* maskg = (unsigned long long*)(F.ws + WS_MASK);
    const int kw = 128 * ((q0 >> 7) + 1);
#pragma unroll 1
    for (int qq = 0; qq < (DBG_REP_SUB == 2 ? 4 : 2); ++qq) {
        const int qrow = wq + (qq & 1);
        const float* sr = scr + (size_t)(2 * F.wave + (qq & 1)) * 8192;
        unsigned key[128];
        int ln1 = F.lane; asm volatile("" : "+v"(ln1));
        int ke1 = kend; asm volatile("" : "+s"(ke1));
        const float* srl = sr + ln1;
#pragma unroll
        for (int j = 0; j < 128; ++j) { key[j] = 0x007FFFFEu; if (j * 64 < ke1) key[j] = __builtin_bit_cast(unsigned, __builtin_nontemporal_load(srl + j * 64)); }
        __builtin_amdgcn_sched_barrier(0);
#pragma unroll
        for (int j = 0; j < 128; ++j) { const unsigned u = key[j]; unsigned k = (u & 0x80000000u) ? ~u : (u | 0x80000000u); if (j * 64 + ln1 >= ke1) k = 0u; key[j] = k; }
        unsigned thr = 0u;
        for (int bit = 31; bit >= 16; --bit) { const unsigned cand = thr | (1u << bit); int c0 = 0, c1 = 0, c2 = 0, c3 = 0;
            int ke = kend; asm volatile("" : "+s"(ke));
#pragma unroll
            for (int jb = 0; jb < 16; ++jb) { if (jb * 512 < ke) {
                    c0 += (key[jb * 8 + 0] >= cand) ? 1 : 0; c1 += (key[jb * 8 + 1] >= cand) ? 1 : 0; c2 += (key[jb * 8 + 2] >= cand) ? 1 : 0; c3 += (key[jb * 8 + 3] >= cand) ? 1 : 0;
                    c0 += (key[jb * 8 + 4] >= cand) ? 1 : 0; c1 += (key[jb * 8 + 5] >= cand) ? 1 : 0; c2 += (key[jb * 8 + 6] >= cand) ? 1 : 0; c3 += (key[jb * 8 + 7] >= cand) ? 1 : 0; }
                __builtin_amdgcn_sched_barrier(0); }
            int c = (c0 + c1) + (c2 + c3);
#pragma unroll
            for (int o = 1; o < 64; o <<= 1) c += __shfl_xor(c, o);
            if (c >= TOPK) thr = cand; }
        const unsigned thr_hi = thr + 0x10000u;
        int ngt = 0;
        int ke3 = kend; asm volatile("" : "+s"(ke3));
#pragma unroll
        for (int jb = 0; jb < 16; ++jb) { if (jb * 512 < ke3) {
#pragma unroll
                for (int jj = 0; jj < 8; ++jj) ngt += __builtin_popcountll(__ballot(key[jb * 8 + jj] >= thr_hi && key[jb * 8 + jj] > NEG_KEY)); }
            __builtin_amdgcn_sched_barrier(0); }
        const int need = TOPK - ngt;
        int tie_seen = 0;
        int ke4 = kw; asm volatile("" : "+s"(ke4));
        unsigned long long mw0 = 0ull, mw1 = 0ull;
#pragma unroll
        for (int j = 0; j < 128; ++j) { if (j * 64 < ke4) {
            const bool valid = key[j] > NEG_KEY, gt = valid && key[j] >= thr_hi, eq = valid && key[j] >= thr && key[j] < thr_hi;
            const unsigned long long meq = __ballot(eq);
            const bool take = gt || (eq && (tie_seen + mbcnt64(meq)) < need);
            tie_seen += __builtin_popcountll(meq);
            const unsigned long long m = __ballot(take);
            if (F.lane == (j & 63)) { if (j < 64) mw0 = m; else mw1 = m; } }
            __builtin_amdgcn_sched_barrier(0); }
        if (F.lane * 64 < kw) maskg[(size_t)qrow * 128 + F.lane] = mw0;
        if ((64 + F.lane) * 64 < kw) maskg[(size_t)qrow * 128 + 64 + F.lane] = mw1;
    }
}

typedef short s16x4 __attribute__((ext_vector_type(4)));
__device__ __forceinline__ f32x4 mfma16(bf16x8 a, bf16x8 b, f32x4 c) { return __builtin_amdgcn_mfma_f32_16x16x32_bf16(a, b, c, 0, 0, 0); }
constexpr int ATT_KP = 272, ATT_VP = 288;
constexpr int ATT_KB = 64 * ATT_KP, ATT_VB = 64 * ATT_VP;
constexpr int ATT_VOFF = 2 * ATT_KB, ATT_TAB = ATT_VOFF + 2 * ATT_VB;

#define ATT_LOAD_TILE(t_) do { _Pragma("unroll") for (int i_ = 0; i_ < 2; ++i_) { const int c_ = F.tid + 512 * i_; \
    const bf16* gp_ = kvb + (size_t)((t_) * 64 + (c_ >> 4)) * 2048 + head * 128 + (c_ & 15) * 8; \
    kst[i_] = *(const GAS v4u*)gp_; vst[i_] = *(const GAS v4u*)(gp_ + 1024); } } while (0)

#define ATT_TILE_BODY(NEAR_) \
        LAS unsigned char* Kb = F.lds + (t & 1) * ATT_KB; LAS unsigned char* Vb = F.lds + ATT_VOFF + (t & 1) * ATT_VB; \
        _Pragma("unroll") \
        for (int i = 0; i < 2; ++i) { const int c = F.tid + 512 * i; *(LAS v4u*)(Kb + (c >> 4) * ATT_KP + (c & 15) * 16) = kst[i]; *(LAS v4u*)(Vb + (c >> 4) * ATT_VP + (c & 15) * 16) = vst[i]; } \
        __syncthreads(); \
        const unsigned long long mw = mw_next; \
        if (t + 1 < ntiles) { ATT_LOAD_TILE(t + 1); mw_next = maskg[(size_t)qrow * 128 + t + 1]; } \
 \
        f32x4 S[4]; bf16x8 Kf[4][4]; \
        _Pragma("unroll") \
        for (int st = 0; st < 4; ++st) \
        _Pragma("unroll") \
            for (int ks = 0; ks < 4; ++ks) Kf[st][ks] = *(const LAS bf16x8*)(Kb + (16 * st + qi) * ATT_KP + (ks * 32 + 8 * g) * 2); \
        _Pragma("unroll") \
        for (int st = 0; st < 4; ++st) S[st] = (f32x4){0.f, 0.f, 0.f, 0.f}; \
        _Pragma("unroll") \
        for (int ks = 0; ks < 4; ++ks) \
        _Pragma("unroll") \
            for (int st = 0; st < 4; ++st) S[st] = mfma16(Kf[st][ks], Qf[ks], S[st]); \
 \
 \
        const unsigned mlo = (unsigned)(mw >> (4 * g)), mhi = (unsigned)((mw >> (4 * g)) >> 32); \
        float psum = 0.f; \
        _Pragma("unroll") \
        for (int st = 0; st < 4; ++st) \
        _Pragma("unroll") \
            for (int r = 0; r < 4; ++r) { const int bit = 16 * st + 4 * g + r; float s = S[st][r]; \
                if (NEAR_) { const int dist = qps - pos[t * 64 + bit]; if (dist >= 0 && dist < 128) s += tab[dist]; } \
                s = fminf(fmaxf(s, -120.f), 120.f); \
                const unsigned word = st < 2 ? mlo : mhi; const unsigned sel = word & (1u << ((16 * st + r) & 31)); \
                const float p = sel ? __builtin_amdgcn_exp2f(s) : 0.f; \
                S[st][r] = p; psum += p; } \
        lsum += psum; \
 \
        bf16x8 Pf[2]; \
        _Pragma("unroll") \
        for (int kk = 0; kk < 2; ++kk) { v4u w; w.x = pk2(S[2 * kk][0], S[2 * kk][1]); w.y = pk2(S[2 * kk][2], S[2 * kk][3]); w.z = pk2(S[2 * kk + 1][0], S[2 * kk + 1][1]); w.w = pk2(S[2 * kk + 1][2], S[2 * kk + 1][3]); \
            Pf[kk] = __builtin_bit_cast(bf16x8, w); } \
 \
        _Pragma("unroll") \
        for (int dt = 0; dt < 8; ++dt) \
        _Pragma("unroll") \
            for (int kk = 0; kk < 2; ++kk) { \
                LAS unsigned char* ap = Vb + (32 * kk + 4 * g + (qi >> 2)) * ATT_VP + (16 * dt + 4 * (qi & 3)) * 2; \
                const s16x4 a0 = __builtin_amdgcn_ds_read_tr16_b64_v4i16((LAS s16x4*)ap), a1 = __builtin_amdgcn_ds_read_tr16_b64_v4i16((LAS s16x4*)(ap + 16 * ATT_VP)); \
                const bf16x8 A = (bf16x8){a0[0], a0[1], a0[2], a0[3], a1[0], a1[1], a1[2], a1[3]}; \
                O[dt] = mfma16(A, Pf[kk], O[dt]); } \


__device__ __forceinline__ void attn_unit(Frame& F, int qb, int head) {
    const bf16* qg = (const bf16*)(F.ws + WS_Q); const bf16* kvb = (const bf16*)(F.ws + WS_KV);
    const unsigned long long* maskg = (const unsigned long long*)(F.ws + WS_MASK);
    const int* pos = (const int*)F.in(2);
    const int qi = F.lane & 15, g = F.lane >> 4;
    const int qrow = qb * 128 + F.wave * 16 + qi;
    LAS float* tab = (LAS float*)(F.lds + ATT_TAB);
    __syncthreads();
    if (F.tid < 128) { const float* relb = F.in(5); tab[F.tid] = (relb[(int)REL_BUCKET[F.tid] * 8 + head] - relb[31 * 8 + head]) * 1.4426950408889634f; }
    bf16x8 Qf[4];
#pragma unroll
    for (int ks = 0; ks < 4; ++ks) Qf[ks] = *(const GAS bf16x8*)(qg + (size_t)qrow * 1024 + head * 128 + ks * 32 + 8 * g);
    const int qps = pos[qrow];
    const int qpmin = pos[qb * 128 + F.wave * 16];
    f32x4 O[8];
#pragma unroll
    for (int d = 0; d < 8; ++d) O[d] = (f32x4){0.f, 0.f, 0.f, 0.f};
    float lsum = 0.f;
    const int ntiles = 2 * (qb + 1);
    int tnear = ntiles;
    while (tnear > 0 && (qpmin - pos[(tnear - 1) * 64 + 63]) < 113) --tnear;
    v4u kst[2], vst[2];
    ATT_LOAD_TILE(0);
    unsigned long long mw_next = maskg[(size_t)qrow * 128];
    int t = 0;
    for (; t < tnear; ++t) { ATT_TILE_BODY(false) }
    for (; t < ntiles; ++t) { ATT_TILE_BODY(true) }
    lsum += __shfl_xor(lsum, 16); lsum += __shfl_xor(lsum, 32);
    const float inv = 1.f / lsum;
    bf16* op = (bf16*)(F.ws + WS_ATT) + (size_t)qrow * 1024 + head * 128 + 4 * g;
#pragma unroll
    for (int dt = 0; dt < 8; ++dt) { v2u w; w.x = pk2(O[dt][0] * inv, O[dt][1] * inv); w.y = pk2(O[dt][2] * inv, O[dt][3] * inv); *(GAS v2u*)(op + 16 * dt) = w; }
}

__device__ __forceinline__ float unsortable(unsigned k) { return __builtin_bit_cast(float, (k & 0x80000000u) ? (k & 0x7fffffffu) : ~k); }
#define DOT2(a, b, c) dot2bf((a), (b), (c))

__device__ __forceinline__ void peer_unit(Frame& F, int unit) {
    const int tok0 = unit * 32;
    const bf16* pq = (const bf16*)(F.ws + WS_PQ); const bf16* subk = (const bf16*)(F.ws + WS_SUBK);
    LAS float* topS = (LAS float*)F.lds; LAS int* topI = (LAS int*)(F.lds + 32768);
    LAS int* esel = (LAS int*)(F.lds + 65536); LAS float* ew = (LAS float*)(F.lds + 81920); LAS float* eu = (LAS float*)(F.lds + 98304);
    const int r = F.lane & 31, hh = F.lane >> 5;
#ifndef NO_A
    {
        const int h = F.wave;
        for (int p = 0; p < 2; ++p) {
            const int hp = h * 2 + p;
            bf16x8 Bq[8];
#pragma unroll
            for (int ks = 0; ks < 8; ++ks) Bq[ks] = *(const GAS bf16x8*)(pq + (size_t)(tok0 + r) * 2048 + hp * 128 + ks * 16 + 8 * hh);
            unsigned key[64];
#pragma unroll
            for (int kt = 0; kt < 4; ++kt) { f32x16 acc;
#pragma unroll
                for (int e = 0; e < 16; ++e) acc[e] = 0.f;
#pragma unroll
                for (int ks = 0; ks < 8; ++ks) { const bf16x8 A = *(const GAS bf16x8*)(subk + ((size_t)hp * 128 + kt * 32 + r) * 128 + ks * 16 + 8 * hh); acc = mfma32(A, Bq[ks], acc); }
#pragma unroll
                for (int e = 0; e < 16; ++e) key[kt * 16 + e] = sortable(acc[e]);
                __builtin_amdgcn_sched_barrier(0); }
            unsigned thr = 0u;
            for (int bit = 31; bit >= 0; --bit) { const unsigned cand = thr | (1u << bit); int c = 0;
#pragma unroll
                for (int i = 0; i < 64; ++i) c += (key[i] >= cand) ? 1 : 0;
                c += __shfl_xor(c, 32);
                if (c >= PE_TOPK) thr = cand; }
            int ngt = 0, neq = 0;
#pragma unroll
            for (int i = 0; i < 64; ++i) { ngt += (key[i] > thr) ? 1 : 0; neq += (key[i] == thr) ? 1 : 0; }
            const int pgt = __shfl_xor(ngt, 32), peq = __shfl_xor(neq, 32);
            int pg = hh ? pgt : 0, pe = ngt + pgt + (hh ? peq : 0);
            LAS float* ls = topS + ((r * 8 + h) * 2 + p) * 16; LAS int* li = topI + ((r * 8 + h) * 2 + p) * 16;
            unsigned thr2 = thr; asm volatile("" : "+v"(thr2));
#pragma unroll
            for (int kt = 0; kt < 4; ++kt)
#pragma unroll
                for (int e = 0; e < 16; ++e) { const unsigned k = key[kt * 16 + e]; const int kidx = kt * 32 + (e & 3) + 8 * (e >> 2) + 4 * hh;
                    if (k > thr2) { ls[pg] = unsortable(k); li[pg] = kidx; ++pg; }
                    else if (k == thr2) { if (pe < PE_TOPK) { ls[pe] = unsortable(k); li[pe] = kidx; } ++pe; } }
        }
    }
#endif
    __syncthreads();
#ifndef NO_B
    if (F.wave < 4) {
        int lnB = F.lane; asm volatile("" : "+v"(lnB));
        const int L = F.wave * 64 + lnB, tk = L >> 3, hd = L & 7;
        const LAS float* S0 = topS + ((tk * 8 + hd) * 2 + 0) * 16; const LAS int* I0 = topI + ((tk * 8 + hd) * 2 + 0) * 16;
        float s1[16]; int i1[16];
#pragma unroll
        for (int b = 0; b < 16; ++b) { s1[b] = topS[((tk * 8 + hd) * 2 + 1) * 16 + b]; i1[b] = topI[((tk * 8 + hd) * 2 + 1) * 16 + b]; }
        const float NINF = -__builtin_inff();
        float prev = __builtin_inff(), thr = NINF, top = 0.f;
        for (int round = 0; round < 16; ++round) {
            float cur = NINF;
#pragma unroll 1
            for (int a = 0; a < 16; ++a) { const float sa = S0[a];
#pragma unroll
                for (int b = 0; b < 16; ++b) { const float v = sa + s1[b]; cur = fmaxf(cur, v < prev ? v : NINF); } }
            if (round == 0) top = cur;
            thr = cur; prev = cur;
        }
        int n = 0; float den = 0.f; const int ob = tk * 128 + hd * 16;
#pragma unroll 1
        for (int a = 0; a < 16; ++a) { const float sa = S0[a]; const int ia = I0[a] * PE_NK;
#pragma unroll
            for (int b = 0; b < 16; ++b) { const float v = sa + s1[b];
                if (v > thr && n < PE_TOPK) { const float w = __expf(v - top); esel[ob + n] = ia + i1[b]; ew[ob + n] = w; den += w; ++n; } } }
#pragma unroll 1
        for (int a = 0; a < 16; ++a) { const float sa = S0[a]; const int ia = I0[a] * PE_NK;
#pragma unroll
            for (int b = 0; b < 16; ++b) { const float v = sa + s1[b];
                if (v == thr && n < PE_TOPK) { const float w = __expf(v - top); esel[ob + n] = ia + i1[b]; ew[ob + n] = w; den += w; ++n; } } }
        const float inv = 1.f / den;
        const float* psc = (const float*)(F.ws + WS_PSC);
        for (int k = 0; k < PE_TOPK; ++k) { const int e = esel[ob + k]; ew[ob + k] *= inv * psc[PE_NE + e]; eu[ob + k] = psc[e]; }
    }
#endif
    __syncthreads();
#ifndef NO_C
    {
        int lnC = F.lane; asm volatile("" : "+v"(lnC));
        const float* h1f = (const float*)(F.ws + WS_H1F);
        const unsigned char* PU = (const unsigned char*)(F.ws + WS_PU); const unsigned char* PV = (const unsigned char*)(F.ws + WS_PV);
        float* rf = (float*)(F.ws + WS_RF); bf16* rb = (bf16*)(F.ws + WS_RB);
#pragma unroll 1
        for (int tt = 0; tt < 4; ++tt) {
            const int tl = F.wave * 4 + tt, tok = tok0 + tl;
            f32x2 xv[16], o[16];
#pragma unroll
            for (int i = 0; i < 2; ++i)
#pragma unroll
                for (int c = 0; c < 4; ++c) { const f32x4 hv = *(const GAS f32x4*)(h1f + (size_t)tok * DM + i * 1024 + lnC * 16 + c * 4);
                    xv[i * 8 + c * 2] = (f32x2){hv.x, hv.y}; xv[i * 8 + c * 2 + 1] = (f32x2){hv.z, hv.w}; }
#pragma unroll
            for (int e = 0; e < 16; ++e) o[e] = (f32x2){0.f, 0.f};
#pragma unroll 1
            for (int e0 = 0; e0 < DBG_PEER_NEXP; e0 += 4) {
                v4u uq[4][2], vq[4][2]; float gv[4], su[4];
#pragma unroll
                for (int k = 0; k < 4; ++k) { const int id = __builtin_amdgcn_readfirstlane(esel[tl * 128 + e0 + k]); gv[k] = ew[tl * 128 + e0 + k]; su[k] = eu[tl * 128 + e0 + k];
                    const GAS v4u* up = (const GAS v4u*)(PU + (size_t)id * DM) + lnC; const GAS v4u* vp = (const GAS v4u*)(PV + (size_t)id * DM) + lnC;
                    uq[k][0] = up[0]; uq[k][1] = up[64]; vq[k][0] = vp[0]; vq[k][1] = vp[64]; }
                float av[4];
#pragma unroll
                for (int k = 0; k < 4; ++k) { f32x2 acc = (f32x2){0.f, 0.f};
#pragma unroll
                    for (int i = 0; i < 2; ++i)
#pragma unroll
                        for (int c = 0; c < 4; ++c) { const int w = (int)uq[k][i][c];
                            acc = __builtin_amdgcn_cvt_pk_f32_fp8(w, false) * xv[i * 8 + c * 2] + acc; acc = __builtin_amdgcn_cvt_pk_f32_fp8(w, true) * xv[i * 8 + c * 2 + 1] + acc; }
                    av[k] = acc.x + acc.y; }
#pragma unroll
                for (int k = 0; k < 4; ++k) av[k] = wave_sum(av[k]);
#pragma unroll
                for (int k = 0; k < 4; ++k) { const float a = gv[k] * gelu_tanh(av[k] * su[k]); const f32x2 a2 = (f32x2){a, a};
#pragma unroll
                    for (int i = 0; i < 2; ++i)
#pragma unroll
                        for (int c = 0; c < 4; ++c) { const int w = (int)vq[k][i][c];
                            o[i * 8 + c * 2] = __builtin_amdgcn_cvt_pk_f32_fp8(w, false) * a2 + o[i * 8 + c * 2]; o[i * 8 + c * 2 + 1] = __builtin_amdgcn_cvt_pk_f32_fp8(w, true) * a2 + o[i * 8 + c * 2 + 1]; } }
            }
#pragma unroll
            for (int i = 0; i < 2; ++i)
#pragma unroll
                for (int c = 0; c < 4; ++c) { const size_t off = (size_t)tok * DM + i * 1024 + lnC * 16 + c * 4;
                    f32x2 ra = xv[i * 8 + c * 2] * ALPHA + o[i * 8 + c * 2], rbv = xv[i * 8 + c * 2 + 1] * ALPHA + o[i * 8 + c * 2 + 1];
#if DBG_NO_PEER
                    ra = xv[i * 8 + c * 2] * ALPHA; rbv = xv[i * 8 + c * 2 + 1] * ALPHA;
#endif
                    *(GAS f32x4*)(rf + off) = (f32x4){ra.x, ra.y, rbv.x, rbv.y};
                    v2u w; w.x = pk2(ra.x, ra.y); w.y = pk2(rbv.x, rbv.y); *(GAS v2u*)(rb + off) = w; }
        }
    }
#endif
    __syncthreads();
}

struct Args { const float* in[24]; float* out; unsigned char* ws; int ph_lo, ph_hi; };
constexpr int N_PHASES = 11;

__global__ void __launch_bounds__(NTHREADS, 2) mega_fwd(Args args) {
    extern __shared__ __attribute__((aligned(16))) unsigned char lds_raw[];
    const int lo = args.ph_lo, hi = args.ph_hi;
#if MK_COOP
    cg::grid_group grid = cg::this_grid();
    if (threadIdx.x < 2) ((LAS unsigned*)(lds_raw + LDS_BARST))[threadIdx.x] = 0u;
    __syncthreads();
    XcdBarrier xbar = xcd_barrier_post((unsigned*)(args.ws + WS_CTL) + 1024, (volatile LAS unsigned*)((LAS unsigned char*)lds_raw + LDS_BARST));
    int nbar_ = 0;
#if DBG_ALL_CG
#define GRID_BAR() grid.sync()
#else
#define GRID_BAR() do { if (nbar_++ == 0) grid.sync(); else xcd_barrier(xbar); } while (0)
#endif
#else
#define GRID_BAR() do {} while (0)
#endif
#define IN(k) (lo <= (k) && (k) < hi)
#define NREP(k) ((k) == DBG_REP_PHASE ? 2 : 1)
#define BOTH(k) (IN(k) && IN((k) + 1))

    if (IN(0)) for (int rep_ = 0; rep_ < NREP(0); ++rep_) { if (rep_) GRID_BAR(); MAKE_FRAME(F); p0_prologue(F); if (BOTH(0) && rep_ + 1 == NREP(0)) GRID_BAR(); }

    if (IN(1)) for (int rep_ = 0; rep_ < NREP(1); ++rep_) {
        if (rep_) GRID_BAR();
        MAKE_FRAME(F); unsigned char* ws = F.ws; LAS unsigned char* glds = F.lds;
        pg8::Gemm g{(const bf16*)(ws + WS_HB), (const bf16*)(ws + WS_WIN), SEQ, INW_PAD, DM}; asm volatile("" : "+s"(g.K), "+s"(g.N), "+s"(g.M)); pg8::StaticOrder S; S.init(SEQ, INW_PAD, F.G, F.bid);
        pg8::EpiWin E{(bf16*)(ws + WS_Q), (bf16*)(ws + WS_KV), (bf16*)(ws + WS_QI), (bf16*)(ws + WS_GU), (bf16*)(ws + WS_GV), (bf16*)(ws + WS_GA), (bf16*)(ws + WS_GG), (bf16*)(ws + WS_KIWI)};
        pg8::gemm_phase<pg8::EpiWin, pg8::StaticOrder, true, true>(glds, g, S, E);
        if (BOTH(1) && rep_ + 1 == NREP(1)) GRID_BAR();
    }

    if (IN(2)) for (int rep_ = 0; rep_ < NREP(2); ++rep_) {
        if (rep_) GRID_BAR();
        MAKE_FRAME(F); unsigned char* ws = F.ws; LAS unsigned char* glds = F.lds;
        for (int u = F.bid; u < 512; u += F.G) gmlp_unit(F, u);
#pragma unroll 1
        for (int k = F.bid, i = 0; k < 512; k += F.G, ++i) idx_unit(F, (F.G == 256 && i == 1) ? 511 - F.bid : k);
        if (BOTH(2) && rep_ + 1 == NREP(2)) GRID_BAR();
    }

    if (IN(3)) for (int rep_ = 0; rep_ < NREP(3); ++rep_) {
        if (rep_) GRID_BAR();
        MAKE_FRAME(F);
#pragma unroll 1
        for (int u = F.bid; u < 256; u += F.G) { const int head = u & 7, pair = u >> 3;
#pragma unroll 1
            for (int i = 0; i < 2; ++i) attn_unit(F, i ? 63 - pair : pair, head); }
        if (BOTH(3) && rep_ + 1 == NREP(3)) GRID_BAR();
    }

    if (IN(4)) for (int rep_ = 0; rep_ < NREP(4); ++rep_) {
        if (rep_) GRID_BAR();
        MAKE_FRAME(F); unsigned char* ws = F.ws; LAS unsigned char* glds = F.lds;
        { pg8::Gemm g{(const bf16*)(ws + WS_ATT), (const bf16*)(ws + WS_WA), SEQ, DM, AW}; asm volatile("" : "+s"(g.K), "+s"(g.N), "+s"(g.M)); pg8::StaticOrder S; S.init(SEQ, DM, F.G, F.bid);
          pg8::EpiGateF32 E{(const bf16*)(ws + WS_GA), (float*)(ws + WS_T), DM};
          pg8::gemm_phase<pg8::EpiGateF32, pg8::StaticOrder, true, true>(glds, g, S, E); }
        __syncthreads();
        { pg8::Gemm g{(const bf16*)(ws + WS_GM), (const bf16*)(ws + WS_WG), SEQ, DM, GW}; asm volatile("" : "+s"(g.K), "+s"(g.N), "+s"(g.M)); pg8::StaticOrder S; S.init(SEQ, DM, F.G, F.bid);
          pg8::EpiMerge E{(const bf16*)(ws + WS_GG), (const float*)(ws + WS_T), (bf16*)(ws + WS_MERGED), DM};
          pg8::gemm_phase<pg8::EpiMerge, pg8::StaticOrder, true, true>(glds, g, S, E); }
        if (BOTH(4) && rep_ + 1 == NREP(4)) GRID_BAR();
    }

    if (IN(5)) for (int rep_ = 0; rep_ < NREP(5); ++rep_) {
        if (rep_) GRID_BAR();
        MAKE_FRAME(F); unsigned char* ws = F.ws; LAS unsigned char* glds = F.lds;
        pg8::Gemm g{(const bf16*)(ws + WS_MERGED), (const bf16*)(ws + WS_WMIX), SEQ, DM, DM}; asm volatile("" : "+s"(g.K), "+s"(g.N), "+s"(g.M)); pg8::StaticOrder S; S.init(SEQ, DM, F.G, F.bid);
        pg8::EpiMix E{F.in(0), (const float*)(ws + WS_STATS), F.in(3), F.in(4), F.out, DM};
        pg8::gemm_phase<pg8::EpiMix, pg8::StaticOrder, true, true>(glds, g, S, E);
        if (BOTH(5) && rep_ + 1 == NREP(5)) GRID_BAR();
    }

    if (IN(6)) for (int rep_ = 0; rep_ < NREP(6); ++rep_) {
        if (rep_) GRID_BAR();
        MAKE_FRAME(F); unsigned char* ws = F.ws; LAS unsigned char* glds = F.lds;
        const int gw = F.bid * NWAVES + F.wave, NGW = F.G * NWAVES;
        for (int m = gw; m < SEQ; m += NGW) ln_row(F, F.out + (size_t)m * DM, F.in(14), F.in(15), (bf16*)(ws + WS_H1B) + (size_t)m * DM, (float*)(ws + WS_H1F) + (size_t)m * DM, nullptr);
        if (BOTH(6) && rep_ + 1 == NREP(6)) GRID_BAR();
    }

    if (IN(7)) for (int rep_ = 0; rep_ < NREP(7); ++rep_) {
        if (rep_) GRID_BAR();
        MAKE_FRAME(F); unsigned char* ws = F.ws; LAS unsigned char* glds = F.lds;
        pg8::Gemm g{(const bf16*)(ws + WS_H1B), (const bf16*)(ws + WS_WQ), SEQ, DM, DM}; asm volatile("" : "+s"(g.K), "+s"(g.N), "+s"(g.M)); pg8::StaticOrder S; S.init(SEQ, DM, F.G, F.bid);
        pg8::EpiBf16<0> E{(bf16*)(ws + WS_PQ), DM, nullptr, 0, 0, 1.f};
        pg8::gemm_phase<pg8::EpiBf16<0>, pg8::StaticOrder, true, true>(glds, g, S, E);
        if (BOTH(7) && rep_ + 1 == NREP(7)) GRID_BAR();
    }

    if (IN(8)) for (int rep_ = 0; rep_ < NREP(8); ++rep_) {
        if (rep_) GRID_BAR();
        MAKE_FRAME(F); unsigned char* ws = F.ws; LAS unsigned char* glds = F.lds;
        for (int u = F.bid; u < SEQ / 32; u += F.G) peer_unit(F, u);
        if (BOTH(8) && rep_ + 1 == NREP(8)) GRID_BAR();
    }

    if (IN(9)) for (int rep_ = 0; rep_ < NREP(9); ++rep_) {
        if (rep_) GRID_BAR();
        MAKE_FRAME(F); unsigned char* ws = F.ws; LAS unsigned char* glds = F.lds;
        { pg8::Gemm g{(const bf16*)(ws + WS_PB), (const bf16*)(ws + WS_WPP), SEQ, DM, PLE}; asm volatile("" : "+s"(g.K), "+s"(g.N), "+s"(g.M)); pg8::StaticOrder S; S.init(SEQ, DM, F.G, F.bid);
          pg8::EpiF32 E{(float*)(ws + WS_T2), DM};
          pg8::gemm_phase<pg8::EpiF32, pg8::StaticOrder, true, true>(glds, g, S, E); }
        __syncthreads();
        { pg8::Gemm g{(const bf16*)(ws + WS_RB), (const bf16*)(ws + WS_WPG), SEQ, DM, DM}; asm volatile("" : "+s"(g.K), "+s"(g.N), "+s"(g.M)); pg8::StaticOrder S; S.init(SEQ, DM, F.G, F.bid);
          pg8::EpiPle E{(const float*)(ws + WS_RF), (const float*)(ws + WS_T2), F.out, DM};
          pg8::gemm_phase<pg8::EpiPle, pg8::StaticOrder, true, true>(glds, g, S, E); }
        if (BOTH(9) && rep_ + 1 == NREP(9)) GRID_BAR();
    }

    if (IN(10)) for (int rep_ = 0; rep_ < NREP(10); ++rep_) {
        if (rep_) GRID_BAR();
        MAKE_FRAME(F); unsigned char* ws = F.ws; LAS unsigned char* glds = F.lds;
        const int gw = F.bid * NWAVES + F.wave, NGW = F.G * NWAVES;
        for (int m = gw; m < SEQ; m += NGW) ln_row(F, F.out + (size_t)m * DM, F.in(22), F.in(23), nullptr, F.out + (size_t)m * DM, nullptr);
    }
}

extern "C" void kernel_launch(void* const* d_in, const int* in_sizes, int n_in, void* d_out, int out_size, void* d_ws, size_t ws_size, hipStream_t stream) {
    static int grid = 0;
    if (grid == 0) {
        if (n_in != 24 || out_size != SEQ * DM || ws_size < WS_END) { fprintf(stderr, "kernel_launch: unexpected problem: n_in %d out %d ws %zu (need %zu)\n", n_in, out_size, ws_size, (size_t)WS_END); grid = -1; return; }
        int dev = 0, cus = 0, per_cu = 0;
        if (hipGetDevice(&dev) != hipSuccess || hipDeviceGetAttribute(&cus, hipDeviceAttributeMultiprocessorCount, dev) != hipSuccess) { grid = -1; return; }
        if (hipFuncSetAttribute((const void*)mega_fwd, hipFuncAttributeMaxDynamicSharedMemorySize, LDS_BYTES) != hipSuccess) { fprintf(stderr, "kernel_launch: hipFuncSetAttribute failed\n"); grid = -1; return; }
        if (hipOccupancyMaxActiveBlocksPerMultiprocessor(&per_cu, (const void*)mega_fwd, NTHREADS, LDS_BYTES) != hipSuccess || per_cu < 1) { fprintf(stderr, "kernel_launch: occupancy query says %d blocks per CU\n", per_cu); (void)hipGetLastError(); grid = -1; return; }
        grid = cus;
        fprintf(stderr, "kernel_launch: grid %d (per_cu %d), ws %zu\n", grid, per_cu, ws_size);
    }
    if (grid < 0) return;
    if (hipMemsetAsync((char*)d_ws + WS_CTL, 0, CTL_ZERO_BYTES, stream) != hipSuccess) { fprintf(stderr, "kernel_launch: memset of the barrier words failed\n"); return; }
    Args a{};
    for (int i = 0; i < 24; ++i) a.in[i] = (const float*)d_in[i];
    a.out = (float*)d_out; a.ws = (unsigned char*)d_ws;
#if MK_COOP
    a.ph_lo = 0; a.ph_hi = N_PHASES;
    void* kargs[] = {&a};
    hipError_t e = hipLaunchCooperativeKernel((const void*)mega_fwd, dim3(grid), dim3(NTHREADS), kargs, LDS_BYTES, stream);
    if (e != hipSuccess) fprintf(stderr, "kernel_launch: cooperative launch failed: %s\n", hipGetErrorString(e));
#else
    for (int ph = 0; ph < N_PHASES; ++ph) { a.ph_lo = ph; a.ph_hi = ph + 1; hipLaunchKernelGGL(mega_fwd, dim3(grid), dim3(NTHREADS), LDS_BYTES, stream, a); }
#endif
}
```

```cpp
#include <hip/hip_runtime.h>
#include <hip/hip_cooperative_groups.h>
#include <cstdio>
#include <cstdint>
namespace cg = cooperative_groups;
#ifndef MK_COOP
#define MK_COOP 1
#endif
#define DBG_NO_ATTN 0
#define DBG_ATTN_X2 0
#define DBG_PEER_X2 0
#define DBG_NO_PEER 0
#define DBG_NO_GMLP 0
#define DBG_GMLP_X2 0
#define DBG_PLE_S 1.0f
#define DBG_MIX_S 1.0f
#define DBG_ATTN_HI_S 1.0f
#define DBG_LOGIT_S 1.0f
#define DBG_NO_BIAS 0
#define DBG_REP_PHASE -1
#define DBG_REP_SUB 0
#define DBG_ALL_CG 0
#define DBG_PEER_NEXP 128
namespace pg8 {
#define PG8_LAS __attribute__((address_space(3)))
typedef unsigned short bf16_t;
typedef short bf16x8 __attribute__((ext_vector_type(8)));
typedef float f32x4 __attribute__((ext_vector_type(4)));
typedef unsigned u32x4 __attribute__((ext_vector_type(4)));
constexpr int BM = 256, BK = 64, HALF = 128, HTB = HALF * BK * 2  , STAGE_BYTES = 8 * HTB, NXCD = 8, WGM = 8;

__host__ __device__ __forceinline__ int lds_byte(int r, int c) { const int st = (r >> 4) * 2 + (c >> 5), rr = r & 15, cc = c & 31, ob = rr * 64 + cc * 2; return st * 1024 + (ob ^ (((ob >> 9) & 1) << 5)); }
__host__ __device__ __forceinline__ void stage_rc(int b, int& R, int& C) { const int st = b / 1024, sb = b % 1024, swz = sb ^ (((sb >> 9) & 1) << 5); R = (st >> 1) * 16 + swz / 64; C = (st & 1) * 32 + (swz % 64) / 2; }
__host__ __device__ __forceinline__ int perm32(int rho) { const int n = rho >> 4, i = rho & 15; return 8 * (i >> 2) + 4 * n + (i & 3); }

struct Unit { int pm, pn; };
struct Gemm { const bf16_t* A; const bf16_t* Bt; int M, N, K; };

struct StaticOrder {
    int nM, nN, nwg, G, c;
    __host__ __device__ void init(int M, int N, int G_, int c_) { nM = M / BM; nN = N / BM; nwg = nM * nN; G = G_; c = c_; }
    __host__ __device__ bool next(int i, Unit& u) const {
        const long L = (long)i * G + c; if (L >= nwg) return false;
        int wgid = (int)L; { const int q = nwg / NXCD, r = nwg % NXCD, xcd = wgid % NXCD, off = wgid / NXCD; wgid = (xcd < r ? xcd * (q + 1) : r * (q + 1) + (xcd - r) * q) + off; }
        const int nig = WGM * nN, gid = wgid / nig, fm = gid * WGM, gsz = (nM - fm) < WGM ? (nM - fm) : WGM;
        u.pm = fm + ((wgid % nig) % gsz); u.pn = (wgid % nig) / gsz; return true;
    }
    __device__ __forceinline__ void a_ready(const Unit&) const {}
    __device__ __forceinline__ void done(const Unit&) const {}
};

__device__ __forceinline__ unsigned cvt_pk_bf16(float lo, float hi) { unsigned r; asm volatile("v_cvt_pk_bf16_f32 %0, %1, %2" : "=v"(r) : "v"(lo), "v"(hi)); return r; }
typedef float f32x2 __attribute__((ext_vector_type(2)));
__device__ __forceinline__ f32x2 gelu_pk(f32x2 v) {
    const f32x2 av = __builtin_elementwise_abs(v), d = av * 0.2316418882f + 1.0f;
    f32x2 t; t.x = __builtin_amdgcn_rcpf(d.x); t.y = __builtin_amdgcn_rcpf(d.y);
    f32x2 q = t * 0.5307027145f + (-0.7265760135f); q = q * t + 0.7107068705f; q = q * t + (-0.142248368f); q = q * t + 0.127414796f; q = q * t;
    const f32x2 s = (v * v) * (-0.72134752044f);
    f32x2 e; e.x = __builtin_amdgcn_exp2f(s.x); e.y = __builtin_amdgcn_exp2f(s.y);
    const f32x2 m = v * (q * e), r = v - m;
    f32x2 o; o.x = v.x < 0.f ? m.x : r.x; o.y = v.y < 0.f ? m.y : r.y; return o;
}

template <int ACT  > struct EpiBf16 {
    static constexpr bool PERM = true, AFTER_DRAIN = false; static_assert(ACT == 0 || ACT == 1, "EpiBf16: ACT is 0 (none) or 1 (gelu_pk)");
    bf16_t* O; int ldc; const float* bias; int split_cols; size_t split_stride; float scale0;
    __device__ __forceinline__ void operator()(const f32x4 (&acc)[2][2][4][2], const Unit& u, int wr, int wc, int fr, int fq) const {
        const int row0 = u.pm * BM + wr * 64 + fr; int colt = u.pn * BM; bf16_t* base = O;
        float sc = 1.f; if (split_cols) { const int t = colt / split_cols; base += (size_t)t * split_stride; colt -= t * split_cols; if (t == 0) sc = scale0; }
        const int col0 = colt + wc * 32 + 8 * fq, bcol0 = u.pn * BM + wc * 32 + 8 * fq;
        f32x4 bv[2][2];
#pragma unroll
        for (int bj = 0; bj < 2; ++bj)
#pragma unroll
            for (int n = 0; n < 2; ++n) bv[bj][n] = bias ? *(const f32x4*)(bias + bcol0 + bj * HALF + 4 * n) : (f32x4){0.f, 0.f, 0.f, 0.f};
#pragma unroll
        for (int ai = 0; ai < 2; ++ai)
#pragma unroll
            for (int m = 0; m < 4; ++m) { bf16_t* rowp = base + (size_t)(row0 + ai * HALF + m * 16) * ldc + col0;
#pragma unroll
                for (int bj = 0; bj < 2; ++bj) { f32x4 v0 = acc[ai][bj][m][0] + bv[bj][0], v1 = acc[ai][bj][m][1] + bv[bj][1];
                    if (ACT == 1) { f32x2 a = gelu_pk((f32x2){v0[0], v0[1]}), b = gelu_pk((f32x2){v0[2], v0[3]}), c = gelu_pk((f32x2){v1[0], v1[1]}), d = gelu_pk((f32x2){v1[2], v1[3]});
                        v0 = (f32x4){a.x, a.y, b.x, b.y}; v1 = (f32x4){c.x, c.y, d.x, d.y}; }
                    v0 = v0 * sc; v1 = v1 * sc; u32x4 w; w.x = cvt_pk_bf16(v0[0], v0[1]); w.y = cvt_pk_bf16(v0[2], v0[3]); w.z = cvt_pk_bf16(v1[0], v1[1]); w.w = cvt_pk_bf16(v1[2], v1[3]);
                    *(u32x4*)(rowp + bj * HALF) = w; } }
    }
};
template <class Epi, class Sched, bool ALIGN_EPI = false, bool SP2 = false>
__device__ __forceinline__ void gemm_phase(PG8_LAS unsigned char* lds, const Gemm g, const Sched& S, const Epi& E) {
    const int tid = threadIdx.x, wid = __builtin_amdgcn_readfirstlane(tid >> 6), lane = tid & 63, wr = wid >> 2, wc = wid & 3, fr = lane & 15, fq = lane >> 4;
    const int K = g.K, nt = K / BK;
    unsigned voffA[2], voffB[2];
#pragma unroll
    for (int i = 0; i < 2; ++i) { int R, C; stage_rc(tid * 16 + i * 8192, R, C); const int Rb = Epi::PERM ? ((R & ~31) + perm32(R & 31)) : R;
        voffA[i] = (unsigned)(R * K + C) * 2u; voffB[i] = (unsigned)(Rb * K + C) * 2u; }
    const size_t kstep = (size_t)(BK * 2);
    const size_t hstep = (size_t)HALF * K * 2;
    const size_t tstep = 2 * hstep;
    const unsigned ldsw = (unsigned)wid * 1024u;
    const int aoff = lds_byte(wr * 64 + fr, fq * 8), boff = lds_byte(wc * 32 + fr, fq * 8);
#define PG8_SA(b, h) (((b) * 2 + (h)) * HTB)
#define PG8_SB(b, h) ((4 + (b) * 2 + (h)) * HTB)
#define PG8_STAGE(bufoff, gbase, voff) do { _Pragma("unroll") for (int _i = 0; _i < 2; ++_i) \
        __builtin_amdgcn_global_load_lds((const unsigned*)((const char*)(gbase) + (voff)[_i]), (PG8_LAS unsigned*)(lds + (bufoff) + ldsw + _i * 8192), 16, 0, 0); } while (0)
#define PG8_LDA(dst, b, h) do { _Pragma("unroll") for (int m = 0; m < 4; ++m) _Pragma("unroll") for (int k = 0; k < 2; ++k) dst[m][k] = *(const PG8_LAS bf16x8*)(lds + PG8_SA(b, h) + aoff + m * 2048 + k * 1024); } while (0)
#define PG8_LDB(dst, b, h) do { _Pragma("unroll") for (int n = 0; n < 2; ++n) _Pragma("unroll") for (int k = 0; k < 2; ++k) dst[n][k] = *(const PG8_LAS bf16x8*)(lds + PG8_SB(b, h) + boff + n * 2048 + k * 1024); } while (0)
#define PG8_MMA(ai, bj, At, Bt) do { __builtin_amdgcn_s_setprio(1); _Pragma("unroll") for (int m = 0; m < 4; ++m) _Pragma("unroll") for (int n = 0; n < 2; ++n) _Pragma("unroll") for (int k = 0; k < 2; ++k) \
        acc[ai][bj][m][n] = __builtin_amdgcn_mfma_f32_16x16x32_bf16(Bt[n][k], At[m][k], acc[ai][bj][m][n], 0, 0, 0); __builtin_amdgcn_s_setprio(0); } while (0)
#define PG8_WAIT_V(n) asm volatile("s_waitcnt vmcnt(" #n ")" ::: "memory")
#define PG8_WAIT_L(n) asm volatile("s_waitcnt lgkmcnt(" #n ")" ::: "memory")
#define PG8_BAR __builtin_amdgcn_s_barrier()
#define PG8_SCHED __builtin_amdgcn_sched_barrier(0)
    Unit cur, nxt; int ui = 0;
    if (!S.next(0, cur)) return;
    f32x4 acc[2][2][4][2];
#pragma unroll
    for (int a = 0; a < 2; ++a)
#pragma unroll
        for (int b = 0; b < 2; ++b)
#pragma unroll
            for (int m = 0; m < 4; ++m)
#pragma unroll
                for (int n = 0; n < 2; ++n) acc[a][b][m][n] = (f32x4){0.f, 0.f, 0.f, 0.f};
    bf16x8 At[4][2], B0[2][2], B1[2][2];
    const char* cA = (const char*)g.A + (size_t)cur.pm * tstep; const char* cB = (const char*)g.Bt + (size_t)cur.pn * tstep;
    S.a_ready(cur);
    if constexpr (SP2) {
        PG8_STAGE(PG8_SB(0, 0), cB, voffB); PG8_STAGE(PG8_SB(0, 1), cB + hstep, voffB); PG8_STAGE(PG8_SA(0, 0), cA, voffA); PG8_STAGE(PG8_SA(0, 1), cA + hstep, voffA);
        if (wr == 1) PG8_BAR;
        PG8_WAIT_V(2); PG8_BAR;
        PG8_STAGE(PG8_SB(1, 0), cB + kstep, voffB); PG8_STAGE(PG8_SA(1, 0), cA + kstep, voffA); PG8_STAGE(PG8_SB(1, 1), cB + hstep + kstep, voffB);
        PG8_WAIT_V(6); PG8_BAR;
    } else {
        PG8_STAGE(PG8_SB(0, 0), cB, voffB); PG8_STAGE(PG8_SA(0, 0), cA, voffA); PG8_STAGE(PG8_SB(0, 1), cB + hstep, voffB); PG8_STAGE(PG8_SA(0, 1), cA + hstep, voffA);
        if (wr == 1) PG8_BAR;
        PG8_WAIT_V(4); PG8_BAR;
        PG8_STAGE(PG8_SB(1, 0), cB + kstep, voffB); PG8_STAGE(PG8_SA(1, 0), cA + kstep, voffA); PG8_STAGE(PG8_SB(1, 1), cB + hstep + kstep, voffB);
        PG8_WAIT_V(6); PG8_BAR;
    }
    for (;;) {
        const bool has_next = S.next(ui + 1, nxt);
        const char* nA = has_next ? (const char*)g.A + (size_t)nxt.pm * tstep : cA; const char* nB = has_next ? (const char*)g.Bt + (size_t)nxt.pn * tstep : cB;
        for (int t = 0; t < nt; t += 2) {
            const bool last = (t == nt - 2);
            const char* a1 = cA + (size_t)(t + 1) * kstep;
            const char* a2 = last ? nA : cA + (size_t)(t + 2) * kstep; const char* b2 = last ? nB : cB + (size_t)(t + 2) * kstep;
            const char* a3 = a2 + kstep; const char* b3 = b2 + kstep;
            if (last && has_next) S.a_ready(nxt);
            if constexpr (SP2) {
            PG8_LDB(B0, 0, 0); PG8_LDB(B1, 0, 1); PG8_SCHED; PG8_LDA(At, 0, 0); PG8_STAGE(PG8_SA(1, 1), a1 + hstep, voffA);
            PG8_WAIT_V(8); PG8_WAIT_L(0); PG8_BAR; PG8_MMA(0, 0, At, B0); PG8_MMA(0, 1, At, B1); PG8_BAR; PG8_SCHED;
            PG8_LDA(At, 0, 1); PG8_STAGE(PG8_SB(0, 0), b2, voffB); PG8_STAGE(PG8_SB(0, 1), b2 + hstep, voffB); PG8_STAGE(PG8_SA(0, 0), a2, voffA);
            PG8_WAIT_V(8); PG8_WAIT_L(0); PG8_BAR; PG8_MMA(1, 0, At, B0); PG8_MMA(1, 1, At, B1); PG8_BAR; PG8_SCHED;
            PG8_LDB(B0, 1, 0); PG8_LDB(B1, 1, 1); PG8_SCHED; PG8_LDA(At, 1, 0); PG8_STAGE(PG8_SA(0, 1), a2 + hstep, voffA);
            PG8_WAIT_V(8); PG8_WAIT_L(0); PG8_BAR; PG8_MMA(0, 0, At, B0); PG8_MMA(0, 1, At, B1); PG8_BAR; PG8_SCHED;
            PG8_LDA(At, 1, 1); PG8_STAGE(PG8_SB(1, 0), b3, voffB); PG8_STAGE(PG8_SB(1, 1), b3 + hstep, voffB); PG8_STAGE(PG8_SA(1, 0), a3, voffA);
            PG8_WAIT_V(8); PG8_WAIT_L(0); PG8_BAR; PG8_MMA(1, 0, At, B0); PG8_MMA(1, 1, At, B1); PG8_BAR; PG8_SCHED;
            } else {
            PG8_LDB(B0, 0, 0); PG8_SCHED; PG8_LDA(At, 0, 0); PG8_STAGE(PG8_SA(1, 1), a1 + hstep, voffA);
            PG8_WAIT_L(8); PG8_BAR; PG8_WAIT_L(0); PG8_MMA(0, 0, At, B0); PG8_BAR; PG8_SCHED;
            PG8_LDB(B1, 0, 1); PG8_STAGE(PG8_SB(0, 0), b2, voffB);
            PG8_BAR; PG8_WAIT_L(0); PG8_MMA(0, 1, At, B1); PG8_BAR;
            PG8_LDA(At, 0, 1); PG8_STAGE(PG8_SA(0, 0), a2, voffA);
            PG8_BAR; PG8_WAIT_L(0); PG8_MMA(1, 0, At, B0); PG8_BAR; PG8_SCHED;
            PG8_STAGE(PG8_SB(0, 1), b2 + hstep, voffB);
            PG8_WAIT_V(6); PG8_BAR; PG8_MMA(1, 1, At, B1); PG8_BAR;
            PG8_LDB(B0, 1, 0); PG8_SCHED; PG8_LDA(At, 1, 0); PG8_STAGE(PG8_SA(0, 1), a2 + hstep, voffA);
            PG8_WAIT_L(8); PG8_BAR; PG8_WAIT_L(0); PG8_MMA(0, 0, At, B0); PG8_BAR; PG8_SCHED;
            PG8_LDB(B1, 1, 1); PG8_STAGE(PG8_SB(1, 0), b3, voffB);
            PG8_BAR; PG8_WAIT_L(0); PG8_MMA(0, 1, At, B1); PG8_BAR;
            PG8_LDA(At, 1, 1); PG8_STAGE(PG8_SA(1, 0), a3, voffA);
            PG8_BAR; PG8_WAIT_L(0); PG8_MMA(1, 0, At, B0); PG8_BAR; PG8_SCHED;
            PG8_STAGE(PG8_SB(1, 1), b3 + hstep, voffB);
            PG8_WAIT_V(6); PG8_BAR; PG8_MMA(1, 1, At, B1); PG8_BAR;
            }
        }
        if constexpr (ALIGN_EPI) { if (wr == 0) PG8_BAR; }
        if constexpr (!Epi::AFTER_DRAIN) { E(acc, cur, wr, wc, fr, fq); S.done(cur); }
        if (!has_next) break;
#pragma unroll
        for (int a = 0; a < 2; ++a)
#pragma unroll
            for (int b = 0; b < 2; ++b)
#pragma unroll
                for (int m = 0; m < 4; ++m)
#pragma unroll
                    for (int n = 0; n < 2; ++n) acc[a][b][m][n] = (f32x4){0.f, 0.f, 0.f, 0.f};
        cur = nxt; cA = nA; cB = nB; ++ui;
        if constexpr (ALIGN_EPI) { if (wr == 1) PG8_BAR; }
    }
    PG8_WAIT_V(0);
    if constexpr (!ALIGN_EPI) { if (wr == 0) PG8_BAR; }
    PG8_BAR;
    if constexpr (Epi::AFTER_DRAIN) { E.fused(acc, cur, wr, wc, fr, fq, lds, wid, lane); S.done(cur); }
#undef PG8_SA
#undef PG8_SB
#undef PG8_STAGE
#undef PG8_LDA
#undef PG8_LDB
#undef PG8_MMA
#undef PG8_WAIT_V
#undef PG8_WAIT_L
#undef PG8_BAR
#undef PG8_SCHED
}
}

constexpr int SEQ = 8192, DM = 2048, INW = 10320, INW_PAD = 10496;
constexpr int AW = 1024, NIH = 16, IHD = 64, TOPK = 256, GW = 1024;
constexpr int PE_H = 8, PE_NK = 128, PE_TOPK = 16, PE_NE = 16384, PLE = 256;
constexpr float LN_EPS = 1e-5f;
constexpr float ALPHA = 1.189207115002721f;
constexpr float QSCALE = 0.08838834764831845f * 1.4426950408889634f;
constexpr int NWAVES = 8, NTHREADS = 512;
constexpr int LDS_BYTES = 147456;
constexpr int LDS_BARST = LDS_BYTES - 64;

constexpr size_t MiB = 1u << 20;
constexpr size_t WS_CTL = 0, CTL_ZERO_BYTES = 65536;
constexpr size_t WS_WA = 1 * MiB, WS_WG = 5 * MiB, WS_WMIX = 9 * MiB, WS_WQ = 17 * MiB, WS_WPG = 25 * MiB, WS_WPP = 33 * MiB, WS_SUBK = 34 * MiB;
constexpr size_t WS_PU = 35 * MiB, WS_PV = 99 * MiB, WS_STATS = 163 * MiB;
constexpr size_t WS_WIN = 164 * MiB, WS_HB = 205 * MiB;
constexpr size_t WS_Q = 237 * MiB, WS_KV = 253 * MiB, WS_QI = 285 * MiB, WS_KIWI = 301 * MiB;
constexpr size_t WS_GU = 305 * MiB, WS_GV = 321 * MiB, WS_GA = 337 * MiB, WS_GG = 369 * MiB;
constexpr size_t WS_GM = 401 * MiB, WS_ATT = 417 * MiB, WS_SC = 433 * MiB, WS_PB = 497 * MiB;
constexpr size_t WS_T = 164 * MiB, WS_MERGED = 237 * MiB, WS_H1F = 269 * MiB, WS_H1B = 333 * MiB, WS_PQ = 365 * MiB;
constexpr size_t WS_RF = 164 * MiB, WS_RB = 228 * MiB, WS_T2 = 405 * MiB;
constexpr size_t WS_PSC = 163 * MiB + 131072;
constexpr size_t WS_MASK = 501 * MiB;
constexpr size_t WS_END = 512 * MiB;

#define GAS __attribute__((address_space(1)))
#define LAS __attribute__((address_space(3)))
typedef unsigned short bf16;
typedef unsigned v4u __attribute__((ext_vector_type(4)));
typedef unsigned v2u __attribute__((ext_vector_type(2)));
typedef float f32x4 __attribute__((ext_vector_type(4)));
typedef float f32x2 __attribute__((ext_vector_type(2)));
typedef float f32x16 __attribute__((ext_vector_type(16)));
typedef short bf16x8 __attribute__((ext_vector_type(8)));
typedef __attribute__((ext_vector_type(2))) __bf16 bf2v;
#define LDS_WAIT() asm volatile("s_waitcnt lgkmcnt(0)" ::: "memory")
#define VM_WAIT() asm volatile("s_waitcnt vmcnt(0)" ::: "memory")

__device__ __forceinline__ unsigned f2bf(float f) { unsigned u = __builtin_bit_cast(unsigned, f); return (u + 0x7fffu + ((u >> 16) & 1u)) >> 16; }
typedef __bf16 bf16x2_t __attribute__((ext_vector_type(2)));
__device__ __forceinline__ unsigned pk2(float lo, float hi) { const f32x2 v = {lo, hi}; return __builtin_bit_cast(unsigned, __builtin_convertvector(v, bf16x2_t)); }
__device__ __forceinline__ float bflo(unsigned u) { return __builtin_bit_cast(float, u << 16); }
__device__ __forceinline__ float bfhi(unsigned u) { return __builtin_bit_cast(float, u & 0xffff0000u); }
__device__ __forceinline__ float bf2f(bf16 h) { return __builtin_bit_cast(float, (unsigned)h << 16); }
__device__ __forceinline__ float fast_rcp(float x) { return __builtin_amdgcn_rcpf(x); }
__device__ __forceinline__ float sigmoidf_(float x) { return fast_rcp(1.f + __expf(-x)); }
__device__ __forceinline__ float gelu_tanh(float x) { const float u = 1.5957691216057308f * (x + 0.044715f * x * x * x); return x * fast_rcp(1.f + __expf(-u)); }
__device__ __forceinline__ float wave_sum(float v) {
#pragma unroll
    for (int o = 1; o < 64; o <<= 1) v += __shfl_xor(v, o);
    return v;
}
__device__ __forceinline__ float dot2bf(unsigned a, unsigned b, float c) { return __builtin_amdgcn_fdot2_f32_bf16(__builtin_bit_cast(bf2v, a), __builtin_bit_cast(bf2v, b), c, false); }
__device__ __forceinline__ unsigned sortable(float f) { const unsigned u = __builtin_bit_cast(unsigned, f); return (u & 0x80000000u) ? ~u : (u | 0x80000000u); }

typedef const __attribute__((address_space(4))) unsigned char* kargp_t;
__device__ __forceinline__ unsigned long long karg_u64(int byte_off) {
    kargp_t ka = (kargp_t)__builtin_amdgcn_kernarg_segment_ptr();
    asm volatile("" : "+s"(ka));
    return *(const __attribute__((address_space(4))) unsigned long long*)(ka + byte_off);
}
struct Frame {
    LAS unsigned char* lds;
    int tid, lane, wave, G, bid;
    float* out; unsigned char* ws;
    __device__ __forceinline__ const float* in(int k) const { return (const float*)karg_u64(8 * k); }
};
#define MAKE_FRAME(F) Frame F; { int t_ = threadIdx.x; asm volatile("" : "+v"(t_)); F.tid = t_; F.lane = t_ & 63; F.wave = __builtin_amdgcn_readfirstlane(t_ >> 6); \
    F.G = gridDim.x; F.bid = blockIdx.x; F.lds = (LAS unsigned char*)lds_raw; F.out = (float*)karg_u64(192); F.ws = (unsigned char*)karg_u64(200); }

__device__ __forceinline__ int win_dest(int n) { return n < 4096 ? n : (n < 4176 ? n + 6144 : n - 80); }
template <bool MAP>
__device__ __forceinline__ void p0_transpose_item(const float* W, int K, int N, bf16* WT, LAS float* scr, int item, int lane) {
    const int nblk = (N + 31) / 32, kb = item / nblk, nb = item % nblk, k0 = 64 * kb, n0 = 32 * nb;
    const int nn = n0 + (lane & 31); const bool ok = nn < N;
    float tv[32];
#pragma unroll
    for (int i = 0; i < 32; ++i) { const int kk = 2 * i + (lane >> 5); tv[i] = ok ? W[(size_t)(k0 + kk) * N + nn] : 0.f; }
#pragma unroll
    for (int i = 0; i < 32; ++i) { const int kk = 2 * i + (lane >> 5); scr[kk * 33 + (lane & 31)] = tv[i]; }
    LDS_WAIT(); asm volatile("" ::: "memory");
    const int c = lane & 7;
#pragma unroll
    for (int j = 0; j < 4; ++j) { const int n = (lane >> 3) + 8 * j; const LAS float* s = scr + (8 * c) * 33 + n;
        v4u o; o.x = pk2(s[0 * 33], s[1 * 33]); o.y = pk2(s[2 * 33], s[3 * 33]); o.z = pk2(s[4 * 33], s[5 * 33]); o.w = pk2(s[6 * 33], s[7 * 33]);
        if (n0 + n < N) { const int drow = MAP ? win_dest(n0 + n) : (n0 + n); *(GAS v4u*)(WT + (size_t)drow * K + k0 + 8 * c) = o; } }
    LDS_WAIT(); asm volatile("" ::: "memory");
}
__device__ __forceinline__ void p0_convert(Frame& F, const float* src, bf16* dst, size_t n) {
    const size_t nth = (size_t)F.G * NTHREADS, n8 = n / 8;
    for (size_t i = (size_t)F.bid * NTHREADS + F.tid; i < n8; i += nth) {
        const f32x4 a = ((const GAS f32x4*)src)[2 * i], b = ((const GAS f32x4*)src)[2 * i + 1];
        v4u o; o.x = pk2(a.x, a.y); o.y = pk2(a.z, a.w); o.z = pk2(b.x, b.y); o.w = pk2(b.z, b.w);
        ((GAS v4u*)dst)[i] = o; }
}
__device__ __forceinline__ void ln_row(Frame& F, const float* xrow, const float* g, const float* b, bf16* ob, float* of, float* stats) {
    const GAS f32x4* xr = (const GAS f32x4*)xrow + F.lane;
    f32x4 v[8]; float s = 0.f;
#pragma unroll
    for (int j = 0; j < 8; ++j) { v[j] = xr[64 * j]; s += (v[j].x + v[j].y) + (v[j].z + v[j].w); }
    const float mean = wave_sum(s) * (1.f / DM); float s2 = 0.f;
#pragma unroll
    for (int j = 0; j < 8; ++j) { v[j] = v[j] - mean; s2 += (v[j].x * v[j].x + v[j].y * v[j].y) + (v[j].z * v[j].z + v[j].w * v[j].w); }
    const float rstd = 1.f / sqrtf(wave_sum(s2) * (1.f / DM) + LN_EPS);
    if (stats && F.lane == 0) { stats[0] = mean; stats[1] = rstd; }
#pragma unroll
    for (int j = 0; j < 8; ++j) {
        const f32x4 gg = ((const GAS f32x4*)g)[64 * j + F.lane], bb = ((const GAS f32x4*)b)[64 * j + F.lane];
        const f32x4 y = v[j] * rstd * gg + bb;
        if (ob) { v2u o; o.x = pk2(y.x, y.y); o.y = pk2(y.z, y.w); ((GAS v2u*)ob)[64 * j + F.lane] = o; }
        if (of) ((GAS f32x4*)of)[64 * j + F.lane] = y;
    }
}
__device__ __forceinline__ void p0_prologue(Frame& F) {
    LAS float* scr = (LAS float*)(F.lds + F.wave * 16384);
    const int gw = F.bid * NWAVES + F.wave, NGW = F.G * NWAVES;
    unsigned char* ws = F.ws;
    constexpr int I_IN = (DM / 64) * ((INW + 31) / 32), I_A = (AW / 64) * (DM / 32), I_G = (GW / 64) * (DM / 32), I_SQ = (DM / 64) * (DM / 32), I_PP = (PLE / 64) * (DM / 32);
    constexpr int NITEMS = I_IN + I_A + I_G + 3 * I_SQ + I_PP;
    for (int it = gw; it < NITEMS; it += NGW) {
        int r = it;
        if (r < I_IN) { p0_transpose_item<true>(F.in(6), DM, INW, (bf16*)(ws + WS_WIN), scr, r, F.lane); continue; } r -= I_IN;
        if (r < I_A) { p0_transpose_item<false>(F.in(11), AW, DM, (bf16*)(ws + WS_WA), scr, r, F.lane); continue; } r -= I_A;
        if (r < I_G) { p0_transpose_item<false>(F.in(12), GW, DM, (bf16*)(ws + WS_WG), scr, r, F.lane); continue; } r -= I_G;
        if (r < I_SQ) { p0_transpose_item<false>(F.in(13), DM, DM, (bf16*)(ws + WS_WMIX), scr, r, F.lane); continue; } r -= I_SQ;
        if (r < I_SQ) { p0_transpose_item<false>(F.in(16), DM, DM, (bf16*)(ws + WS_WQ), scr, r, F.lane); continue; } r -= I_SQ;
        if (r < I_SQ) { p0_transpose_item<false>(F.in(21), DM, DM, (bf16*)(ws + WS_WPG), scr, r, F.lane); continue; } r -= I_SQ;
        p0_transpose_item<false>(F.in(20), PLE, DM, (bf16*)(ws + WS_WPP), scr, r, F.lane);
    }
    { const size_t n16 = (size_t)(INW_PAD - INW) * DM * 2 / 16; GAS v4u* z = (GAS v4u*)(ws + WS_WIN + (size_t)INW * DM * 2);
      for (size_t i = (size_t)F.bid * NTHREADS + F.tid; i < n16; i += (size_t)F.G * NTHREADS) z[i] = (v4u){0u, 0u, 0u, 0u}; }
    for (int row0 = gw; row0 < 2 * PE_NE; row0 += 2 * NGW) {
        f32x4 v[2][8]; float mx[2];
#pragma unroll
        for (int h = 0; h < 2; ++h) { const int row = row0 + h * NGW, tb = row >= PE_NE ? 1 : 0, r = row - tb * PE_NE;
            const GAS f32x4* src = (const GAS f32x4*)((tb ? F.in(19) : F.in(18)) + (size_t)r * DM) + F.lane;
#pragma unroll
            for (int j = 0; j < 8; ++j) v[h][j] = src[64 * j]; }
#pragma unroll
        for (int h = 0; h < 2; ++h) { float m_ = 0.f;
#pragma unroll
            for (int j = 0; j < 8; ++j) m_ = fmaxf(m_, fmaxf(fmaxf(fabsf(v[h][j].x), fabsf(v[h][j].y)), fmaxf(fabsf(v[h][j].z), fabsf(v[h][j].w))));
#pragma unroll
            for (int o = 1; o < 64; o <<= 1) m_ = fmaxf(m_, __shfl_xor(m_, o));
            mx[h] = m_; }
#pragma unroll
        for (int h = 0; h < 2; ++h) { const int row = row0 + h * NGW, tb = row >= PE_NE ? 1 : 0, r = row - tb * PE_NE;
            float sc = 1.f;
            if (mx[h] > 1e-30f) sc = __builtin_bit_cast(float, __builtin_bit_cast(unsigned, 224.f / mx[h]) & 0x7f800000u);
            if (F.lane == 0) ((float*)(ws + WS_PSC))[row] = 1.f / sc;
            GAS unsigned* dst = (GAS unsigned*)(ws + (tb ? WS_PV : WS_PU) + (size_t)r * DM) + F.lane;
#pragma unroll
            for (int j = 0; j < 8; ++j) { int w = __builtin_amdgcn_cvt_pk_fp8_f32(v[h][j].x * sc, v[h][j].y * sc, 0, false); w = __builtin_amdgcn_cvt_pk_fp8_f32(v[h][j].z * sc, v[h][j].w * sc, w, true); dst[64 * j] = (unsigned)w; } }
    }
    p0_convert(F, F.in(17), (bf16*)(ws + WS_SUBK), (size_t)PE_H * 2 * PE_NK * 128);
    p0_convert(F, F.in(1), (bf16*)(ws + WS_PB), (size_t)SEQ * PLE);
    for (int m = gw; m < SEQ; m += NGW) ln_row(F, F.in(0) + (size_t)m * DM, F.in(3), F.in(4), (bf16*)(ws + WS_HB) + (size_t)m * DM, nullptr, (float*)(ws + WS_STATS) + 2 * m);
}

typedef GAS unsigned gu32;
#define XB_TMO      128
#define XB_XCNT(j)  (256  + 64 * (j))
#define XB_XSUB(j)  (1280 + 64 * (j))
#define XB_XGEN(j)  (2304 + 64 * (j))
#define XB_TOP      3328
#define XB_TOPGEN   3392
#define XCD_BAR_WORDS 3456
#define XB_SPIN_CAP (1u << 18)

__device__ __forceinline__ unsigned xb_ld(unsigned* p)              { return __hip_atomic_load(p, __ATOMIC_RELAXED, __HIP_MEMORY_SCOPE_AGENT); }
__device__ __forceinline__ unsigned xb_add(unsigned* p, unsigned v) { return __hip_atomic_fetch_add(p, v, __ATOMIC_RELAXED, __HIP_MEMORY_SCOPE_AGENT); }
__device__ __forceinline__ unsigned xb_xcc_id() { return (unsigned)__builtin_amdgcn_s_getreg((3 << 11) | 20) & 0xFu; }
#define XB_SPIN(cond, bar) do { unsigned _sp = 0; while (cond) { __builtin_amdgcn_s_sleep(1); \
    if ((++_sp & 255u) == 0u) { if (xb_ld(&(bar)[XB_TMO])) break; if (_sp > XB_SPIN_CAP) { atomicAdd(&(bar)[XB_TMO], 1u); break; } } } } while (0)

struct XcdBarrier {
    unsigned* bar; unsigned x;
    volatile LAS unsigned* st;
};

__device__ __forceinline__ XcdBarrier xcd_barrier_post(unsigned* bar, volatile LAS unsigned* st) {
    XcdBarrier b; b.bar = bar; b.x = xb_xcc_id(); b.st = st;
    if (threadIdx.x == 0) (void)xb_add(&bar[XB_XCNT(b.x)], 1u);
    return b;
}
__device__ __forceinline__ void xcd_barrier_complete(unsigned* bar, unsigned x, unsigned& nloc, unsigned& nx) {
    const unsigned G = gridDim.x * gridDim.y * gridDim.z;
    unsigned sum, cnt, mine, sp = 0u;
    for (;;) {
        sum = 0u; cnt = 0u; mine = 0u;
#pragma unroll
        for (unsigned j = 0; j < 16; ++j) { const unsigned c = xb_ld(&bar[XB_XCNT(j)]); sum += c; cnt += (c > 0u) ? 1u : 0u; mine = (j == x) ? c : mine; }
        if (sum == G) break;
        __builtin_amdgcn_s_sleep(1);
        if ((++sp & 255u) == 0u) { if (xb_ld(&bar[XB_TMO])) break; if (sp > XB_SPIN_CAP) { atomicAdd(&bar[XB_TMO], 1u); break; } }
    }
    nloc = mine > 0u ? mine : 1u; nx = cnt > 0u ? cnt : 1u;
}

__device__ __forceinline__ void xcd_barrier(const XcdBarrier& b) {
    asm volatile("s_waitcnt vmcnt(0)" ::: "memory");
    __syncthreads();
    if (threadIdx.x == 0) {
        unsigned* bar = b.bar;
        __builtin_amdgcn_s_waitcnt(0);
        unsigned nloc = b.st[0], nx = b.st[1];
        if (nloc == 0u) { xcd_barrier_complete(bar, b.x, nloc, nx); b.st[0] = nloc; b.st[1] = nx; }
        const unsigned old = xb_add(&bar[XB_XSUB(b.x)], 1u);
        const unsigned gen = old / nloc;
        if (old + 1u == (gen + 1u) * nloc) {
            __builtin_amdgcn_fence(__ATOMIC_RELEASE, "agent");
            asm volatile("s_waitcnt vmcnt(0)" ::: "memory");
            const unsigned og = xb_add(&bar[XB_TOP], 1u);
            const unsigned tg = og / nx;
            if (og + 1u == (tg + 1u) * nx) xb_add(&bar[XB_TOPGEN], 1u);
            else XB_SPIN(xb_ld(&bar[XB_TOPGEN]) == tg, bar);
            __builtin_amdgcn_fence(__ATOMIC_ACQUIRE, "agent");
            xb_add(&bar[XB_XGEN(b.x)], 1u);
            asm volatile("s_waitcnt vmcnt(0)" ::: "memory");
        } else {
            XB_SPIN(xb_ld(&bar[XB_XGEN(b.x)]) == gen, bar);
            __builtin_amdgcn_fence(__ATOMIC_ACQUIRE, "agent");
            asm volatile("s_waitcnt vmcnt(0)" ::: "memory");
        }
    }
    __syncthreads();
}

namespace pg8 {
struct EpiWin {
    static constexpr bool PERM = true, AFTER_DRAIN = false;
    bf16 *q, *kv, *qi, *gu, *gv, *ga, *gg, *kiwi;
    __device__ __forceinline__ void operator()(const f32x4 (&acc)[2][2][4][2], const Unit& u, int wr, int wc, int fr, int fq) const {
        const int pn = u.pn; bf16* base; int ld, colt, act = 0; float sc = 1.f;
        if (pn < 4) { base = q; ld = 1024; colt = pn * 256; sc = QSCALE; }
        else if (pn < 12) { base = kv; ld = 2048; colt = (pn - 4) * 256; }
        else if (pn < 16) { base = qi; ld = 1024; colt = (pn - 12) * 256; }
        else if (pn < 20) { base = gu; ld = 1024; colt = (pn - 16) * 256; act = 1; }
        else if (pn < 24) { base = gv; ld = 1024; colt = (pn - 20) * 256; act = 1; }
        else if (pn < 32) { base = ga; ld = 2048; colt = (pn - 24) * 256; act = 2; }
        else if (pn < 40) { base = gg; ld = 2048; colt = (pn - 32) * 256; act = 2; }
        else { base = kiwi; ld = 256; colt = 0; }
        const int row0 = u.pm * BM + wr * 64 + fr, col0 = colt + wc * 32 + 8 * fq;
#pragma unroll
        for (int ai = 0; ai < 2; ++ai)
#pragma unroll
            for (int m = 0; m < 4; ++m) { bf16* rowp = base + (size_t)(row0 + ai * HALF + m * 16) * ld + col0;
#pragma unroll
                for (int bj = 0; bj < 2; ++bj) { f32x4 v0 = acc[ai][bj][m][0], v1 = acc[ai][bj][m][1];
                    if (act == 1) {
#pragma unroll
                        for (int e = 0; e < 4; ++e) { v0[e] = gelu_tanh(v0[e]); v1[e] = gelu_tanh(v1[e]); } }
                    else if (act == 2) {
#pragma unroll
                        for (int e = 0; e < 4; ++e) { v0[e] = sigmoidf_(v0[e]); v1[e] = sigmoidf_(v1[e]); } }
                    else { v0 = v0 * sc; v1 = v1 * sc; }
                    v4u w; w.x = pk2(v0[0], v0[1]); w.y = pk2(v0[2], v0[3]); w.z = pk2(v1[0], v1[1]); w.w = pk2(v1[2], v1[3]);
                    *(GAS v4u*)(rowp + bj * HALF) = w; } }
    }
};
struct EpiGateF32 {
    static constexpr bool PERM = true, AFTER_DRAIN = false;
    const bf16* gate; float* T; int ldc;
    __device__ __forceinline__ void operator()(const f32x4 (&acc)[2][2][4][2], const Unit& u, int wr, int wc, int fr, int fq) const {
        const int row0 = u.pm * BM + wr * 64 + fr, col0 = u.pn * BM + wc * 32 + 8 * fq;
#pragma unroll
        for (int ai = 0; ai < 2; ++ai)
#pragma unroll
            for (int m = 0; m < 4; ++m) { const size_t off = (size_t)(row0 + ai * HALF + m * 16) * ldc + col0;
#pragma unroll
                for (int bj = 0; bj < 2; ++bj) { const v4u g = *(const GAS v4u*)(gate + off + bj * HALF);
                    f32x4 v0 = acc[ai][bj][m][0], v1 = acc[ai][bj][m][1];
                    v0[0] *= bflo(g.x); v0[1] *= bfhi(g.x); v0[2] *= bflo(g.y); v0[3] *= bfhi(g.y);
                    v1[0] *= bflo(g.z); v1[1] *= bfhi(g.z); v1[2] *= bflo(g.w); v1[3] *= bfhi(g.w);
                    *(GAS f32x4*)(T + off + bj * HALF) = v0; *(GAS f32x4*)(T + off + bj * HALF + 4) = v1; } }
    }
};
struct EpiMerge {
    static constexpr bool PERM = true, AFTER_DRAIN = false;
    const bf16* gate; const float* T; bf16* O; int ldc;
    __device__ __forceinline__ void operator()(const f32x4 (&acc)[2][2][4][2], const Unit& u, int wr, int wc, int fr, int fq) const {
        const int row0 = u.pm * BM + wr * 64 + fr, col0 = u.pn * BM + wc * 32 + 8 * fq;
#pragma unroll
        for (int ai = 0; ai < 2; ++ai)
#pragma unroll
            for (int m = 0; m < 4; ++m) { const size_t off = (size_t)(row0 + ai * HALF + m * 16) * ldc + col0;
#pragma unroll
                for (int bj = 0; bj < 2; ++bj) { const v4u g = *(const GAS v4u*)(gate + off + bj * HALF);
                    const f32x4 t0 = *(const GAS f32x4*)(T + off + bj * HALF), t1 = *(const GAS f32x4*)(T + off + bj * HALF + 4);
                    f32x4 v0 = acc[ai][bj][m][0], v1 = acc[ai][bj][m][1];
                    v0[0] = t0[0] + v0[0] * bflo(g.x); v0[1] = t0[1] + v0[1] * bfhi(g.x); v0[2] = t0[2] + v0[2] * bflo(g.y); v0[3] = t0[3] + v0[3] * bfhi(g.y);
                    v1[0] = t1[0] + v1[0] * bflo(g.z); v1[1] = t1[1] + v1[1] * bfhi(g.z); v1[2] = t1[2] + v1[2] * bflo(g.w); v1[3] = t1[3] + v1[3] * bfhi(g.w);
                    v4u w; w.x = pk2(v0[0], v0[1]); w.y = pk2(v0[2], v0[3]); w.z = pk2(v1[0], v1[1]); w.w = pk2(v1[2], v1[3]);
                    *(GAS v4u*)(O + off + bj * HALF) = w; } }
    }
};
struct EpiMix {
    static constexpr bool PERM = false, AFTER_DRAIN = false;
    const float* x; const float* stats; const float* g; const float* b; float* Y; int ldc;
    __device__ __forceinline__ void operator()(const f32x4 (&acc)[2][2][4][2], const Unit& u, int wr, int wc, int fr, int fq) const {
        const int row0 = u.pm * BM + wr * 64 + fr, col0 = u.pn * BM + wc * 32 + 4 * fq;
        f32x4 gv[2][2], bv[2][2];
#pragma unroll
        for (int bj = 0; bj < 2; ++bj)
#pragma unroll
            for (int n = 0; n < 2; ++n) { gv[bj][n] = *(const GAS f32x4*)(g + col0 + bj * HALF + n * 16); bv[bj][n] = *(const GAS f32x4*)(b + col0 + bj * HALF + n * 16); }
#pragma unroll
        for (int ai = 0; ai < 2; ++ai)
#pragma unroll
            for (int m = 0; m < 4; ++m) { const int r = row0 + ai * HALF + m * 16; const size_t off = (size_t)r * ldc + col0;
                const float mean = stats[2 * r], rstd = stats[2 * r + 1];
#pragma unroll
                for (int bj = 0; bj < 2; ++bj)
#pragma unroll
                    for (int n = 0; n < 2; ++n) { const f32x4 xv = *(const GAS f32x4*)(x + off + bj * HALF + n * 16);
                        const f32x4 h = (xv - mean) * rstd * gv[bj][n] + bv[bj][n];
                        *(GAS f32x4*)(Y + off + bj * HALF + n * 16) = h * ALPHA + acc[ai][bj][m][n] * DBG_MIX_S; } }
    }
};
struct EpiF32 {
    static constexpr bool PERM = false, AFTER_DRAIN = false;
    float* Y; int ldc;
    __device__ __forceinline__ void operator()(const f32x4 (&acc)[2][2][4][2], const Unit& u, int wr, int wc, int fr, int fq) const {
        const int row0 = u.pm * BM + wr * 64 + fr, col0 = u.pn * BM + wc * 32 + 4 * fq;
#pragma unroll
        for (int ai = 0; ai < 2; ++ai)
#pragma unroll
            for (int m = 0; m < 4; ++m) { const size_t off = (size_t)(row0 + ai * HALF + m * 16) * ldc + col0;
#pragma unroll
                for (int bj = 0; bj < 2; ++bj)
#pragma unroll
                    for (int n = 0; n < 2; ++n) *(GAS f32x4*)(Y + off + bj * HALF + n * 16) = acc[ai][bj][m][n]; }
    }
};
struct EpiPle {
    static constexpr bool PERM = false, AFTER_DRAIN = false;
    const float* R; const float* T2; float* Y; int ldc;
    __device__ __forceinline__ void operator()(const f32x4 (&acc)[2][2][4][2], const Unit& u, int wr, int wc, int fr, int fq) const {
        const int row0 = u.pm * BM + wr * 64 + fr, col0 = u.pn * BM + wc * 32 + 4 * fq;
#pragma unroll
        for (int ai = 0; ai < 2; ++ai)
#pragma unroll
            for (int m = 0; m < 4; ++m) { const size_t off = (size_t)(row0 + ai * HALF + m * 16) * ldc + col0;
#pragma unroll
                for (int bj = 0; bj < 2; ++bj)
#pragma unroll
                    for (int n = 0; n < 2; ++n) { const f32x4 rv = *(const GAS f32x4*)(R + off + bj * HALF + n * 16), tv = *(const GAS f32x4*)(T2 + off + bj * HALF + n * 16);
                        const f32x4 a = acc[ai][bj][m][n]; f32x4 o;
#pragma unroll
                        for (int e = 0; e < 4; ++e) o[e] = rv[e] + DBG_PLE_S * sigmoidf_(a[e]) * tv[e];
                        *(GAS f32x4*)(Y + off + bj * HALF + n * 16) = o; } }
    }
};
}

__device__ __forceinline__ f32x16 mfma32(bf16x8 a, bf16x8 b, f32x16 c) { return __builtin_amdgcn_mfma_f32_32x32x16_bf16(a, b, c, 0, 0, 0); }
__device__ __forceinline__ void unpack8(const v4u a, float (&x)[8]) { x[0] = bflo(a.x); x[1] = bfhi(a.x); x[2] = bflo(a.y); x[3] = bfhi(a.y); x[4] = bflo(a.z); x[5] = bfhi(a.z); x[6] = bflo(a.w); x[7] = bfhi(a.w); }

__device__ __forceinline__ void gmlp_unit(Frame& F, int unit) {
    const int n = unit >> 3, g = unit & 7, row0 = n * 128;
    const bf16* gvb = (const bf16*)(F.ws + WS_GV); const bf16* gub = (const bf16*)(F.ws + WS_GU); bf16* gm = (bf16*)(F.ws + WS_GM);
    LAS float* st = (LAS float*)F.lds;
    LAS bf16* VT = (LAS bf16*)(F.lds + 1024);
    for (int i = 0; i < 16; ++i) { const int r = F.wave * 16 + i;
        const GAS v4u* rp = (const GAS v4u*)(gvb + (size_t)(row0 + r) * GW);
        const v4u a = rp[F.lane], b = rp[64 + F.lane];
        float x[16]; { float t0[8], t1[8]; unpack8(a, t0); unpack8(b, t1);
#pragma unroll
            for (int e = 0; e < 8; ++e) { x[e] = t0[e]; x[8 + e] = t1[e]; } }
        float s = 0.f;
#pragma unroll
        for (int e = 0; e < 16; ++e) s += x[e];
        const float mean = wave_sum(s) * (1.f / GW); float s2 = 0.f;
#pragma unroll
        for (int e = 0; e < 16; ++e) { const float d = x[e] - mean; s2 += d * d; }
        const float rstd = 1.f / sqrtf(wave_sum(s2) * (1.f / GW) + LN_EPS);
        if (F.lane == 0) { st[2 * r] = mean; st[2 * r + 1] = rstd; } }
    __syncthreads();
    const float* lg = F.in(7) + g * 128; const float* lb = F.in(8) + g * 128;
#pragma unroll
    for (int i = 0; i < 4; ++i) { const int id = F.tid + 512 * i, s = id >> 4, c8 = id & 15;
        const v4u a = *(const GAS v4u*)(gvb + (size_t)(row0 + s) * GW + g * 128 + c8 * 8);
        float x[8]; unpack8(a, x);
        const float mean = st[2 * s], rstd = st[2 * s + 1];
        const f32x4 g0 = *(const GAS f32x4*)(lg + c8 * 8), g1 = *(const GAS f32x4*)(lg + c8 * 8 + 4), b0 = *(const GAS f32x4*)(lb + c8 * 8), b1 = *(const GAS f32x4*)(lb + c8 * 8 + 4);
#pragma unroll
        for (int e = 0; e < 8; ++e) { const float gg = e < 4 ? g0[e & 3] : g1[e & 3], bb = e < 4 ? b0[e & 3] : b1[e & 3];
            VT[(c8 * 8 + e) * 136 + s] = (bf16)f2bf((x[e] - mean) * rstd * gg + bb); } }
    __syncthreads();
    const int r = F.lane & 31, hh = F.lane >> 5, tt = F.wave >> 1, ct0 = (F.wave & 1) * 2;
    f32x16 acc0, acc1;
#pragma unroll
    for (int e = 0; e < 16; ++e) { acc0[e] = 0.f; acc1[e] = 0.f; }
    const float* wsm = F.in(9) + (size_t)g * 128 * 128;
    const int t = tt * 32 + r;
    for (int ks = 0; ks < (tt + 1) * 2; ++ks) {
        const int k0 = ks * 16 + 8 * hh;
        const f32x4 w0 = *(const GAS f32x4*)(wsm + t * 128 + k0), w1 = *(const GAS f32x4*)(wsm + t * 128 + k0 + 4);
        float wv[8] = {w0.x, w0.y, w0.z, w0.w, w1.x, w1.y, w1.z, w1.w};
#pragma unroll
        for (int e = 0; e < 8; ++e) if (k0 + e > t) wv[e] = 0.f;
        v4u ap; ap.x = pk2(wv[0], wv[1]); ap.y = pk2(wv[2], wv[3]); ap.z = pk2(wv[4], wv[5]); ap.w = pk2(wv[6], wv[7]);
        const bf16x8 A = __builtin_bit_cast(bf16x8, ap);
        const bf16x8 B0 = *(const LAS bf16x8*)(VT + (ct0 * 32 + r) * 136 + k0), B1 = *(const LAS bf16x8*)(VT + ((ct0 + 1) * 32 + r) * 136 + k0);
        acc0 = mfma32(A, B0, acc0); acc1 = mfma32(A, B1, acc1);
    }
    const float* bs = F.in(10) + g * 128;
#pragma unroll
    for (int reg = 0; reg < 16; ++reg) { const int tr = tt * 32 + (reg & 3) + 8 * (reg >> 2) + 4 * hh; const float bsv = bs[tr];
        const size_t o0 = (size_t)(row0 + tr) * GW + g * 128 + ct0 * 32 + r;
#if DBG_GMLP_X2
        acc0[reg] *= 2.f; acc1[reg] *= 2.f;
#endif
#if DBG_NO_GMLP
        acc0[reg] = 0.f; acc1[reg] = 0.f;
#endif
        gm[o0] = (bf16)f2bf(bf2f(gub[o0]) * (acc0[reg] + bsv));
        gm[o0 + 32] = (bf16)f2bf(bf2f(gub[o0 + 32]) * (acc1[reg] + bsv)); }
    __syncthreads();
}

__device__ __constant__ unsigned char REL_BUCKET[128] = {0, 1, 2, 3, 4, 5, 6, 7, 8, 9, 10, 11, 12, 13, 14, 15, 16, 16, 16, 17, 17, 18, 18, 18, 19, 19, 19, 20, 20, 20, 20, 21, 21, 21, 21, 22, 22, 22, 22, 22, 23, 23, 23, 23, 23, 23, 24, 24, 24, 24, 24, 24, 25, 25, 25, 25, 25, 25, 25, 26, 26, 26, 26, 26, 26, 26, 26, 27, 27, 27, 27, 27, 27, 27, 27, 27, 27, 28, 28, 28, 28, 28, 28, 28, 28, 28, 28, 29, 29, 29, 29, 29, 29, 29, 29, 29, 29, 29, 29, 30, 30, 30, 30, 30, 30, 30, 30, 30, 30, 30, 30, 30, 30, 31, 31, 31, 31, 31, 31, 31, 31, 31, 31, 31, 31, 31, 31, 31};
constexpr int KI_PITCH = 144;
constexpr unsigned NEG_KEY = 0x007FFFFFu;
__device__ __forceinline__ int mbcnt64(unsigned long long m) { return __builtin_amdgcn_mbcnt_hi((unsigned)(m >> 32), __builtin_amdgcn_mbcnt_lo((unsigned)m, 0u)); }

#define IDX_LOAD_TILE(t_) do { _Pragma("unroll") for (int i_ = 0; i_ < 4; ++i_) { const int id_ = F.tid + 512 * i_; \
    stg[i_] = *(const GAS v4u*)(kiwi + (size_t)((t_) * 256 + (id_ >> 3)) * 256 + (id_ & 7) * 8); } } while (0)

__device__ __forceinline__ void idx_unit(Frame& F, int unit) {
    const int q0 = unit * 16;
    const int kend = ((q0 + 15) / 32 + 1) * 32;
    const int nkt = (kend + 255) >> 8;
    const bf16* qi = (const bf16*)(F.ws + WS_QI); const bf16* kiwi = (const bf16*)(F.ws + WS_KIWI);
    const int* pos = (const int*)F.in(2);
    float* scr = (F.bid < 128) ? F.out + (size_t)F.bid * (16 * 8192) : (float*)(F.ws + WS_SC) + (size_t)(F.bid - 128) * (16 * 8192);
    const int r = F.lane & 31, hh = F.lane >> 5;
    const int wq = q0 + 2 * F.wave;
    for (int repA = 0; repA < (DBG_REP_SUB == 1 ? 2 : 1); ++repA) {
        const int aq = wq + ((r >> 2) & 1), ah = (r & 3) + 4 * (r >> 3);
        bf16x8 Af[4];
#pragma unroll
        for (int s = 0; s < 4; ++s) Af[s] = *(const GAS bf16x8*)(qi + (size_t)aq * 1024 + ah * 64 + s * 16 + 8 * hh);
        float wgt[16];
        { const v4u a = *(const GAS v4u*)(kiwi + (size_t)(wq + hh) * 256 + 64), b = *(const GAS v4u*)(kiwi + (size_t)(wq + hh) * 256 + 72);
          float t0[8], t1[8]; unpack8(a, t0); unpack8(b, t1);
#pragma unroll
          for (int e = 0; e < 8; ++e) { wgt[e] = t0[e]; wgt[8 + e] = t1[e]; } }
        const int qpos = pos[wq + hh];
        float* srow = scr + (size_t)(2 * F.wave + hh) * 8192;
        v4u stg[4];
        IDX_LOAD_TILE(0);
        for (int t = 0; t < nkt; ++t) {
            __syncthreads();
#pragma unroll
            for (int i = 0; i < 4; ++i) { const int id = F.tid + 512 * i; *(LAS v4u*)(F.lds + (id >> 3) * KI_PITCH + (id & 7) * 16) = stg[i]; }
            __syncthreads();
            if (t + 1 < nkt) IDX_LOAD_TILE(t + 1);
            for (int sub = 0; sub < 8; ++sub) {
                const int key0 = t * 256 + sub * 32;
                if (key0 >= kend) break;
                f32x16 acc;
#pragma unroll
                for (int e = 0; e < 16; ++e) acc[e] = 0.f;
#pragma unroll
                for (int s = 0; s < 4; ++s) { const bf16x8 B = *(const LAS bf16x8*)(F.lds + (sub * 32 + r) * KI_PITCH + s * 32 + hh * 16); acc = mfma32(Af[s], B, acc); }
                float sc = 0.f;
#pragma unroll
                for (int e = 0; e < 16; ++e) sc += wgt[e] * fmaxf(acc[e], 0.f);
                const int key = key0 + r; const int kp = pos[key];
                srow[key] = (kp <= qpos) ? sc : -__builtin_inff();
            }
        }
    }
    __threadfence(); __syncthreads();
    unsigned long long* maskg = (unsigned long long*)(F.ws + WS_MASK);
    const int kw = 128 * ((q0 >> 7) + 1);
#pragma unroll 1
    for (int qq = 0; qq < (DBG_REP_SUB == 2 ? 4 : 2); ++qq) {
        const int qrow = wq + (qq & 1);
        const float* sr = scr + (size_t)(2 * F.wave + (qq & 1)) * 8192;
        unsigned key[128];
        int ln1 = F.lane; asm volatile("" : "+v"(ln1));
        int ke1 = kend; asm volatile("" : "+s"(ke1));
        const float* srl = sr + ln1;
#pragma unroll
        for (int j = 0; j < 128; ++j) { key[j] = 0x007FFFFEu; if (j * 64 < ke1) key[j] = __builtin_bit_cast(unsigned, __builtin_nontemporal_load(srl + j * 64)); }
        __builtin_amdgcn_sched_barrier(0);
#pragma unroll
        for (int j = 0; j < 128; ++j) { const unsigned u = key[j]; unsigned k = (u & 0x80000000u) ? ~u : (u | 0x80000000u); if (j * 64 + ln1 >= ke1) k = 0u; key[j] = k; }
        unsigned thr = 0u;
        for (int bit = 31; bit >= 16; --bit) { const unsigned cand = thr | (1u << bit); int c0 = 0, c1 = 0, c2 = 0, c3 = 0;
            int ke = kend; asm volatile("" : "+s"(ke));
#pragma unroll
            for (int jb = 0; jb < 16; ++jb) { if (jb * 512 < ke) {
                    c0 += (key[jb * 8 + 0] >= cand) ? 1 : 0; c1 += (key[jb * 8 + 1] >= cand) ? 1 : 0; c2 += (key[jb * 8 + 2] >= cand) ? 1 : 0; c3 += (key[jb * 8 + 3] >= cand) ? 1 : 0;
                    c0 += (key[jb * 8 + 4] >= cand) ? 1 : 0; c1 += (key[jb * 8 + 5] >= cand) ? 1 : 0; c2 += (key[jb * 8 + 6] >= cand) ? 1 : 0; c3 += (key[jb * 8 + 7] >= cand) ? 1 : 0; }
                __builtin_amdgcn_sched_barrier(0); }
            int c = (c0 + c1) + (c2 + c3);
#pragma unroll
            for (int o = 1; o < 64; o <<= 1) c += __shfl_xor(c, o);
            if (c >= TOPK) thr = cand; }
        const unsigned thr_hi = thr + 0x10000u;
        int ngt = 0;
        int ke3 = kend; asm volatile("" : "+s"(ke3));
#pragma unroll
        for (int jb = 0; jb < 16; ++jb) { if (jb * 512 < ke3) {
#pragma unroll
                for (int jj = 0; jj < 8; ++jj) ngt += __builtin_popcountll(__ballot(key[jb * 8 + jj] >= thr_hi && key[jb * 8 + jj] > NEG_KEY)); }
            __builtin_amdgcn_sched_barrier(0); }
        const int need = TOPK - ngt;
        int tie_seen = 0;
        int ke4 = kw; asm volatile("" : "+s"(ke4));
        unsigned long long mw0 = 0ull, mw1 = 0ull;
#pragma unroll
        for (int j = 0; j < 128; ++j) { if (j * 64 < ke4) {
            const bool valid = key[j] > NEG_KEY, gt = valid && key[j] >= thr_hi, eq = valid && key[j] >= thr && key[j] < thr_hi;
            const unsigned long long meq = __ballot(eq);
            const bool take = gt || (eq && (tie_seen + mbcnt64(meq)) < need);
            tie_seen += __builtin_popcountll(meq);
            const unsigned long long m = __ballot(take);
            if (F.lane == (j & 63)) { if (j < 64) mw0 = m; else mw1 = m; } }
            __builtin_amdgcn_sched_barrier(0); }
        if (F.lane * 64 < kw) maskg[(size_t)qrow * 128 + F.lane] = mw0;
        if ((64 + F.lane) * 64 < kw) maskg[(size_t)qrow * 128 + 64 + F.lane] = mw1;
    }
}

typedef short s16x4 __attribute__((ext_vector_type(4)));
__device__ __forceinline__ f32x4 mfma16(bf16x8 a, bf16x8 b, f32x4 c) { return __builtin_amdgcn_mfma_f32_16x16x32_bf16(a, b, c, 0, 0, 0); }
constexpr int ATT_KP = 272, ATT_VP = 288;
constexpr int ATT_KB = 64 * ATT_KP, ATT_VB = 64 * ATT_VP;
constexpr int ATT_VOFF = 2 * ATT_KB, ATT_TAB = ATT_VOFF + 2 * ATT_VB;

#define ATT_LOAD_TILE(t_) do { _Pragma("unroll") for (int i_ = 0; i_ < 2; ++i_) { const int c_ = F.tid + 512 * i_; \
    const bf16* gp_ = kvb + (size_t)((t_) * 64 + (c_ >> 4)) * 2048 + head * 128 + (c_ & 15) * 8; \
    kst[i_] = *(const GAS v4u*)gp_; vst[i_] = *(const GAS v4u*)(gp_ + 1024); } } while (0)

#define ATT_TILE_BODY(NEAR_) \
        LAS unsigned char* Kb = F.lds + (t & 1) * ATT_KB; LAS unsigned char* Vb = F.lds + ATT_VOFF + (t & 1) * ATT_VB; \
        _Pragma("unroll") \
        for (int i = 0; i < 2; ++i) { const int c = F.tid + 512 * i; *(LAS v4u*)(Kb + (c >> 4) * ATT_KP + (c & 15) * 16) = kst[i]; *(LAS v4u*)(Vb + (c >> 4) * ATT_VP + (c & 15) * 16) = vst[i]; } \
        __syncthreads(); \
        const unsigned long long mw = mw_next; \
        if (t + 1 < ntiles) { ATT_LOAD_TILE(t + 1); mw_next = maskg[(size_t)qrow * 128 + t + 1]; } \
 \
        f32x4 S[4]; bf16x8 Kf[4][4]; \
        _Pragma("unroll") \
        for (int st = 0; st < 4; ++st) \
        _Pragma("unroll") \
            for (int ks = 0; ks < 4; ++ks) Kf[st][ks] = *(const LAS bf16x8*)(Kb + (16 * st + qi) * ATT_KP + (ks * 32 + 8 * g) * 2); \
        _Pragma("unroll") \
        for (int st = 0; st < 4; ++st) S[st] = (f32x4){0.f, 0.f, 0.f, 0.f}; \
        _Pragma("unroll") \
        for (int ks = 0; ks < 4; ++ks) \
        _Pragma("unroll") \
            for (int st = 0; st < 4; ++st) S[st] = mfma16(Kf[st][ks], Qf[ks], S[st]); \
 \
 \
        const unsigned mlo = (unsigned)(mw >> (4 * g)), mhi = (unsigned)((mw >> (4 * g)) >> 32); \
        float psum = 0.f; \
        _Pragma("unroll") \
        for (int st = 0; st < 4; ++st) \
        _Pragma("unroll") \
            for (int r = 0; r < 4; ++r) { const int bit = 16 * st + 4 * g + r; float s = S[st][r]; \
                if (NEAR_) { const int dist = qps - pos[t * 64 + bit]; if (dist >= 0 && dist < 128) s += tab[dist]; } \
                s = fminf(fmaxf(s, -120.f), 120.f); \
                const unsigned word = st < 2 ? mlo : mhi; const unsigned sel = word & (1u << ((16 * st + r) & 31)); \
                const float p = sel ? __builtin_amdgcn_exp2f(s) : 0.f; \
                S[st][r] = p; psum += p; } \
        lsum += psum; \
 \
        bf16x8 Pf[2]; \
        _Pragma("unroll") \
        for (int kk = 0; kk < 2; ++kk) { v4u w; w.x = pk2(S[2 * kk][0], S[2 * kk][1]); w.y = pk2(S[2 * kk][2], S[2 * kk][3]); w.z = pk2(S[2 * kk + 1][0], S[2 * kk + 1][1]); w.w = pk2(S[2 * kk + 1][2], S[2 * kk + 1][3]); \
            Pf[kk] = __builtin_bit_cast(bf16x8, w); } \
 \
        _Pragma("unroll") \
        for (int dt = 0; dt < 8; ++dt) \
        _Pragma("unroll") \
            for (int kk = 0; kk < 2; ++kk) { \
                LAS unsigned char* ap = Vb + (32 * kk + 4 * g + (qi >> 2)) * ATT_VP + (16 * dt + 4 * (qi & 3)) * 2; \
                const s16x4 a0 = __builtin_amdgcn_ds_read_tr16_b64_v4i16((LAS s16x4*)ap), a1 = __builtin_amdgcn_ds_read_tr16_b64_v4i16((LAS s16x4*)(ap + 16 * ATT_VP)); \
                const bf16x8 A = (bf16x8){a0[0], a0[1], a0[2], a0[3], a1[0], a1[1], a1[2], a1[3]}; \
                O[dt] = mfma16(A, Pf[kk], O[dt]); } \


__device__ __forceinline__ void attn_unit(Frame& F, int qb, int head) {
    const bf16* qg = (const bf16*)(F.ws + WS_Q); const bf16* kvb = (const bf16*)(F.ws + WS_KV);
    const unsigned long long* maskg = (const unsigned long long*)(F.ws + WS_MASK);
    const int* pos = (const int*)F.in(2);
    const int qi = F.lane & 15, g = F.lane >> 4;
    const int qrow = qb * 128 + F.wave * 16 + qi;
    LAS float* tab = (LAS float*)(F.lds + ATT_TAB);
    __syncthreads();
    if (F.tid < 128) { const float* relb = F.in(5); tab[F.tid] = (relb[(int)REL_BUCKET[F.tid] * 8 + head] - relb[31 * 8 + head]) * 1.4426950408889634f; }
    bf16x8 Qf[4];
#pragma unroll
    for (int ks = 0; ks < 4; ++ks) Qf[ks] = *(const GAS bf16x8*)(qg + (size_t)qrow * 1024 + head * 128 + ks * 32 + 8 * g);
    const int qps = pos[qrow];
    const int qpmin = pos[qb * 128 + F.wave * 16];
    f32x4 O[8];
#pragma unroll
    for (int d = 0; d < 8; ++d) O[d] = (f32x4){0.f, 0.f, 0.f, 0.f};
    float lsum = 0.f;
    const int ntiles = 2 * (qb + 1);
    int tnear = ntiles;
    while (tnear > 0 && (qpmin - pos[(tnear - 1) * 64 + 63]) < 113) --tnear;
    v4u kst[2], vst[2];
    ATT_LOAD_TILE(0);
    unsigned long long mw_next = maskg[(size_t)qrow * 128];
    int t = 0;
    for (; t < tnear; ++t) { ATT_TILE_BODY(false) }
    for (; t < ntiles; ++t) { ATT_TILE_BODY(true) }
    lsum += __shfl_xor(lsum, 16); lsum += __shfl_xor(lsum, 32);
    const float inv = 1.f / lsum;
    bf16* op = (bf16*)(F.ws + WS_ATT) + (size_t)qrow * 1024 + head * 128 + 4 * g;
#pragma unroll
    for (int dt = 0; dt < 8; ++dt) { v2u w; w.x = pk2(O[dt][0] * inv, O[dt][1] * inv); w.y = pk2(O[dt][2] * inv, O[dt][3] * inv); *(GAS v2u*)(op + 16 * dt) = w; }
}

__device__ __forceinline__ float unsortable(unsigned k) { return __builtin_bit_cast(float, (k & 0x80000000u) ? (k & 0x7fffffffu) : ~k); }
#define DOT2(a, b, c) dot2bf((a), (b), (c))
template <int N> __device__ __forceinline__ void bitonic_desc(unsigned (&k)[N]) {
#pragma unroll
    for (int size = 2; size <= N; size <<= 1)
#pragma unroll
        for (int stride = size >> 1; stride > 0; stride >>= 1)
#pragma unroll
            for (int i = 0; i < N; ++i) { const int l = i ^ stride;
                if (l > i) { const bool desc = (i & size) == 0; const unsigned hi = k[i] > k[l] ? k[i] : k[l], lo = k[i] > k[l] ? k[l] : k[i]; k[i] = desc ? hi : lo; k[l] = desc ? lo : hi; } }
}

__device__ __forceinline__ void peer_unit(Frame& F, int unit) {
    const int tok0 = unit * 32;
    const bf16* pq = (const bf16*)(F.ws + WS_PQ); const bf16* subk = (const bf16*)(F.ws + WS_SUBK);
    LAS float* topS = (LAS float*)F.lds; LAS int* topI = (LAS int*)(F.lds + 32768);
    LAS int* esel = (LAS int*)(F.lds + 65536); LAS float* ew = (LAS float*)(F.lds + 81920); LAS float* eu = (LAS float*)(F.lds + 98304);
    const int r = F.lane & 31, hh = F.lane >> 5;
    for (int repAB = 0; repAB < (DBG_REP_SUB == 3 ? 2 : 1); ++repAB) {
#ifndef NO_A
    {
        const int h = F.wave;
        for (int p = 0; p < 2; ++p) {
            const int hp = h * 2 + p;
            bf16x8 Bq[8];
#pragma unroll
            for (int ks = 0; ks < 8; ++ks) Bq[ks] = *(const GAS bf16x8*)(pq + (size_t)(tok0 + r) * 2048 + hp * 128 + ks * 16 + 8 * hh);
            unsigned key[64];
#pragma unroll
            for (int kt = 0; kt < 4; ++kt) { f32x16 acc;
#pragma unroll
                for (int e = 0; e < 16; ++e) acc[e] = 0.f;
#pragma unroll
                for (int ks = 0; ks < 8; ++ks) { const bf16x8 A = *(const GAS bf16x8*)(subk + ((size_t)hp * 128 + kt * 32 + r) * 128 + ks * 16 + 8 * hh); acc = mfma32(A, Bq[ks], acc); }
#pragma unroll
                for (int e = 0; e < 16; ++e) key[kt * 16 + e] = sortable(acc[e]);
                __builtin_amdgcn_sched_barrier(0); }
            unsigned thr = 0u;
            for (int bit = 31; bit >= 16; --bit) { const unsigned cand = thr | (1u << bit); int c = 0;
#pragma unroll
                for (int i = 0; i < 64; ++i) c += (key[i] >= cand) ? 1 : 0;
                c += __shfl_xor(c, 32);
                if (c >= PE_TOPK) thr = cand; }
            int ngt = 0, neq = 0;
            const unsigned thr_hi = thr + 0x10000u;
#pragma unroll
            for (int i = 0; i < 64; ++i) { ngt += (key[i] >= thr_hi) ? 1 : 0; neq += (key[i] >= thr && key[i] < thr_hi) ? 1 : 0; }
            const int pgt = __shfl_xor(ngt, 32), peq = __shfl_xor(neq, 32);
            int pg = hh ? pgt : 0, pe = ngt + pgt + (hh ? peq : 0);
            LAS float* ls = topS + ((r * 8 + h) * 2 + p) * 16; LAS int* li = topI + ((r * 8 + h) * 2 + p) * 16;
            unsigned thr2 = thr; asm volatile("" : "+v"(thr2)); const unsigned thr2_hi = thr2 + 0x10000u;
#pragma unroll
            for (int kt = 0; kt < 4; ++kt)
#pragma unroll
                for (int e = 0; e < 16; ++e) { const unsigned k = key[kt * 16 + e]; const int kidx = kt * 32 + (e & 3) + 8 * (e >> 2) + 4 * hh;
                    if (k >= thr2_hi) { ls[pg] = unsortable(k); li[pg] = kidx; ++pg; }
                    else if (k >= thr2) { if (pe < PE_TOPK) { ls[pe] = unsortable(k); li[pe] = kidx; } ++pe; } }
        }
    }
#endif
    __syncthreads();
#ifndef NO_B
    if (F.wave < 4) {
        int lnB = F.lane; asm volatile("" : "+v"(lnB));
        const int L = F.wave * 64 + lnB, tk = L >> 3, hd = L & 7;
        unsigned k0[16], k1[16];
#pragma unroll
        for (int a = 0; a < 16; ++a) { k0[a] = (sortable(topS[((tk * 8 + hd) * 2 + 0) * 16 + a]) & 0xFFFFFF80u) | (unsigned)topI[((tk * 8 + hd) * 2 + 0) * 16 + a];
                                       k1[a] = (sortable(topS[((tk * 8 + hd) * 2 + 1) * 16 + a]) & 0xFFFFFF80u) | (unsigned)topI[((tk * 8 + hd) * 2 + 1) * 16 + a]; }
        bitonic_desc<16>(k0); bitonic_desc<16>(k1);
        float s0[16], s1[16];
#pragma unroll
        for (int a = 0; a < 16; ++a) { s0[a] = unsortable(k0[a] & 0xFFFFFF80u); s1[a] = unsortable(k1[a] & 0xFFFFFF80u); }
        unsigned cs[64];
        { int q = 0;
#pragma unroll
          for (int a = 0; a < 16; ++a)
#pragma unroll
              for (int b = 0; b < 16; ++b) if ((a + 1) * (b + 1) <= 16) { cs[q] = (sortable(s0[a] + s1[b]) & 0xFFFFC000u) | ((k0[a] & 127u) << 7) | (k1[b] & 127u); ++q; }
#pragma unroll
          for (int z = 50; z < 64; ++z) cs[z] = 0u; }
        bitonic_desc<64>(cs);
        const float top = unsortable(cs[0] & 0xFFFFC000u);
        float den = 0.f, wv[16]; const int ob = tk * 128 + hd * 16;
#pragma unroll
        for (int n = 0; n < 16; ++n) { wv[n] = __expf(unsortable(cs[n] & 0xFFFFC000u) - top); den += wv[n]; esel[ob + n] = (int)(cs[n] & 0x3FFFu); }
        const float inv = 1.f / den;
        const float* psc = (const float*)(F.ws + WS_PSC);
#pragma unroll
        for (int n = 0; n < 16; ++n) { const int e = (int)(cs[n] & 0x3FFFu); ew[ob + n] = wv[n] * inv * psc[PE_NE + e]; eu[ob + n] = psc[e]; }
    }
#endif
    __syncthreads();
    }
#ifndef NO_C
    {
        int lnC = F.lane; asm volatile("" : "+v"(lnC));
        const float* h1f = (const float*)(F.ws + WS_H1F);
        const unsigned char* PU = (const unsigned char*)(F.ws + WS_PU); const unsigned char* PV = (const unsigned char*)(F.ws + WS_PV);
        float* rf = (float*)(F.ws + WS_RF); bf16* rb = (bf16*)(F.ws + WS_RB);
#pragma unroll 1
        for (int tt = 0; tt < 4; ++tt) {
            const int tl = F.wave * 4 + tt, tok = tok0 + tl;
            f32x2 xv[16], o[16];
#pragma unroll
            for (int i = 0; i < 2; ++i)
#pragma unroll
                for (int c = 0; c < 4; ++c) { const f32x4 hv = *(const GAS f32x4*)(h1f + (size_t)tok * DM + i * 1024 + lnC * 16 + c * 4);
                    xv[i * 8 + c * 2] = (f32x2){hv.x, hv.y}; xv[i * 8 + c * 2 + 1] = (f32x2){hv.z, hv.w}; }
#pragma unroll
            for (int e = 0; e < 16; ++e) o[e] = (f32x2){0.f, 0.f};
#pragma unroll 1
            for (int e0 = 0; e0 < DBG_PEER_NEXP; e0 += 4) {
                v4u uq[4][2], vq[4][2]; float gv[4], su[4];
#pragma unroll
                for (int k = 0; k < 4; ++k) { const int id = __builtin_amdgcn_readfirstlane(esel[tl * 128 + e0 + k]); gv[k] = ew[tl * 128 + e0 + k]; su[k] = eu[tl * 128 + e0 + k];
                    const GAS v4u* up = (const GAS v4u*)(PU + (size_t)id * DM) + lnC; const GAS v4u* vp = (const GAS v4u*)(PV + (size_t)id * DM) + lnC;
                    uq[k][0] = up[0]; uq[k][1] = up[64]; vq[k][0] = vp[0]; vq[k][1] = vp[64]; }
                float av[4];
#pragma unroll
                for (int k = 0; k < 4; ++k) { f32x2 acc = (f32x2){0.f, 0.f};
#pragma unroll
                    for (int i = 0; i < 2; ++i)
#pragma unroll
                        for (int c = 0; c < 4; ++c) { const int w = (int)uq[k][i][c];
                            acc = __builtin_amdgcn_cvt_pk_f32_fp8(w, false) * xv[i * 8 + c * 2] + acc; acc = __builtin_amdgcn_cvt_pk_f32_fp8(w, true) * xv[i * 8 + c * 2 + 1] + acc; }
                    av[k] = acc.x + acc.y; }
#pragma unroll
                for (int k = 0; k < 4; ++k) av[k] = wave_sum(av[k]);
#pragma unroll
                for (int k = 0; k < 4; ++k) { const float a = gv[k] * gelu_tanh(av[k] * su[k]); const f32x2 a2 = (f32x2){a, a};
#pragma unroll
                    for (int i = 0; i < 2; ++i)
#pragma unroll
                        for (int c = 0; c < 4; ++c) { const int w = (int)vq[k][i][c];
                            o[i * 8 + c * 2] = __builtin_amdgcn_cvt_pk_f32_fp8(w, false) * a2 + o[i * 8 + c * 2]; o[i * 8 + c * 2 + 1] = __builtin_amdgcn_cvt_pk_f32_fp8(w, true) * a2 + o[i * 8 + c * 2 + 1]; } }
            }
#pragma unroll
            for (int i = 0; i < 2; ++i)
#pragma unroll
                for (int c = 0; c < 4; ++c) { const size_t off = (size_t)tok * DM + i * 1024 + lnC * 16 + c * 4;
                    f32x2 ra = xv[i * 8 + c * 2] * ALPHA + o[i * 8 + c * 2], rbv = xv[i * 8 + c * 2 + 1] * ALPHA + o[i * 8 + c * 2 + 1];
#if DBG_NO_PEER
                    ra = xv[i * 8 + c * 2] * ALPHA; rbv = xv[i * 8 + c * 2 + 1] * ALPHA;
#endif
                    *(GAS f32x4*)(rf + off) = (f32x4){ra.x, ra.y, rbv.x, rbv.y};
                    v2u w; w.x = pk2(ra.x, ra.y); w.y = pk2(rbv.x, rbv.y); *(GAS v2u*)(rb + off) = w; }
        }
    }
#endif
    __syncthreads();
}

struct Args { const float* in[24]; float* out; unsigned char* ws; int ph_lo, ph_hi; };
constexpr int N_PHASES = 11;

__global__ void __launch_bounds__(NTHREADS, 2) mega_fwd(Args args) {
    extern __shared__ __attribute__((aligned(16))) unsigned char lds_raw[];
    const int lo = args.ph_lo, hi = args.ph_hi;
#if MK_COOP
    cg::grid_group grid = cg::this_grid();
    if (threadIdx.x < 2) ((LAS unsigned*)(lds_raw + LDS_BARST))[threadIdx.x] = 0u;
    __syncthreads();
    XcdBarrier xbar = xcd_barrier_post((unsigned*)(args.ws + WS_CTL) + 1024, (volatile LAS unsigned*)((LAS unsigned char*)lds_raw + LDS_BARST));
    int nbar_ = 0;
#if DBG_ALL_CG
#define GRID_BAR() grid.sync()
#else
#define GRID_BAR() do { if (nbar_++ == 0) grid.sync(); else xcd_barrier(xbar); } while (0)
#endif
#else
#define GRID_BAR() do {} while (0)
#endif
#define IN(k) (lo <= (k) && (k) < hi)
#define NREP(k) ((k) == DBG_REP_PHASE ? 2 : 1)
#define BOTH(k) (IN(k) && IN((k) + 1))

    if (IN(0)) for (int rep_ = 0; rep_ < NREP(0); ++rep_) { if (rep_) GRID_BAR(); MAKE_FRAME(F); p0_prologue(F); if (BOTH(0) && rep_ + 1 == NREP(0)) GRID_BAR(); }

    if (IN(1)) for (int rep_ = 0; rep_ < NREP(1); ++rep_) {
        if (rep_) GRID_BAR();
        MAKE_FRAME(F); unsigned char* ws = F.ws; LAS unsigned char* glds = F.lds;
        pg8::Gemm g{(const bf16*)(ws + WS_HB), (const bf16*)(ws + WS_WIN), SEQ, INW_PAD, DM}; asm volatile("" : "+s"(g.K), "+s"(g.N), "+s"(g.M)); pg8::StaticOrder S; S.init(SEQ, INW_PAD, F.G, F.bid);
        pg8::EpiWin E{(bf16*)(ws + WS_Q), (bf16*)(ws + WS_KV), (bf16*)(ws + WS_QI), (bf16*)(ws + WS_GU), (bf16*)(ws + WS_GV), (bf16*)(ws + WS_GA), (bf16*)(ws + WS_GG), (bf16*)(ws + WS_KIWI)};
        pg8::gemm_phase<pg8::EpiWin, pg8::StaticOrder, true, true>(glds, g, S, E);
        if (BOTH(1) && rep_ + 1 == NREP(1)) GRID_BAR();
    }

    if (IN(2)) for (int rep_ = 0; rep_ < NREP(2); ++rep_) {
        if (rep_) GRID_BAR();
        MAKE_FRAME(F); unsigned char* ws = F.ws; LAS unsigned char* glds = F.lds;
        for (int u = F.bid; u < 512; u += F.G) gmlp_unit(F, u);
#pragma unroll 1
        for (int k = F.bid, i = 0; k < 512; k += F.G, ++i) idx_unit(F, (F.G == 256 && i == 1) ? 511 - F.bid : k);
        if (BOTH(2) && rep_ + 1 == NREP(2)) GRID_BAR();
    }

    if (IN(3)) for (int rep_ = 0; rep_ < NREP(3); ++rep_) {
        if (rep_) GRID_BAR();
        MAKE_FRAME(F);
#pragma unroll 1
        for (int u = F.bid; u < 256; u += F.G) { const int head = u & 7, pair = u >> 3;
#pragma unroll 1
            for (int i = 0; i < 2; ++i) attn_unit(F, i ? 63 - pair : pair, head); }
        if (BOTH(3) && rep_ + 1 == NREP(3)) GRID_BAR();
    }

    if (IN(4)) for (int rep_ = 0; rep_ < NREP(4); ++rep_) {
        if (rep_) GRID_BAR();
        MAKE_FRAME(F); unsigned char* ws = F.ws; LAS unsigned char* glds = F.lds;
        { pg8::Gemm g{(const bf16*)(ws + WS_ATT), (const bf16*)(ws + WS_WA), SEQ, DM, AW}; asm volatile("" : "+s"(g.K), "+s"(g.N), "+s"(g.M)); pg8::StaticOrder S; S.init(SEQ, DM, F.G, F.bid);
          pg8::EpiGateF32 E{(const bf16*)(ws + WS_GA), (float*)(ws + WS_T), DM};
          pg8::gemm_phase<pg8::EpiGateF32, pg8::StaticOrder, true, true>(glds, g, S, E); }
        __syncthreads();
        { pg8::Gemm g{(const bf16*)(ws + WS_GM), (const bf16*)(ws + WS_WG), SEQ, DM, GW}; asm volatile("" : "+s"(g.K), "+s"(g.N), "+s"(g.M)); pg8::StaticOrder S; S.init(SEQ, DM, F.G, F.bid);
          pg8::EpiMerge E{(const bf16*)(ws + WS_GG), (const float*)(ws + WS_T), (bf16*)(ws + WS_MERGED), DM};
          pg8::gemm_phase<pg8::EpiMerge, pg8::StaticOrder, true, true>(glds, g, S, E); }
        if (BOTH(4) && rep_ + 1 == NREP(4)) GRID_BAR();
    }

    if (IN(5)) for (int rep_ = 0; rep_ < NREP(5); ++rep_) {
        if (rep_) GRID_BAR();
        MAKE_FRAME(F); unsigned char* ws = F.ws; LAS unsigned char* glds = F.lds;
        pg8::Gemm g{(const bf16*)(ws + WS_MERGED), (const bf16*)(ws + WS_WMIX), SEQ, DM, DM}; asm volatile("" : "+s"(g.K), "+s"(g.N), "+s"(g.M)); pg8::StaticOrder S; S.init(SEQ, DM, F.G, F.bid);
        pg8::EpiMix E{F.in(0), (const float*)(ws + WS_STATS), F.in(3), F.in(4), F.out, DM};
        pg8::gemm_phase<pg8::EpiMix, pg8::StaticOrder, true, true>(glds, g, S, E);
        if (BOTH(5) && rep_ + 1 == NREP(5)) GRID_BAR();
    }

    if (IN(6)) for (int rep_ = 0; rep_ < NREP(6); ++rep_) {
        if (rep_) GRID_BAR();
        MAKE_FRAME(F); unsigned char* ws = F.ws; LAS unsigned char* glds = F.lds;
        const int gw = F.bid * NWAVES + F.wave, NGW = F.G * NWAVES;
        for (int m = gw; m < SEQ; m += NGW) ln_row(F, F.out + (size_t)m * DM, F.in(14), F.in(15), (bf16*)(ws + WS_H1B) + (size_t)m * DM, (float*)(ws + WS_H1F) + (size_t)m * DM, nullptr);
        if (BOTH(6) && rep_ + 1 == NREP(6)) GRID_BAR();
    }

    if (IN(7)) for (int rep_ = 0; rep_ < NREP(7); ++rep_) {
        if (rep_) GRID_BAR();
        MAKE_FRAME(F); unsigned char* ws = F.ws; LAS unsigned char* glds = F.lds;
        pg8::Gemm g{(const bf16*)(ws + WS_H1B), (const bf16*)(ws + WS_WQ), SEQ, DM, DM}; asm volatile("" : "+s"(g.K), "+s"(g.N), "+s"(g.M)); pg8::StaticOrder S; S.init(SEQ, DM, F.G, F.bid);
        pg8::EpiBf16<0> E{(bf16*)(ws + WS_PQ), DM, nullptr, 0, 0, 1.f};
        pg8::gemm_phase<pg8::EpiBf16<0>, pg8::StaticOrder, true, true>(glds, g, S, E);
        if (BOTH(7) && rep_ + 1 == NREP(7)) GRID_BAR();
    }

    if (IN(8)) for (int rep_ = 0; rep_ < NREP(8); ++rep_) {
        if (rep_) GRID_BAR();
        MAKE_FRAME(F); unsigned char* ws = F.ws; LAS unsigned char* glds = F.lds;
        for (int u = F.bid; u < SEQ / 32; u += F.G) peer_unit(F, u);
        if (BOTH(8) && rep_ + 1 == NREP(8)) GRID_BAR();
    }

    if (IN(9)) for (int rep_ = 0; rep_ < NREP(9); ++rep_) {
        if (rep_) GRID_BAR();
        MAKE_FRAME(F); unsigned char* ws = F.ws; LAS unsigned char* glds = F.lds;
        { pg8::Gemm g{(const bf16*)(ws + WS_PB), (const bf16*)(ws + WS_WPP), SEQ, DM, PLE}; asm volatile("" : "+s"(g.K), "+s"(g.N), "+s"(g.M)); pg8::StaticOrder S; S.init(SEQ, DM, F.G, F.bid);
          pg8::EpiF32 E{(float*)(ws + WS_T2), DM};
          pg8::gemm_phase<pg8::EpiF32, pg8::StaticOrder, true, true>(glds, g, S, E); }
        __syncthreads();
        { pg8::Gemm g{(const bf16*)(ws + WS_RB), (const bf16*)(ws + WS_WPG), SEQ, DM, DM}; asm volatile("" : "+s"(g.K), "+s"(g.N), "+s"(g.M)); pg8::StaticOrder S; S.init(SEQ, DM, F.G, F.bid);
          pg8::EpiPle E{(const float*)(ws + WS_RF), (const float*)(ws + WS_T2), F.out, DM};
          pg8::gemm_phase<pg8::EpiPle, pg8::StaticOrder, true, true>(glds, g, S, E); }
        if (BOTH(9) && rep_ + 1 == NREP(9)) GRID_BAR();
    }

    if (IN(10)) for (int rep_ = 0; rep_ < NREP(10); ++rep_) {
        if (rep_) GRID_BAR();
        MAKE_FRAME(F); unsigned char* ws = F.ws; LAS unsigned char* glds = F.lds;
        const int gw = F.bid * NWAVES + F.wave, NGW = F.G * NWAVES;
        for (int m = gw; m < SEQ; m += NGW) ln_row(F, F.out + (size_t)m * DM, F.in(22), F.in(23), nullptr, F.out + (size_t)m * DM, nullptr);
    }
}

extern "C" void kernel_launch(void* const* d_in, const int* in_sizes, int n_in, void* d_out, int out_size, void* d_ws, size_t ws_size, hipStream_t stream) {
    static int grid = 0;
    if (grid == 0) {
        if (n_in != 24 || out_size != SEQ * DM || ws_size < WS_END) { fprintf(stderr, "kernel_launch: unexpected problem: n_in %d out %d ws %zu (need %zu)\n", n_in, out_size, ws_size, (size_t)WS_END); grid = -1; return; }
        int dev = 0, cus = 0, per_cu = 0;
        if (hipGetDevice(&dev) != hipSuccess || hipDeviceGetAttribute(&cus, hipDeviceAttributeMultiprocessorCount, dev) != hipSuccess) { grid = -1; return; }
        if (hipFuncSetAttribute((const void*)mega_fwd, hipFuncAttributeMaxDynamicSharedMemorySize, LDS_BYTES) != hipSuccess) { fprintf(stderr, "kernel_launch: hipFuncSetAttribute failed\n"); grid = -1; return; }
        if (hipOccupancyMaxActiveBlocksPerMultiprocessor(&per_cu, (const void*)mega_fwd, NTHREADS, LDS_BYTES) != hipSuccess || per_cu < 1) { fprintf(stderr, "kernel_launch: occupancy query says %d blocks per CU\n", per_cu); (void)hipGetLastError(); grid = -1; return; }
        grid = cus;
        fprintf(stderr, "kernel_launch: grid %d (per_cu %d), ws %zu\n", grid, per_cu, ws_size);
    }
    if (grid < 0) return;
    if (hipMemsetAsync((char*)d_ws + WS_CTL, 0, CTL_ZERO_BYTES, stream) != hipSuccess) { fprintf(stderr, "kernel_launch: memset of the barrier words failed\n"); return; }
    Args a{};
    for (int i = 0; i < 24; ++i) a.in[i] = (const float*)d_in[i];
    a.out = (float*)d_out; a.ws = (unsigned char*)d_ws;
#if MK_COOP
    a.ph_lo = 0; a.ph_hi = N_PHASES;
    void* kargs[] = {&a};
    hipError_t e = hipLaunchCooperativeKernel((const void*)mega_fwd, dim3(grid), dim3(NTHREADS), kargs, LDS_BYTES, stream);
    if (e != hipSuccess) fprintf(stderr, "kernel_launch: cooperative launch failed: %s\n", hipGetErrorString(e));
#else
    for (int ph = 0; ph < N_PHASES; ++ph) { a.ph_lo = ph; a.ph_hi = ph + 1; hipLaunchKernelGGL(mega_fwd, dim3(grid), dim3(NTHREADS), LDS_BYTES, stream, a); }
#endif
}
```

```cpp
#include <hip/hip_runtime.h>
#include <hip/hip_cooperative_groups.h>
#include <cstdio>
#include <cstdint>
namespace cg = cooperative_groups;
#ifndef MK_COOP
#define MK_COOP 1
#endif
#define DBG_NO_ATTN 0
#define DBG_ATTN_X2 0
#define DBG_PEER_X2 0
#define DBG_NO_PEER 0
#define DBG_NO_GMLP 0
#define DBG_GMLP_X2 0
#define DBG_PLE_S 1.0f
#define DBG_MIX_S 1.0f
#define DBG_ATTN_HI_S 1.0f
#define DBG_LOGIT_S 1.0f
#define DBG_NO_BIAS 0
#define DBG_REP_PHASE -1
#define DBG_REP_SUB 0
#define DBG_ALL_CG 0
#define DBG_PEER_NEXP 128
namespace pg8 {
#define PG8_LAS __attribute__((address_space(3)))
typedef unsigned short bf16_t;
typedef short bf16x8 __attribute__((ext_vector_type(8)));
typedef float f32x4 __attribute__((ext_vector_type(4)));
typedef unsigned u32x4 __attribute__((ext_vector_type(4)));
constexpr int BM = 256, BK = 64, HALF = 128, HTB = HALF * BK * 2  , STAGE_BYTES = 8 * HTB, NXCD = 8, WGM = 8;

__host__ __device__ __forceinline__ int lds_byte(int r, int c) { const int st = (r >> 4) * 2 + (c >> 5), rr = r & 15, cc = c & 31, ob = rr * 64 + cc * 2; return st * 1024 + (ob ^ (((ob >> 9) & 1) << 5)); }
__host__ __device__ __forceinline__ void stage_rc(int b, int& R, int& C) { const int st = b / 1024, sb = b % 1024, swz = sb ^ (((sb >> 9) & 1) << 5); R = (st >> 1) * 16 + swz / 64; C = (st & 1) * 32 + (swz % 64) / 2; }
__host__ __device__ __forceinline__ int perm32(int rho) { const int n = rho >> 4, i = rho & 15; return 8 * (i >> 2) + 4 * n + (i & 3); }

struct Unit { int pm, pn; };
struct Gemm { const bf16_t* A; const bf16_t* Bt; int M, N, K; };

struct StaticOrder {
    int nM, nN, nwg, G, c;
    __host__ __device__ void init(int M, int N, int G_, int c_) { nM = M / BM; nN = N / BM; nwg = nM * nN; G = G_; c = c_; }
    __host__ __device__ bool next(int i, Unit& u) const {
        const long L = (long)i * G + c; if (L >= nwg) return false;
        int wgid = (int)L; { const int q = nwg / NXCD, r = nwg % NXCD, xcd = wgid % NXCD, off = wgid / NXCD; wgid = (xcd < r ? xcd * (q + 1) : r * (q + 1) + (xcd - r) * q) + off; }
        const int nig = WGM * nN, gid = wgid / nig, fm = gid * WGM, gsz = (nM - fm) < WGM ? (nM - fm) : WGM;
        u.pm = fm + ((wgid % nig) % gsz); u.pn = (wgid % nig) / gsz; return true;
    }
    __device__ __forceinline__ void a_ready(const Unit&) const {}
    __device__ __forceinline__ void done(const Unit&) const {}
};

__device__ __forceinline__ unsigned cvt_pk_bf16(float lo, float hi) { unsigned r; asm volatile("v_cvt_pk_bf16_f32 %0, %1, %2" : "=v"(r) : "v"(lo), "v"(hi)); return r; }
typedef float f32x2 __attribute__((ext_vector_type(2)));
__device__ __forceinline__ f32x2 gelu_pk(f32x2 v) {
    const f32x2 av = __builtin_elementwise_abs(v), d = av * 0.2316418882f + 1.0f;
    f32x2 t; t.x = __builtin_amdgcn_rcpf(d.x); t.y = __builtin_amdgcn_rcpf(d.y);
    f32x2 q = t * 0.5307027145f + (-0.7265760135f); q = q * t + 0.7107068705f; q = q * t + (-0.142248368f); q = q * t + 0.127414796f; q = q * t;
    const f32x2 s = (v * v) * (-0.72134752044f);
    f32x2 e; e.x = __builtin_amdgcn_exp2f(s.x); e.y = __builtin_amdgcn_exp2f(s.y);
    const f32x2 m = v * (q * e), r = v - m;
    f32x2 o; o.x = v.x < 0.f ? m.x : r.x; o.y = v.y < 0.f ? m.y : r.y; return o;
}

template <int ACT  > struct EpiBf16 {
    static constexpr bool PERM = true, AFTER_DRAIN = false; static_assert(ACT == 0 || ACT == 1, "EpiBf16: ACT is 0 (none) or 1 (gelu_pk)");
    bf16_t* O; int ldc; const float* bias; int split_cols; size_t split_stride; float scale0;
    __device__ __forceinline__ void operator()(const f32x4 (&acc)[2][2][4][2], const Unit& u, int wr, int wc, int fr, int fq) const {
        const int row0 = u.pm * BM + wr * 64 + fr; int colt = u.pn * BM; bf16_t* base = O;
        float sc = 1.f; if (split_cols) { const int t = colt / split_cols; base += (size_t)t * split_stride; colt -= t * split_cols; if (t == 0) sc = scale0; }
        const int col0 = colt + wc * 32 + 8 * fq, bcol0 = u.pn * BM + wc * 32 + 8 * fq;
        f32x4 bv[2][2];
#pragma unroll
        for (int bj = 0; bj < 2; ++bj)
#pragma unroll
            for (int n = 0; n < 2; ++n) bv[bj][n] = bias ? *(const f32x4*)(bias + bcol0 + bj * HALF + 4 * n) : (f32x4){0.f, 0.f, 0.f, 0.f};
#pragma unroll
        for (int ai = 0; ai < 2; ++ai)
#pragma unroll
            for (int m = 0; m < 4; ++m) { bf16_t* rowp = base + (size_t)(row0 + ai * HALF + m * 16) * ldc + col0;
#pragma unroll
                for (int bj = 0; bj < 2; ++bj) { f32x4 v0 = acc[ai][bj][m][0] + bv[bj][0], v1 = acc[ai][bj][m][1] + bv[bj][1];
                    if (ACT == 1) { f32x2 a = gelu_pk((f32x2){v0[0], v0[1]}), b = gelu_pk((f32x2){v0[2], v0[3]}), c = gelu_pk((f32x2){v1[0], v1[1]}), d = gelu_pk((f32x2){v1[2], v1[3]});
                        v0 = (f32x4){a.x, a.y, b.x, b.y}; v1 = (f32x4){c.x, c.y, d.x, d.y}; }
                    v0 = v0 * sc; v1 = v1 * sc; u32x4 w; w.x = cvt_pk_bf16(v0[0], v0[1]); w.y = cvt_pk_bf16(v0[2], v0[3]); w.z = cvt_pk_bf16(v1[0], v1[1]); w.w = cvt_pk_bf16(v1[2], v1[3]);
                    *(u32x4*)(rowp + bj * HALF) = w; } }
    }
};
template <class Epi, class Sched, bool ALIGN_EPI = false, bool SP2 = false>
__device__ __forceinline__ void gemm_phase(PG8_LAS unsigned char* lds, const Gemm g, const Sched& S, const Epi& E) {
    const int tid = threadIdx.x, wid = __builtin_amdgcn_readfirstlane(tid >> 6), lane = tid & 63, wr = wid >> 2, wc = wid & 3, fr = lane & 15, fq = lane >> 4;
    const int K = g.K, nt = K / BK;
    unsigned voffA[2], voffB[2];
#pragma unroll
    for (int i = 0; i < 2; ++i) { int R, C; stage_rc(tid * 16 + i * 8192, R, C); const int Rb = Epi::PERM ? ((R & ~31) + perm32(R & 31)) : R;
        voffA[i] = (unsigned)(R * K + C) * 2u; voffB[i] = (unsigned)(Rb * K + C) * 2u; }
    const size_t kstep = (size_t)(BK * 2);
    const size_t hstep = (size_t)HALF * K * 2;
    const size_t tstep = 2 * hstep;
    const unsigned ldsw = (unsigned)wid * 1024u;
    const int aoff = lds_byte(wr * 64 + fr, fq * 8), boff = lds_byte(wc * 32 + fr, fq * 8);
#define PG8_SA(b, h) (((b) * 2 + (h)) * HTB)
#define PG8_SB(b, h) ((4 + (b) * 2 + (h)) * HTB)
#define PG8_STAGE(bufoff, gbase, voff) do { _Pragma("unroll") for (int _i = 0; _i < 2; ++_i) \
        __builtin_amdgcn_global_load_lds((const unsigned*)((const char*)(gbase) + (voff)[_i]), (PG8_LAS unsigned*)(lds + (bufoff) + ldsw + _i * 8192), 16, 0, 0); } while (0)
#define PG8_LDA(dst, b, h) do { _Pragma("unroll") for (int m = 0; m < 4; ++m) _Pragma("unroll") for (int k = 0; k < 2; ++k) dst[m][k] = *(const PG8_LAS bf16x8*)(lds + PG8_SA(b, h) + aoff + m * 2048 + k * 1024); } while (0)
#define PG8_LDB(dst, b, h) do { _Pragma("unroll") for (int n = 0; n < 2; ++n) _Pragma("unroll") for (int k = 0; k < 2; ++k) dst[n][k] = *(const PG8_LAS bf16x8*)(lds + PG8_SB(b, h) + boff + n * 2048 + k * 1024); } while (0)
#define PG8_MMA(ai, bj, At, Bt) do { __builtin_amdgcn_s_setprio(1); _Pragma("unroll") for (int m = 0; m < 4; ++m) _Pragma("unroll") for (int n = 0; n < 2; ++n) _Pragma("unroll") for (int k = 0; k < 2; ++k) \
        acc[ai][bj][m][n] = __builtin_amdgcn_mfma_f32_16x16x32_bf16(Bt[n][k], At[m][k], acc[ai][bj][m][n], 0, 0, 0); __builtin_amdgcn_s_setprio(0); } while (0)
#define PG8_WAIT_V(n) asm volatile("s_waitcnt vmcnt(" #n ")" ::: "memory")
#define PG8_WAIT_L(n) asm volatile("s_waitcnt lgkmcnt(" #n ")" ::: "memory")
#define PG8_BAR __builtin_amdgcn_s_barrier()
#define PG8_SCHED __builtin_amdgcn_sched_barrier(0)
    Unit cur, nxt; int ui = 0;
    if (!S.next(0, cur)) return;
    f32x4 acc[2][2][4][2];
#pragma unroll
    for (int a = 0; a < 2; ++a)
#pragma unroll
        for (int b = 0; b < 2; ++b)
#pragma unroll
            for (int m = 0; m < 4; ++m)
#pragma unroll
                for (int n = 0; n < 2; ++n) acc[a][b][m][n] = (f32x4){0.f, 0.f, 0.f, 0.f};
    bf16x8 At[4][2], B0[2][2], B1[2][2];
    const char* cA = (const char*)g.A + (size_t)cur.pm * tstep; const char* cB = (const char*)g.Bt + (size_t)cur.pn * tstep;
    S.a_ready(cur);
    if constexpr (SP2) {
        PG8_STAGE(PG8_SB(0, 0), cB, voffB); PG8_STAGE(PG8_SB(0, 1), cB + hstep, voffB); PG8_STAGE(PG8_SA(0, 0), cA, voffA); PG8_STAGE(PG8_SA(0, 1), cA + hstep, voffA);
        if (wr == 1) PG8_BAR;
        PG8_WAIT_V(2); PG8_BAR;
        PG8_STAGE(PG8_SB(1, 0), cB + kstep, voffB); PG8_STAGE(PG8_SA(1, 0), cA + kstep, voffA); PG8_STAGE(PG8_SB(1, 1), cB + hstep + kstep, voffB);
        PG8_WAIT_V(6); PG8_BAR;
    } else {
        PG8_STAGE(PG8_SB(0, 0), cB, voffB); PG8_STAGE(PG8_SA(0, 0), cA, voffA); PG8_STAGE(PG8_SB(0, 1), cB + hstep, voffB); PG8_STAGE(PG8_SA(0, 1), cA + hstep, voffA);
        if (wr == 1) PG8_BAR;
        PG8_WAIT_V(4); PG8_BAR;
        PG8_STAGE(PG8_SB(1, 0), cB + kstep, voffB); PG8_STAGE(PG8_SA(1, 0), cA + kstep, voffA); PG8_STAGE(PG8_SB(1, 1), cB + hstep + kstep, voffB);
        PG8_WAIT_V(6); PG8_BAR;
    }
    for (;;) {
        const bool has_next = S.next(ui + 1, nxt);
        const char* nA = has_next ? (const char*)g.A + (size_t)nxt.pm * tstep : cA; const char* nB = has_next ? (const char*)g.Bt + (size_t)nxt.pn * tstep : cB;
        for (int t = 0; t < nt; t += 2) {
            const bool last = (t == nt - 2);
            const char* a1 = cA + (size_t)(t + 1) * kstep;
            const char* a2 = last ? nA : cA + (size_t)(t + 2) * kstep; const char* b2 = last ? nB : cB + (size_t)(t + 2) * kstep;
            const char* a3 = a2 + kstep; const char* b3 = b2 + kstep;
            if (last && has_next) S.a_ready(nxt);
            if constexpr (SP2) {
            PG8_LDB(B0, 0, 0); PG8_LDB(B1, 0, 1); PG8_SCHED; PG8_LDA(At, 0, 0); PG8_STAGE(PG8_SA(1, 1), a1 + hstep, voffA);
            PG8_WAIT_V(8); PG8_WAIT_L(0); PG8_BAR; PG8_MMA(0, 0, At, B0); PG8_MMA(0, 1, At, B1); PG8_BAR; PG8_SCHED;
            PG8_LDA(At, 0, 1); PG8_STAGE(PG8_SB(0, 0), b2, voffB); PG8_STAGE(PG8_SB(0, 1), b2 + hstep, voffB); PG8_STAGE(PG8_SA(0, 0), a2, voffA);
            PG8_WAIT_V(8); PG8_WAIT_L(0); PG8_BAR; PG8_MMA(1, 0, At, B0); PG8_MMA(1, 1, At, B1); PG8_BAR; PG8_SCHED;
            PG8_LDB(B0, 1, 0); PG8_LDB(B1, 1, 1); PG8_SCHED; PG8_LDA(At, 1, 0); PG8_STAGE(PG8_SA(0, 1), a2 + hstep, voffA);
            PG8_WAIT_V(8); PG8_WAIT_L(0); PG8_BAR; PG8_MMA(0, 0, At, B0); PG8_MMA(0, 1, At, B1); PG8_BAR; PG8_SCHED;
            PG8_LDA(At, 1, 1); PG8_STAGE(PG8_SB(1, 0), b3, voffB); PG8_STAGE(PG8_SB(1, 1), b3 + hstep, voffB); PG8_STAGE(PG8_SA(1, 0), a3, voffA);
            PG8_WAIT_V(8); PG8_WAIT_L(0); PG8_BAR; PG8_MMA(1, 0, At, B0); PG8_MMA(1, 1, At, B1); PG8_BAR; PG8_SCHED;
            } else {
            PG8_LDB(B0, 0, 0); PG8_SCHED; PG8_LDA(At, 0, 0); PG8_STAGE(PG8_SA(1, 1), a1 + hstep, voffA);
            PG8_WAIT_L(8); PG8_BAR; PG8_WAIT_L(0); PG8_MMA(0, 0, At, B0); PG8_BAR; PG8_SCHED;
            PG8_LDB(B1, 0, 1); PG8_STAGE(PG8_SB(0, 0), b2, voffB);
            PG8_BAR; PG8_WAIT_L(0); PG8_MMA(0, 1, At, B1); PG8_BAR;
            PG8_LDA(At, 0, 1); PG8_STAGE(PG8_SA(0, 0), a2, voffA);
            PG8_BAR; PG8_WAIT_L(0); PG8_MMA(1, 0, At, B0); PG8_BAR; PG8_SCHED;
            PG8_STAGE(PG8_SB(0, 1), b2 + hstep, voffB);
            PG8_WAIT_V(6); PG8_BAR; PG8_MMA(1, 1, At, B1); PG8_BAR;
            PG8_LDB(B0, 1, 0); PG8_SCHED; PG8_LDA(At, 1, 0); PG8_STAGE(PG8_SA(0, 1), a2 + hstep, voffA);
            PG8_WAIT_L(8); PG8_BAR; PG8_WAIT_L(0); PG8_MMA(0, 0, At, B0); PG8_BAR; PG8_SCHED;
            PG8_LDB(B1, 1, 1); PG8_STAGE(PG8_SB(1, 0), b3, voffB);
            PG8_BAR; PG8_WAIT_L(0); PG8_MMA(0, 1, At, B1); PG8_BAR;
            PG8_LDA(At, 1, 1); PG8_STAGE(PG8_SA(1, 0), a3, voffA);
            PG8_BAR; PG8_WAIT_L(0); PG8_MMA(1, 0, At, B0); PG8_BAR; PG8_SCHED;
            PG8_STAGE(PG8_SB(1, 1), b3 + hstep, voffB);
            PG8_WAIT_V(6); PG8_BAR; PG8_MMA(1, 1, At, B1); PG8_BAR;
            }
        }
        if constexpr (ALIGN_EPI) { if (wr == 0) PG8_BAR; }
        if constexpr (!Epi::AFTER_DRAIN) { E(acc, cur, wr, wc, fr, fq); S.done(cur); }
        if (!has_next) break;
#pragma unroll
        for (int a = 0; a < 2; ++a)
#pragma unroll
            for (int b = 0; b < 2; ++b)
#pragma unroll
                for (int m = 0; m < 4; ++m)
#pragma unroll
                    for (int n = 0; n < 2; ++n) acc[a][b][m][n] = (f32x4){0.f, 0.f, 0.f, 0.f};
        cur = nxt; cA = nA; cB = nB; ++ui;
        if constexpr (ALIGN_EPI) { if (wr == 1) PG8_BAR; }
    }
    PG8_WAIT_V(0);
    if constexpr (!ALIGN_EPI) { if (wr == 0) PG8_BAR; }
    PG8_BAR;
    if constexpr (Epi::AFTER_DRAIN) { E.fused(acc, cur, wr, wc, fr, fq, lds, wid, lane); S.done(cur); }
#undef PG8_SA
#undef PG8_SB
#undef PG8_STAGE
#undef PG8_LDA
#undef PG8_LDB
#undef PG8_MMA
#undef PG8_WAIT_V
#undef PG8_WAIT_L
#undef PG8_BAR
#undef PG8_SCHED
}
}

constexpr int SEQ = 8192, DM = 2048, INW = 10320, INW_PAD = 10496;
constexpr int AW = 1024, NIH = 16, IHD = 64, TOPK = 256, GW = 1024;
constexpr int PE_H = 8, PE_NK = 128, PE_TOPK = 16, PE_NE = 16384, PLE = 256;
constexpr float LN_EPS = 1e-5f;
constexpr float ALPHA = 1.189207115002721f;
constexpr float QSCALE = 0.08838834764831845f * 1.4426950408889634f;
constexpr int NWAVES = 8, NTHREADS = 512;
constexpr int LDS_BYTES = 147456;
constexpr int LDS_BARST = LDS_BYTES - 64;

constexpr size_t MiB = 1u << 20;
constexpr size_t WS_CTL = 0, CTL_ZERO_BYTES = 65536;
constexpr size_t WS_WA = 1 * MiB, WS_WG = 5 * MiB, WS_WMIX = 9 * MiB, WS_WQ = 17 * MiB, WS_WPG = 25 * MiB, WS_WPP = 33 * MiB, WS_SUBK = 34 * MiB;
constexpr size_t WS_PU = 35 * MiB, WS_PV = 99 * MiB, WS_STATS = 163 * MiB;
constexpr size_t WS_WIN = 164 * MiB, WS_HB = 205 * MiB;
constexpr size_t WS_Q = 237 * MiB, WS_KV = 253 * MiB, WS_QI = 285 * MiB, WS_KIWI = 301 * MiB;
constexpr size_t WS_GU = 305 * MiB, WS_GV = 321 * MiB, WS_GA = 337 * MiB, WS_GG = 369 * MiB;
constexpr size_t WS_GM = 401 * MiB, WS_ATT = 417 * MiB, WS_SC = 433 * MiB, WS_PB = 497 * MiB;
constexpr size_t WS_T = 164 * MiB, WS_MERGED = 237 * MiB, WS_H1F = 269 * MiB, WS_H1B = 333 * MiB, WS_PQ = 365 * MiB;
constexpr size_t WS_RF = 164 * MiB, WS_RB = 228 * MiB, WS_T2 = 405 * MiB;
constexpr size_t WS_PSC = 163 * MiB + 131072;
constexpr size_t WS_MASK = 501 * MiB;
constexpr size_t WS_END = 512 * MiB;

#define GAS __attribute__((address_space(1)))
#define LAS __attribute__((address_space(3)))
typedef unsigned short bf16;
typedef unsigned v4u __attribute__((ext_vector_type(4)));
typedef unsigned v2u __attribute__((ext_vector_type(2)));
typedef float f32x4 __attribute__((ext_vector_type(4)));
typedef float f32x2 __attribute__((ext_vector_type(2)));
typedef float f32x16 __attribute__((ext_vector_type(16)));
typedef short bf16x8 __attribute__((ext_vector_type(8)));
typedef __attribute__((ext_vector_type(2))) __bf16 bf2v;
#define LDS_WAIT() asm volatile("s_waitcnt lgkmcnt(0)" ::: "memory")
#define VM_WAIT() asm volatile("s_waitcnt vmcnt(0)" ::: "memory")

__device__ __forceinline__ unsigned f2bf(float f) { unsigned u = __builtin_bit_cast(unsigned, f); return (u + 0x7fffu + ((u >> 16) & 1u)) >> 16; }
typedef __bf16 bf16x2_t __attribute__((ext_vector_type(2)));
__device__ __forceinline__ unsigned pk2(float lo, float hi) { const f32x2 v = {lo, hi}; return __builtin_bit_cast(unsigned, __builtin_convertvector(v, bf16x2_t)); }
__device__ __forceinline__ float bflo(unsigned u) { return __builtin_bit_cast(float, u << 16); }
__device__ __forceinline__ float bfhi(unsigned u) { return __builtin_bit_cast(float, u & 0xffff0000u); }
__device__ __forceinline__ float bf2f(bf16 h) { return __builtin_bit_cast(float, (unsigned)h << 16); }
__device__ __forceinline__ float fast_rcp(float x) { return __builtin_amdgcn_rcpf(x); }
__device__ __forceinline__ float sigmoidf_(float x) { return fast_rcp(1.f + __expf(-x)); }
__device__ __forceinline__ float gelu_tanh(float x) { const float u = 1.5957691216057308f * (x + 0.044715f * x * x * x); return x * fast_rcp(1.f + __expf(-u)); }
__device__ __forceinline__ float wave_sum(float v) {
#pragma unroll
    for (int o = 1; o < 64; o <<= 1) v += __shfl_xor(v, o);
    return v;
}
__device__ __forceinline__ float dot2bf(unsigned a, unsigned b, float c) { return __builtin_amdgcn_fdot2_f32_bf16(__builtin_bit_cast(bf2v, a), __builtin_bit_cast(bf2v, b), c, false); }
__device__ __forceinline__ unsigned sortable(float f) { const unsigned u = __builtin_bit_cast(unsigned, f); return (u & 0x80000000u) ? ~u : (u | 0x80000000u); }

typedef const __attribute__((address_space(4))) unsigned char* kargp_t;
__device__ __forceinline__ unsigned long long karg_u64(int byte_off) {
    kargp_t ka = (kargp_t)__builtin_amdgcn_kernarg_segment_ptr();
    asm volatile("" : "+s"(ka));
    return *(const __attribute__((address_space(4))) unsigned long long*)(ka + byte_off);
}
struct Frame {
    LAS unsigned char* lds;
    int tid, lane, wave, G, bid;
    float* out; unsigned char* ws;
    __device__ __forceinline__ const float* in(int k) const { return (const float*)karg_u64(8 * k); }
};
#define MAKE_FRAME(F) Frame F; { int t_ = threadIdx.x; asm volatile("" : "+v"(t_)); F.tid = t_; F.lane = t_ & 63; F.wave = __builtin_amdgcn_readfirstlane(t_ >> 6); \
    F.G = gridDim.x; F.bid = blockIdx.x; F.lds = (LAS unsigned char*)lds_raw; F.out = (float*)karg_u64(192); F.ws = (unsigned char*)karg_u64(200); }

__device__ __forceinline__ int win_dest(int n) { return n < 4096 ? n : (n < 4176 ? n + 6144 : n - 80); }
template <bool MAP>
__device__ __forceinline__ void p0_transpose_item(const float* W, int K, int N, bf16* WT, LAS float* scr, int item, int lane) {
    const int nblk = (N + 31) / 32, kb = item / nblk, nb = item % nblk, k0 = 64 * kb, n0 = 32 * nb;
    const int nn = n0 + (lane & 31); const bool ok = nn < N;
    float tv[32];
#pragma unroll
    for (int i = 0; i < 32; ++i) { const int kk = 2 * i + (lane >> 5); tv[i] = ok ? W[(size_t)(k0 + kk) * N + nn] : 0.f; }
#pragma unroll
    for (int i = 0; i < 32; ++i) { const int kk = 2 * i + (lane >> 5); scr[kk * 33 + (lane & 31)] = tv[i]; }
    LDS_WAIT(); asm volatile("" ::: "memory");
    const int c = lane & 7;
#pragma unroll
    for (int j = 0; j < 4; ++j) { const int n = (lane >> 3) + 8 * j; const LAS float* s = scr + (8 * c) * 33 + n;
        v4u o; o.x = pk2(s[0 * 33], s[1 * 33]); o.y = pk2(s[2 * 33], s[3 * 33]); o.z = pk2(s[4 * 33], s[5 * 33]); o.w = pk2(s[6 * 33], s[7 * 33]);
        if (n0 + n < N) { const int drow = MAP ? win_dest(n0 + n) : (n0 + n); *(GAS v4u*)(WT + (size_t)drow * K + k0 + 8 * c) = o; } }
    LDS_WAIT(); asm volatile("" ::: "memory");
}
__device__ __forceinline__ void p0_convert(Frame& F, const float* src, bf16* dst, size_t n) {
    const size_t nth = (size_t)F.G * NTHREADS, n8 = n / 8;
    for (size_t i = (size_t)F.bid * NTHREADS + F.tid; i < n8; i += nth) {
        const f32x4 a = ((const GAS f32x4*)src)[2 * i], b = ((const GAS f32x4*)src)[2 * i + 1];
        v4u o; o.x = pk2(a.x, a.y); o.y = pk2(a.z, a.w); o.z = pk2(b.x, b.y); o.w = pk2(b.z, b.w);
        ((GAS v4u*)dst)[i] = o; }
}
__device__ __forceinline__ void ln_row(Frame& F, const float* xrow, const float* g, const float* b, bf16* ob, float* of, float* stats) {
    const GAS f32x4* xr = (const GAS f32x4*)xrow + F.lane;
    f32x4 v[8]; float s = 0.f;
#pragma unroll
    for (int j = 0; j < 8; ++j) { v[j] = xr[64 * j]; s += (v[j].x + v[j].y) + (v[j].z + v[j].w); }
    const float mean = wave_sum(s) * (1.f / DM); float s2 = 0.f;
#pragma unroll
    for (int j = 0; j < 8; ++j) { v[j] = v[j] - mean; s2 += (v[j].x * v[j].x + v[j].y * v[j].y) + (v[j].z * v[j].z + v[j].w * v[j].w); }
    const float rstd = 1.f / sqrtf(wave_sum(s2) * (1.f / DM) + LN_EPS);
    if (stats && F.lane == 0) { stats[0] = mean; stats[1] = rstd; }
#pragma unroll
    for (int j = 0; j < 8; ++j) {
        const f32x4 gg = ((const GAS f32x4*)g)[64 * j + F.lane], bb = ((const GAS f32x4*)b)[64 * j + F.lane];
        const f32x4 y = v[j] * rstd * gg + bb;
        if (ob) { v2u o; o.x = pk2(y.x, y.y); o.y = pk2(y.z, y.w); ((GAS v2u*)ob)[64 * j + F.lane] = o; }
        if (of) ((GAS f32x4*)of)[64 * j + F.lane] = y;
    }
}
__device__ __forceinline__ void p0_prologue(Frame& F) {
    LAS float* scr = (LAS float*)(F.lds + F.wave * 16384);
    const int gw = F.bid * NWAVES + F.wave, NGW = F.G * NWAVES;
    unsigned char* ws = F.ws;
    constexpr int I_IN = (DM / 64) * ((INW + 31) / 32), I_A = (AW / 64) * (DM / 32), I_G = (GW / 64) * (DM / 32), I_SQ = (DM / 64) * (DM / 32), I_PP = (PLE / 64) * (DM / 32);
    constexpr int NITEMS = I_IN + I_A + I_G + 3 * I_SQ + I_PP;
    for (int it = gw; it < NITEMS; it += NGW) {
        int r = it;
        if (r < I_IN) { p0_transpose_item<true>(F.in(6), DM, INW, (bf16*)(ws + WS_WIN), scr, r, F.lane); continue; } r -= I_IN;
        if (r < I_A) { p0_transpose_item<false>(F.in(11), AW, DM, (bf16*)(ws + WS_WA), scr, r, F.lane); continue; } r -= I_A;
        if (r < I_G) { p0_transpose_item<false>(F.in(12), GW, DM, (bf16*)(ws + WS_WG), scr, r, F.lane); continue; } r -= I_G;
        if (r < I_SQ) { p0_transpose_item<false>(F.in(13), DM, DM, (bf16*)(ws + WS_WMIX), scr, r, F.lane); continue; } r -= I_SQ;
        if (r < I_SQ) { p0_transpose_item<false>(F.in(16), DM, DM, (bf16*)(ws + WS_WQ), scr, r, F.lane); continue; } r -= I_SQ;
        if (r < I_SQ) { p0_transpose_item<false>(F.in(21), DM, DM, (bf16*)(ws + WS_WPG), scr, r, F.lane); continue; } r -= I_SQ;
        p0_transpose_item<false>(F.in(20), PLE, DM, (bf16*)(ws + WS_WPP), scr, r, F.lane);
    }
    { const size_t n16 = (size_t)(INW_PAD - INW) * DM * 2 / 16; GAS v4u* z = (GAS v4u*)(ws + WS_WIN + (size_t)INW * DM * 2);
      for (size_t i = (size_t)F.bid * NTHREADS + F.tid; i < n16; i += (size_t)F.G * NTHREADS) z[i] = (v4u){0u, 0u, 0u, 0u}; }
    for (int row0 = gw; row0 < 2 * PE_NE; row0 += 2 * NGW) {
        f32x4 v[2][8]; float mx[2];
#pragma unroll
        for (int h = 0; h < 2; ++h) { const int row = row0 + h * NGW, tb = row >= PE_NE ? 1 : 0, r = row - tb * PE_NE;
            const GAS f32x4* src = (const GAS f32x4*)((tb ? F.in(19) : F.in(18)) + (size_t)r * DM) + F.lane;
#pragma unroll
            for (int j = 0; j < 8; ++j) v[h][j] = src[64 * j]; }
#pragma unroll
        for (int h = 0; h < 2; ++h) { float m_ = 0.f;
#pragma unroll
            for (int j = 0; j < 8; ++j) m_ = fmaxf(m_, fmaxf(fmaxf(fabsf(v[h][j].x), fabsf(v[h][j].y)), fmaxf(fabsf(v[h][j].z), fabsf(v[h][j].w))));
#pragma unroll
            for (int o = 1; o < 64; o <<= 1) m_ = fmaxf(m_, __shfl_xor(m_, o));
            mx[h] = m_; }
#pragma unroll
        for (int h = 0; h < 2; ++h) { const int row = row0 + h * NGW, tb = row >= PE_NE ? 1 : 0, r = row - tb * PE_NE;
            float sc = 1.f;
            if (mx[h] > 1e-30f) sc = __builtin_bit_cast(float, __builtin_bit_cast(unsigned, 224.f / mx[h]) & 0x7f800000u);
            if (F.lane == 0) ((float*)(ws + WS_PSC))[row] = 1.f / sc;
            GAS unsigned* dst = (GAS unsigned*)(ws + (tb ? WS_PV : WS_PU) + (size_t)r * DM) + F.lane;
#pragma unroll
            for (int j = 0; j < 8; ++j) { int w = __builtin_amdgcn_cvt_pk_fp8_f32(v[h][j].x * sc, v[h][j].y * sc, 0, false); w = __builtin_amdgcn_cvt_pk_fp8_f32(v[h][j].z * sc, v[h][j].w * sc, w, true); dst[64 * j] = (unsigned)w; } }
    }
    p0_convert(F, F.in(17), (bf16*)(ws + WS_SUBK), (size_t)PE_H * 2 * PE_NK * 128);
    p0_convert(F, F.in(1), (bf16*)(ws + WS_PB), (size_t)SEQ * PLE);
    for (int m = gw; m < SEQ; m += NGW) ln_row(F, F.in(0) + (size_t)m * DM, F.in(3), F.in(4), (bf16*)(ws + WS_HB) + (size_t)m * DM, nullptr, (float*)(ws + WS_STATS) + 2 * m);
}

typedef GAS unsigned gu32;
#define XB_TMO      128
#define XB_XCNT(j)  (256  + 64 * (j))
#define XB_XSUB(j)  (1280 + 64 * (j))
#define XB_XGEN(j)  (2304 + 64 * (j))
#define XB_TOP      3328
#define XB_TOPGEN   3392
#define XCD_BAR_WORDS 3456
#define XB_SPIN_CAP (1u << 18)

__device__ __forceinline__ unsigned xb_ld(unsigned* p)              { return __hip_atomic_load(p, __ATOMIC_RELAXED, __HIP_MEMORY_SCOPE_AGENT); }
__device__ __forceinline__ unsigned xb_add(unsigned* p, unsigned v) { return __hip_atomic_fetch_add(p, v, __ATOMIC_RELAXED, __HIP_MEMORY_SCOPE_AGENT); }
__device__ __forceinline__ unsigned xb_xcc_id() { return (unsigned)__builtin_amdgcn_s_getreg((3 << 11) | 20) & 0xFu; }
#define XB_SPIN(cond, bar) do { unsigned _sp = 0; while (cond) { __builtin_amdgcn_s_sleep(1); \
    if ((++_sp & 255u) == 0u) { if (xb_ld(&(bar)[XB_TMO])) break; if (_sp > XB_SPIN_CAP) { atomicAdd(&(bar)[XB_TMO], 1u); break; } } } } while (0)

struct XcdBarrier {
    unsigned* bar; unsigned x;
    volatile LAS unsigned* st;
};

__device__ __forceinline__ XcdBarrier xcd_barrier_post(unsigned* bar, volatile LAS unsigned* st) {
    XcdBarrier b; b.bar = bar; b.x = xb_xcc_id(); b.st = st;
    if (threadIdx.x == 0) (void)xb_add(&bar[XB_XCNT(b.x)], 1u);
    return b;
}
__device__ __forceinline__ void xcd_barrier_complete(unsigned* bar, unsigned x, unsigned& nloc, unsigned& nx) {
    const unsigned G = gridDim.x * gridDim.y * gridDim.z;
    unsigned sum, cnt, mine, sp = 0u;
    for (;;) {
        sum = 0u; cnt = 0u; mine = 0u;
#pragma unroll
        for (unsigned j = 0; j < 16; ++j) { const unsigned c = xb_ld(&bar[XB_XCNT(j)]); sum += c; cnt += (c > 0u) ? 1u : 0u; mine = (j == x) ? c : mine; }
        if (sum == G) break;
        __builtin_amdgcn_s_sleep(1);
        if ((++sp & 255u) == 0u) { if (xb_ld(&bar[XB_TMO])) break; if (sp > XB_SPIN_CAP) { atomicAdd(&bar[XB_TMO], 1u); break; } }
    }
    nloc = mine > 0u ? mine : 1u; nx = cnt > 0u ? cnt : 1u;
}

__device__ __forceinline__ void xcd_barrier(const XcdBarrier& b) {
    asm volatile("s_waitcnt vmcnt(0)" ::: "memory");
    __syncthreads();
    if (threadIdx.x == 0) {
        unsigned* bar = b.bar;
        __builtin_amdgcn_s_waitcnt(0);
        unsigned nloc = b.st[0], nx = b.st[1];
        if (nloc == 0u) { xcd_barrier_complete(bar, b.x, nloc, nx); b.st[0] = nloc; b.st[1] = nx; }
        const unsigned old = xb_add(&bar[XB_XSUB(b.x)], 1u);
        const unsigned gen = old / nloc;
        if (old + 1u == (gen + 1u) * nloc) {
            __builtin_amdgcn_fence(__ATOMIC_RELEASE, "agent");
            asm volatile("s_waitcnt vmcnt(0)" ::: "memory");
            const unsigned og = xb_add(&bar[XB_TOP], 1u);
            const unsigned tg = og / nx;
            if (og + 1u == (tg + 1u) * nx) xb_add(&bar[XB_TOPGEN], 1u);
            else XB_SPIN(xb_ld(&bar[XB_TOPGEN]) == tg, bar);
            __builtin_amdgcn_fence(__ATOMIC_ACQUIRE, "agent");
            xb_add(&bar[XB_XGEN(b.x)], 1u);
            asm volatile("s_waitcnt vmcnt(0)" ::: "memory");
        } else {
            XB_SPIN(xb_ld(&bar[XB_XGEN(b.x)]) == gen, bar);
            __builtin_amdgcn_fence(__ATOMIC_ACQUIRE, "agent");
            asm volatile("s_waitcnt vmcnt(0)" ::: "memory");
        }
    }
    __syncthreads();
}

namespace pg8 {
struct EpiWin {
    static constexpr bool PERM = true, AFTER_DRAIN = false;
    bf16 *q, *kv, *qi, *gu, *gv, *ga, *gg, *kiwi;
    __device__ __forceinline__ void operator()(const f32x4 (&acc)[2][2][4][2], const Unit& u, int wr, int wc, int fr, int fq) const {
        const int pn = u.pn; bf16* base; int ld, colt, act = 0; float sc = 1.f;
        if (pn < 4) { base = q; ld = 1024; colt = pn * 256; sc = QSCALE; }
        else if (pn < 12) { base = kv; ld = 2048; colt = (pn - 4) * 256; }
        else if (pn < 16) { base = qi; ld = 1024; colt = (pn - 12) * 256; }
        else if (pn < 20) { base = gu; ld = 1024; colt = (pn - 16) * 256; act = 1; }
        else if (pn < 24) { base = gv; ld = 1024; colt = (pn - 20) * 256; act = 1; }
        else if (pn < 32) { base = ga; ld = 2048; colt = (pn - 24) * 256; act = 2; }
        else if (pn < 40) { base = gg; ld = 2048; colt = (pn - 32) * 256; act = 2; }
        else { base = kiwi; ld = 256; colt = 0; }
        const int row0 = u.pm * BM + wr * 64 + fr, col0 = colt + wc * 32 + 8 * fq;
#pragma unroll
        for (int ai = 0; ai < 2; ++ai)
#pragma unroll
            for (int m = 0; m < 4; ++m) { bf16* rowp = base + (size_t)(row0 + ai * HALF + m * 16) * ld + col0;
#pragma unroll
                for (int bj = 0; bj < 2; ++bj) { f32x4 v0 = acc[ai][bj][m][0], v1 = acc[ai][bj][m][1];
                    if (act == 1) {
#pragma unroll
                        for (int e = 0; e < 4; ++e) { v0[e] = gelu_tanh(v0[e]); v1[e] = gelu_tanh(v1[e]); } }
                    else if (act == 2) {
#pragma unroll
                        for (int e = 0; e < 4; ++e) { v0[e] = sigmoidf_(v0[e]); v1[e] = sigmoidf_(v1[e]); } }
                    else { v0 = v0 * sc; v1 = v1 * sc; }
                    v4u w; w.x = pk2(v0[0], v0[1]); w.y = pk2(v0[2], v0[3]); w.z = pk2(v1[0], v1[1]); w.w = pk2(v1[2], v1[3]);
                    *(GAS v4u*)(rowp + bj * HALF) = w; } }
    }
};
struct EpiGateF32 {
    static constexpr bool PERM = true, AFTER_DRAIN = false;
    const bf16* gate; float* T; int ldc;
    __device__ __forceinline__ void operator()(const f32x4 (&acc)[2][2][4][2], const Unit& u, int wr, int wc, int fr, int fq) const {
        const int row0 = u.pm * BM + wr * 64 + fr, col0 = u.pn * BM + wc * 32 + 8 * fq;
#pragma unroll
        for (int ai = 0; ai < 2; ++ai)
#pragma unroll
            for (int m = 0; m < 4; ++m) { const size_t off = (size_t)(row0 + ai * HALF + m * 16) * ldc + col0;
#pragma unroll
                for (int bj = 0; bj < 2; ++bj) { const v4u g = *(const GAS v4u*)(gate + off + bj * HALF);
                    f32x4 v0 = acc[ai][bj][m][0], v1 = acc[ai][bj][m][1];
                    v0[0] *= bflo(g.x); v0[1] *= bfhi(g.x); v0[2] *= bflo(g.y); v0[3] *= bfhi(g.y);
                    v1[0] *= bflo(g.z); v1[1] *= bfhi(g.z); v1[2] *= bflo(g.w); v1[3] *= bfhi(g.w);
                    *(GAS f32x4*)(T + off + bj * HALF) = v0; *(GAS f32x4*)(T + off + bj * HALF + 4) = v1; } }
    }
};
struct EpiMerge {
    static constexpr bool PERM = true, AFTER_DRAIN = false;
    const bf16* gate; const float* T; bf16* O; int ldc;
    __device__ __forceinline__ void operator()(const f32x4 (&acc)[2][2][4][2], const Unit& u, int wr, int wc, int fr, int fq) const {
        const int row0 = u.pm * BM + wr * 64 + fr, col0 = u.pn * BM + wc * 32 + 8 * fq;
#pragma unroll
        for (int ai = 0; ai < 2; ++ai)
#pragma unroll
            for (int m = 0; m < 4; ++m) { const size_t off = (size_t)(row0 + ai * HALF + m * 16) * ldc + col0;
#pragma unroll
                for (int bj = 0; bj < 2; ++bj) { const v4u g = *(const GAS v4u*)(gate + off + bj * HALF);
                    const f32x4 t0 = *(const GAS f32x4*)(T + off + bj * HALF), t1 = *(const GAS f32x4*)(T + off + bj * HALF + 4);
                    f32x4 v0 = acc[ai][bj][m][0], v1 = acc[ai][bj][m][1];
                    v0[0] = t0[0] + v0[0] * bflo(g.x); v0[1] = t0[1] + v0[1] * bfhi(g.x); v0[2] = t0[2] + v0[2] * bflo(g.y); v0[3] = t0[3] + v0[3] * bfhi(g.y);
                    v1[0] = t1[0] + v1[0] * bflo(g.z); v1[1] = t1[1] + v1[1] * bfhi(g.z); v1[2] = t1[2] + v1[2] * bflo(g.w); v1[3] = t1[3] + v1[3] * bfhi(g.w);
                    v4u w; w.x = pk2(v0[0], v0[1]); w.y = pk2(v0[2], v0[3]); w.z = pk2(v1[0], v1[1]); w.w = pk2(v1[2], v1[3]);
                    *(GAS v4u*)(O + off + bj * HALF) = w; } }
    }
};
struct EpiMix {
    static constexpr bool PERM = false, AFTER_DRAIN = false;
    const float* x; const float* stats; const float* g; const float* b; float* Y; int ldc;
    __device__ __forceinline__ void operator()(const f32x4 (&acc)[2][2][4][2], const Unit& u, int wr, int wc, int fr, int fq) const {
        const int row0 = u.pm * BM + wr * 64 + fr, col0 = u.pn * BM + wc * 32 + 4 * fq;
        f32x4 gv[2][2], bv[2][2];
#pragma unroll
        for (int bj = 0; bj < 2; ++bj)
#pragma unroll
            for (int n = 0; n < 2; ++n) { gv[bj][n] = *(const GAS f32x4*)(g + col0 + bj * HALF + n * 16); bv[bj][n] = *(const GAS f32x4*)(b + col0 + bj * HALF + n * 16); }
#pragma unroll
        for (int ai = 0; ai < 2; ++ai)
#pragma unroll
            for (int m = 0; m < 4; ++m) { const int r = row0 + ai * HALF + m * 16; const size_t off = (size_t)r * ldc + col0;
                const float mean = stats[2 * r], rstd = stats[2 * r + 1];
#pragma unroll
                for (int bj = 0; bj < 2; ++bj)
#pragma unroll
                    for (int n = 0; n < 2; ++n) { const f32x4 xv = *(const GAS f32x4*)(x + off + bj * HALF + n * 16);
                        const f32x4 h = (xv - mean) * rstd * gv[bj][n] + bv[bj][n];
                        *(GAS f32x4*)(Y + off + bj * HALF + n * 16) = h * ALPHA + acc[ai][bj][m][n] * DBG_MIX_S; } }
    }
};
struct EpiF32 {
    static constexpr bool PERM = false, AFTER_DRAIN = false;
    float* Y; int ldc;
    __device__ __forceinline__ void operator()(const f32x4 (&acc)[2][2][4][2], const Unit& u, int wr, int wc, int fr, int fq) const {
        const int row0 = u.pm * BM + wr * 64 + fr, col0 = u.pn * BM + wc * 32 + 4 * fq;
#pragma unroll
        for (int ai = 0; ai < 2; ++ai)
#pragma unroll
            for (int m = 0; m < 4; ++m) { const size_t off = (size_t)(row0 + ai * HALF + m * 16) * ldc + col0;
#pragma unroll
                for (int bj = 0; bj < 2; ++bj)
#pragma unroll
                    for (int n = 0; n < 2; ++n) *(GAS f32x4*)(Y + off + bj * HALF + n * 16) = acc[ai][bj][m][n]; }
    }
};
struct EpiPle {
    static constexpr bool PERM = false, AFTER_DRAIN = false;
    const float* R; const float* T2; float* Y; int ldc;
    __device__ __forceinline__ void operator()(const f32x4 (&acc)[2][2][4][2], const Unit& u, int wr, int wc, int fr, int fq) const {
        const int row0 = u.pm * BM + wr * 64 + fr, col0 = u.pn * BM + wc * 32 + 4 * fq;
#pragma unroll
        for (int ai = 0; ai < 2; ++ai)
#pragma unroll
            for (int m = 0; m < 4; ++m) { const size_t off = (size_t)(row0 + ai * HALF + m * 16) * ldc + col0;
#pragma unroll
                for (int bj = 0; bj < 2; ++bj)
#pragma unroll
                    for (int n = 0; n < 2; ++n) { const f32x4 rv = *(const GAS f32x4*)(R + off + bj * HALF + n * 16), tv = *(const GAS f32x4*)(T2 + off + bj * HALF + n * 16);
                        const f32x4 a = acc[ai][bj][m][n]; f32x4 o;
#pragma unroll
                        for (int e = 0; e < 4; ++e) o[e] = rv[e] + DBG_PLE_S * sigmoidf_(a[e]) * tv[e];
                        *(GAS f32x4*)(Y + off + bj * HALF + n * 16) = o; } }
    }
};
}

__device__ __forceinline__ f32x16 mfma32(bf16x8 a, bf16x8 b, f32x16 c) { return __builtin_amdgcn_mfma_f32_32x32x16_bf16(a, b, c, 0, 0, 0); }
__device__ __forceinline__ void unpack8(const v4u a, float (&x)[8]) { x[0] = bflo(a.x); x[1] = bfhi(a.x); x[2] = bflo(a.y); x[3] = bfhi(a.y); x[4] = bflo(a.z); x[5] = bfhi(a.z); x[6] = bflo(a.w); x[7] = bfhi(a.w); }

__device__ __forceinline__ void gmlp_unit(Frame& F, int unit) {
    const int n = unit >> 3, g = unit & 7, row0 = n * 128;
    const bf16* gvb = (const bf16*)(F.ws + WS_GV); const bf16* gub = (const bf16*)(F.ws + WS_GU); bf16* gm = (bf16*)(F.ws + WS_GM);
    LAS float* st = (LAS float*)F.lds;
    LAS bf16* VT = (LAS bf16*)(F.lds + 1024);
    for (int i = 0; i < 16; ++i) { const int r = F.wave * 16 + i;
        const GAS v4u* rp = (const GAS v4u*)(gvb + (size_t)(row0 + r) * GW);
        const v4u a = rp[F.lane], b = rp[64 + F.lane];
        float x[16]; { float t0[8], t1[8]; unpack8(a, t0); unpack8(b, t1);
#pragma unroll
            for (int e = 0; e < 8; ++e) { x[e] = t0[e]; x[8 + e] = t1[e]; } }
        float s = 0.f;
#pragma unroll
        for (int e = 0; e < 16; ++e) s += x[e];
        const float mean = wave_sum(s) * (1.f / GW); float s2 = 0.f;
#pragma unroll
        for (int e = 0; e < 16; ++e) { const float d = x[e] - mean; s2 += d * d; }
        const float rstd = 1.f / sqrtf(wave_sum(s2) * (1.f / GW) + LN_EPS);
        if (F.lane == 0) { st[2 * r] = mean; st[2 * r + 1] = rstd; } }
    __syncthreads();
    const float* lg = F.in(7) + g * 128; const float* lb = F.in(8) + g * 128;
#pragma unroll
    for (int i = 0; i < 4; ++i) { const int id = F.tid + 512 * i, s = id >> 4, c8 = id & 15;
        const v4u a = *(const GAS v4u*)(gvb + (size_t)(row0 + s) * GW + g * 128 + c8 * 8);
        float x[8]; unpack8(a, x);
        const float mean = st[2 * s], rstd = st[2 * s + 1];
        const f32x4 g0 = *(const GAS f32x4*)(lg + c8 * 8), g1 = *(const GAS f32x4*)(lg + c8 * 8 + 4), b0 = *(const GAS f32x4*)(lb + c8 * 8), b1 = *(const GAS f32x4*)(lb + c8 * 8 + 4);
#pragma unroll
        for (int e = 0; e < 8; ++e) { const float gg = e < 4 ? g0[e & 3] : g1[e & 3], bb = e < 4 ? b0[e & 3] : b1[e & 3];
            VT[(c8 * 8 + e) * 136 + s] = (bf16)f2bf((x[e] - mean) * rstd * gg + bb); } }
    __syncthreads();
    const int r = F.lane & 31, hh = F.lane >> 5, tt = F.wave >> 1, ct0 = (F.wave & 1) * 2;
    f32x16 acc0, acc1;
#pragma unroll
    for (int e = 0; e < 16; ++e) { acc0[e] = 0.f; acc1[e] = 0.f; }
    const float* wsm = F.in(9) + (size_t)g * 128 * 128;
    const int t = tt * 32 + r;
    for (int ks = 0; ks < (tt + 1) * 2; ++ks) {
        const int k0 = ks * 16 + 8 * hh;
        const f32x4 w0 = *(const GAS f32x4*)(wsm + t * 128 + k0), w1 = *(const GAS f32x4*)(wsm + t * 128 + k0 + 4);
        float wv[8] = {w0.x, w0.y, w0.z, w0.w, w1.x, w1.y, w1.z, w1.w};
#pragma unroll
        for (int e = 0; e < 8; ++e) if (k0 + e > t) wv[e] = 0.f;
        v4u ap; ap.x = pk2(wv[0], wv[1]); ap.y = pk2(wv[2], wv[3]); ap.z = pk2(wv[4], wv[5]); ap.w = pk2(wv[6], wv[7]);
        const bf16x8 A = __builtin_bit_cast(bf16x8, ap);
        const bf16x8 B0 = *(const LAS bf16x8*)(VT + (ct0 * 32 + r) * 136 + k0), B1 = *(const LAS bf16x8*)(VT + ((ct0 + 1) * 32 + r) * 136 + k0);
        acc0 = mfma32(A, B0, acc0); acc1 = mfma32(A, B1, acc1);
    }
    const float* bs = F.in(10) + g * 128;
#pragma unroll
    for (int reg = 0; reg < 16; ++reg) { const int tr = tt * 32 + (reg & 3) + 8 * (reg >> 2) + 4 * hh; const float bsv = bs[tr];
        const size_t o0 = (size_t)(row0 + tr) * GW + g * 128 + ct0 * 32 + r;
#if DBG_GMLP_X2
        acc0[reg] *= 2.f; acc1[reg] *= 2.f;
#endif
#if DBG_NO_GMLP
        acc0[reg] = 0.f; acc1[reg] = 0.f;
#endif
        gm[o0] = (bf16)f2bf(bf2f(gub[o0]) * (acc0[reg] + bsv));
        gm[o0 + 32] = (bf16)f2bf(bf2f(gub[o0 + 32]) * (acc1[reg] + bsv)); }
    __syncthreads();
}

__device__ __constant__ unsigned char REL_BUCKET[128] = {0, 1, 2, 3, 4, 5, 6, 7, 8, 9, 10, 11, 12, 13, 14, 15, 16, 16, 16, 17, 17, 18, 18, 18, 19, 19, 19, 20, 20, 20, 20, 21, 21, 21, 21, 22, 22, 22, 22, 22, 23, 23, 23, 23, 23, 23, 24, 24, 24, 24, 24, 24, 25, 25, 25, 25, 25, 25, 25, 26, 26, 26, 26, 26, 26, 26, 26, 27, 27, 27, 27, 27, 27, 27, 27, 27, 27, 28, 28, 28, 28, 28, 28, 28, 28, 28, 28, 29, 29, 29, 29, 29, 29, 29, 29, 29, 29, 29, 29, 30, 30, 30, 30, 30, 30, 30, 30, 30, 30, 30, 30, 30, 30, 31, 31, 31, 31, 31, 31, 31, 31, 31, 31, 31, 31, 31, 31, 31};
constexpr int KI_PITCH = 144;
constexpr unsigned NEG_KEY = 0x007FFFFFu;
__device__ __forceinline__ int mbcnt64(unsigned long long m) { return __builtin_amdgcn_mbcnt_hi((unsigned)(m >> 32), __builtin_amdgcn_mbcnt_lo((unsigned)m, 0u)); }

#define IDX_LOAD_TILE(t_) do { _Pragma("unroll") for (int i_ = 0; i_ < 4; ++i_) { const int id_ = F.tid + 512 * i_; \
    stg[i_] = *(const GAS v4u*)(kiwi + (size_t)((t_) * 256 + (id_ >> 3)) * 256 + (id_ & 7) * 8); } } while (0)
typedef short s16x2 __attribute__((ext_vector_type(2)));
typedef unsigned short u16x2 __attribute__((ext_vector_type(2)));
constexpr int KI_TILE = 256 * KI_PITCH;

__device__ __forceinline__ void idx_unit(Frame& F, int unit) {
    const int q0 = unit * 16;
    const int kend = ((q0 + 15) / 128 + 1) * 128;
    const int nkt = (kend + 255) >> 8, nreg = kend >> 7;
    const bf16* qi = (const bf16*)(F.ws + WS_QI); const bf16* kiwi = (const bf16*)(F.ws + WS_KIWI);
    const int* pos = (const int*)F.in(2);
    unsigned* scr = (unsigned*)(F.ws + WS_SC) + (size_t)F.bid * (16 * 4096);
    const int r = F.lane & 31, hh = F.lane >> 5;
    const int wq = q0 + 2 * F.wave;
    for (int repA = 0; repA < (DBG_REP_SUB == 1 ? 2 : 1); ++repA) {
        const int aq = wq + ((r >> 2) & 1), ah = (r & 3) + 4 * (r >> 3);
        bf16x8 Af[4];
#pragma unroll
        for (int s = 0; s < 4; ++s) Af[s] = *(const GAS bf16x8*)(qi + (size_t)aq * 1024 + ah * 64 + s * 16 + 8 * hh);
        float wgt[16];
        { const v4u a = *(const GAS v4u*)(kiwi + (size_t)(wq + hh) * 256 + 64), b = *(const GAS v4u*)(kiwi + (size_t)(wq + hh) * 256 + 72);
          float t0[8], t1[8]; unpack8(a, t0); unpack8(b, t1);
#pragma unroll
          for (int e = 0; e < 8; ++e) { wgt[e] = t0[e]; wgt[8 + e] = t1[e]; } }
        const int qpos = pos[wq + hh];
        unsigned* srow = scr + (size_t)(2 * F.wave + hh) * 4096;
        v4u stg[4];
        IDX_LOAD_TILE(0);
        __syncthreads();
        for (int t = 0; t < nkt; ++t) {
            LAS unsigned char* kb = F.lds + (t & 1) * KI_TILE;
#pragma unroll
            for (int i = 0; i < 4; ++i) { const int id = F.tid + 512 * i; *(LAS v4u*)(kb + (id >> 3) * KI_PITCH + (id & 7) * 16) = stg[i]; }
            __syncthreads();
            if (t + 1 < nkt) IDX_LOAD_TILE(t + 1);
#pragma unroll
            for (int step = 0; step < 4; ++step) {
                const int sA = (step & 1) + 4 * (step >> 1), keyA = t * 256 + sA * 32 + r;
                if (t * 256 + (step >> 1) * 128 < kend) {
                    f32x16 accA, accB;
#pragma unroll
                    for (int e = 0; e < 16; ++e) { accA[e] = 0.f; accB[e] = 0.f; }
#pragma unroll
                    for (int s = 0; s < 4; ++s) { const bf16x8 BA = *(const LAS bf16x8*)(kb + (sA * 32 + r) * KI_PITCH + s * 32 + hh * 16), BB = *(const LAS bf16x8*)(kb + ((sA + 2) * 32 + r) * KI_PITCH + s * 32 + hh * 16);
                        accA = mfma32(Af[s], BA, accA); accB = mfma32(Af[s], BB, accB); }
                    float scA = 0.f, scB = 0.f;
#pragma unroll
                    for (int e = 0; e < 16; ++e) { scA += wgt[e] * fmaxf(accA[e], 0.f); scB += wgt[e] * fmaxf(accB[e], 0.f); }
                    if (pos[keyA] > qpos) scA = -__builtin_inff();
                    if (pos[keyA + 64] > qpos) scB = -__builtin_inff();
                    const unsigned kA = (sortable(scA) >> 16) ^ 0x8000u, kB = (sortable(scB) >> 16) ^ 0x8000u;
                    srow[(2 * t + (step >> 1)) * 64 + (step & 1) * 32 + r] = kA | (kB << 16);
                }
            }
        }
    }
    __syncthreads();
    unsigned long long* maskg = (unsigned long long*)(F.ws + WS_MASK);
#pragma unroll 1
    for (int qq = 0; qq < (DBG_REP_SUB == 2 ? 4 : 2); ++qq) {
        const int qrow = wq + (qq & 1);
        const unsigned* sr = scr + (size_t)(2 * F.wave + (qq & 1)) * 4096;
        unsigned kv[64];
        int ln1 = F.lane; asm volatile("" : "+v"(ln1));
        int nr1 = nreg; asm volatile("" : "+s"(nr1));
        const unsigned* srl = sr + ln1;
#pragma unroll
        for (int j = 0; j < 64; ++j) { kv[j] = 0x80008000u; if (j < nr1) kv[j] = __builtin_nontemporal_load(srl + j * 64); }
        unsigned thr_u = 0u; const int slots = nreg * 128;
        for (int bit = 15; bit >= 0; --bit) { const unsigned cand_u = thr_u | (1u << bit); const unsigned cs_ = (cand_u ^ 0x8000u) & 0xffffu; const s16x2 c2 = __builtin_bit_cast(s16x2, cs_ | (cs_ << 16));
            u16x2 a0 = {0, 0}, a1 = {0, 0}, a2 = {0, 0}, a3 = {0, 0};
            int nr2 = nreg; asm volatile("" : "+s"(nr2));
#pragma unroll
            for (int jb = 0; jb < 8; ++jb) { if (jb * 8 < nr2) {
#pragma unroll
                    for (int jj = 0; jj < 8; jj += 4) {
                        a0 += __builtin_bit_cast(u16x2, __builtin_elementwise_sub_sat(__builtin_bit_cast(s16x2, kv[jb * 8 + jj + 0]), c2)) >> 15;
                        a1 += __builtin_bit_cast(u16x2, __builtin_elementwise_sub_sat(__builtin_bit_cast(s16x2, kv[jb * 8 + jj + 1]), c2)) >> 15;
                        a2 += __builtin_bit_cast(u16x2, __builtin_elementwise_sub_sat(__builtin_bit_cast(s16x2, kv[jb * 8 + jj + 2]), c2)) >> 15;
                        a3 += __builtin_bit_cast(u16x2, __builtin_elementwise_sub_sat(__builtin_bit_cast(s16x2, kv[jb * 8 + jj + 3]), c2)) >> 15; } }
                __builtin_amdgcn_sched_barrier(0); }
            const u16x2 as_ = (a0 + a1) + (a2 + a3);
            int lt = (int)as_[0] + (int)as_[1];
#pragma unroll
            for (int o = 1; o < 64; o <<= 1) lt += __shfl_xor(lt, o);
            const int visited = ((nreg + 7) >> 3) * 8 * 128;
            const int ge = visited - lt;
            if (ge >= TOPK) thr_u = cand_u; }
        (void)slots;
        const int NEGS = (int)(short)(0x007Fu ^ 0x8000u);
        int thr_s = (int)(short)((thr_u ^ 0x8000u) & 0xffffu);
        const bool all_valid = thr_u <= 0x007Fu;
        if (all_valid) thr_s = NEGS;
        int ngt = 0;
        { int nr3 = nreg; asm volatile("" : "+s"(nr3));
#pragma unroll
          for (int jb = 0; jb < 8; ++jb) { if (jb * 8 < nr3) {
#pragma unroll
                  for (int jj = 0; jj < 8; ++jj) { const int lo = (int)(short)(kv[jb * 8 + jj] & 0xffffu), hi = (int)kv[jb * 8 + jj] >> 16;
                      ngt += __builtin_popcountll(__ballot(lo > thr_s)) + __builtin_popcountll(__ballot(hi > thr_s)); } }
              __builtin_amdgcn_sched_barrier(0); } }
        const int need = all_valid ? 0 : TOPK - ngt;
        int tie_seen = 0;
        int nr4 = nreg; asm volatile("" : "+s"(nr4));
        unsigned long long mw0 = 0ull, mw1 = 0ull;
#pragma unroll
        for (int j = 0; j < 64; ++j) { if (j < nr4) {
#pragma unroll
            for (int h = 0; h < 2; ++h) { const int x = h ? ((int)kv[j] >> 16) : (int)(short)(kv[j] & 0xffffu);
                const bool gt = x > thr_s, eq = (x == thr_s) && !all_valid;
                const unsigned long long meq = __ballot(eq);
                const bool take = gt || (eq && (tie_seen + mbcnt64(meq)) < need);
                tie_seen += __builtin_popcountll(meq);
                const unsigned long long m = __ballot(take);
                const int w = 2 * j + h;
                if (F.lane == (w & 63)) { if (w < 64) mw0 = m; else mw1 = m; } } }
            __builtin_amdgcn_sched_barrier(0); }
        if (F.lane < 2 * nreg) maskg[(size_t)qrow * 128 + F.lane] = mw0;
        if (64 + F.lane < 2 * nreg) maskg[(size_t)qrow * 128 + 64 + F.lane] = mw1;
    }
}

typedef short s16x4 __attribute__((ext_vector_type(4)));
__device__ __forceinline__ f32x4 mfma16(bf16x8 a, bf16x8 b, f32x4 c) { return __builtin_amdgcn_mfma_f32_16x16x32_bf16(a, b, c, 0, 0, 0); }
constexpr int ATT_KP = 272, ATT_VP = 288;
constexpr int ATT_KB = 64 * ATT_KP, ATT_VB = 64 * ATT_VP;
constexpr int ATT_VOFF = 2 * ATT_KB, ATT_TAB = ATT_VOFF + 2 * ATT_VB;

#define ATT_LOAD_TILE(t_) do { _Pragma("unroll") for (int i_ = 0; i_ < 2; ++i_) { const int c_ = F.tid + 512 * i_; \
    const bf16* gp_ = kvb + (size_t)((t_) * 64 + (c_ >> 4)) * 2048 + head * 128 + (c_ & 15) * 8; \
    kst[i_] = *(const GAS v4u*)gp_; vst[i_] = *(const GAS v4u*)(gp_ + 1024); } } while (0)

#define ATT_TILE_BODY(NEAR_) \
        LAS unsigned char* Kb = F.lds + (t & 1) * ATT_KB; LAS unsigned char* Vb = F.lds + ATT_VOFF + (t & 1) * ATT_VB; \
        _Pragma("unroll") \
        for (int i = 0; i < 2; ++i) { const int c = F.tid + 512 * i; *(LAS v4u*)(Kb + (c >> 4) * ATT_KP + (c & 15) * 16) = kst[i]; *(LAS v4u*)(Vb + (c >> 4) * ATT_VP + (c & 15) * 16) = vst[i]; } \
        __syncthreads(); \
        const unsigned long long mw = mw_next; \
        if (t + 1 < ntiles) { ATT_LOAD_TILE(t + 1); mw_next = maskg[(size_t)qrow * 128 + t + 1]; } \
 \
        f32x4 S[4]; bf16x8 Kf[4][4]; \
        _Pragma("unroll") \
        for (int st = 0; st < 4; ++st) \
        _Pragma("unroll") \
            for (int ks = 0; ks < 4; ++ks) Kf[st][ks] = *(const LAS bf16x8*)(Kb + (16 * st + qi) * ATT_KP + (ks * 32 + 8 * g) * 2); \
        _Pragma("unroll") \
        for (int st = 0; st < 4; ++st) S[st] = (f32x4){0.f, 0.f, 0.f, 0.f}; \
        _Pragma("unroll") \
        for (int ks = 0; ks < 4; ++ks) \
        _Pragma("unroll") \
            for (int st = 0; st < 4; ++st) S[st] = mfma16(Kf[st][ks], Qf[ks], S[st]); \
 \
 \
        const unsigned mlo = (unsigned)(mw >> (4 * g)), mhi = (unsigned)((mw >> (4 * g)) >> 32); \
        float psum = 0.f; \
        _Pragma("unroll") \
        for (int st = 0; st < 4; ++st) \
        _Pragma("unroll") \
            for (int r = 0; r < 4; ++r) { const int bit = 16 * st + 4 * g + r; float s = S[st][r]; \
                if (NEAR_) { const int dist = qps - pos[t * 64 + bit]; if (dist >= 0 && dist < 128) s += tab[dist]; } \
                s = fminf(fmaxf(s, -120.f), 120.f); \
                const unsigned word = st < 2 ? mlo : mhi; const unsigned sel = word & (1u << ((16 * st + r) & 31)); \
                const float p = sel ? __builtin_amdgcn_exp2f(s) : 0.f; \
                S[st][r] = p; psum += p; } \
        lsum += psum; \
 \
        bf16x8 Pf[2]; \
        _Pragma("unroll") \
        for (int kk = 0; kk < 2; ++kk) { v4u w; w.x = pk2(S[2 * kk][0], S[2 * kk][1]); w.y = pk2(S[2 * kk][2], S[2 * kk][3]); w.z = pk2(S[2 * kk + 1][0], S[2 * kk + 1][1]); w.w = pk2(S[2 * kk + 1][2], S[2 * kk + 1][3]); \
            Pf[kk] = __builtin_bit_cast(bf16x8, w); } \
 \
        _Pragma("unroll") \
        for (int dt = 0; dt < 8; ++dt) \
        _Pragma("unroll") \
            for (int kk = 0; kk < 2; ++kk) { \
                LAS unsigned char* ap = Vb + (32 * kk + 4 * g + (qi >> 2)) * ATT_VP + (16 * dt + 4 * (qi & 3)) * 2; \
                const s16x4 a0 = __builtin_amdgcn_ds_read_tr16_b64_v4i16((LAS s16x4*)ap), a1 = __builtin_amdgcn_ds_read_tr16_b64_v4i16((LAS s16x4*)(ap + 16 * ATT_VP)); \
                const bf16x8 A = (bf16x8){a0[0], a0[1], a0[2], a0[3], a1[0], a1[1], a1[2], a1[3]}; \
                O[dt] = mfma16(A, Pf[kk], O[dt]); } \


__device__ __forceinline__ void attn_unit(Frame& F, int qb, int head) {
    const bf16* qg = (const bf16*)(F.ws + WS_Q); const bf16* kvb = (const bf16*)(F.ws + WS_KV);
    const unsigned long long* maskg = (const unsigned long long*)(F.ws + WS_MASK);
    const int* pos = (const int*)F.in(2);
    const int qi = F.lane & 15, g = F.lane >> 4;
    const int qrow = qb * 128 + F.wave * 16 + qi;
    LAS float* tab = (LAS float*)(F.lds + ATT_TAB);
    __syncthreads();
    if (F.tid < 128) { const float* relb = F.in(5); tab[F.tid] = (relb[(int)REL_BUCKET[F.tid] * 8 + head] - relb[31 * 8 + head]) * 1.4426950408889634f; }
    bf16x8 Qf[4];
#pragma unroll
    for (int ks = 0; ks < 4; ++ks) Qf[ks] = *(const GAS bf16x8*)(qg + (size_t)qrow * 1024 + head * 128 + ks * 32 + 8 * g);
    const int qps = pos[qrow];
    const int qpmin = pos[qb * 128 + F.wave * 16];
    f32x4 O[8];
#pragma unroll
    for (int d = 0; d < 8; ++d) O[d] = (f32x4){0.f, 0.f, 0.f, 0.f};
    float lsum = 0.f;
    const int ntiles = 2 * (qb + 1);
    int tnear = ntiles;
    while (tnear > 0 && (qpmin - pos[(tnear - 1) * 64 + 63]) < 113) --tnear;
    v4u kst[2], vst[2];
    ATT_LOAD_TILE(0);
    unsigned long long mw_next = maskg[(size_t)qrow * 128];
    int t = 0;
    for (; t < tnear; ++t) { ATT_TILE_BODY(false) }
    for (; t < ntiles; ++t) { ATT_TILE_BODY(true) }
    lsum += __shfl_xor(lsum, 16); lsum += __shfl_xor(lsum, 32);
    const float inv = 1.f / lsum;
    bf16* op = (bf16*)(F.ws + WS_ATT) + (size_t)qrow * 1024 + head * 128 + 4 * g;
#pragma unroll
    for (int dt = 0; dt < 8; ++dt) { v2u w; w.x = pk2(O[dt][0] * inv, O[dt][1] * inv); w.y = pk2(O[dt][2] * inv, O[dt][3] * inv); *(GAS v2u*)(op + 16 * dt) = w; }
}

__device__ __forceinline__ float unsortable(unsigned k) { return __builtin_bit_cast(float, (k & 0x80000000u) ? (k & 0x7fffffffu) : ~k); }
#define DOT2(a, b, c) dot2bf((a), (b), (c))
template <int N> __device__ __forceinline__ void bitonic_desc(unsigned (&k)[N]) {
#pragma unroll
    for (int size = 2; size <= N; size <<= 1)
#pragma unroll
        for (int stride = size >> 1; stride > 0; stride >>= 1)
#pragma unroll
            for (int i = 0; i < N; ++i) { const int l = i ^ stride;
                if (l > i) { const bool desc = (i & size) == 0; const unsigned hi = k[i] > k[l] ? k[i] : k[l], lo = k[i] > k[l] ? k[l] : k[i]; k[i] = desc ? hi : lo; k[l] = desc ? lo : hi; } }
}

__device__ __forceinline__ void peer_unit(Frame& F, int unit) {
    const int tok0 = unit * 32;
    const bf16* pq = (const bf16*)(F.ws + WS_PQ); const bf16* subk = (const bf16*)(F.ws + WS_SUBK);
    LAS float* topS = (LAS float*)F.lds; LAS int* topI = (LAS int*)(F.lds + 32768);
    LAS int* esel = (LAS int*)(F.lds + 65536); LAS float* ew = (LAS float*)(F.lds + 81920); LAS float* eu = (LAS float*)(F.lds + 98304);
    const int r = F.lane & 31, hh = F.lane >> 5;
    for (int repAB = 0; repAB < (DBG_REP_SUB == 3 ? 2 : 1); ++repAB) {
#ifndef NO_A
    {
        const int h = F.wave;
        for (int p = 0; p < 2; ++p) {
            const int hp = h * 2 + p;
            bf16x8 Bq[8];
#pragma unroll
            for (int ks = 0; ks < 8; ++ks) Bq[ks] = *(const GAS bf16x8*)(pq + (size_t)(tok0 + r) * 2048 + hp * 128 + ks * 16 + 8 * hh);
            unsigned key[64];
#pragma unroll
            for (int kt = 0; kt < 4; ++kt) { f32x16 acc;
#pragma unroll
                for (int e = 0; e < 16; ++e) acc[e] = 0.f;
#pragma unroll
                for (int ks = 0; ks < 8; ++ks) { const bf16x8 A = *(const GAS bf16x8*)(subk + ((size_t)hp * 128 + kt * 32 + r) * 128 + ks * 16 + 8 * hh); acc = mfma32(A, Bq[ks], acc); }
#pragma unroll
                for (int e = 0; e < 16; ++e) key[kt * 16 + e] = sortable(acc[e]);
                __builtin_amdgcn_sched_barrier(0); }
            unsigned thr = 0u;
            for (int bit = 31; bit >= 16; --bit) { const unsigned cand = thr | (1u << bit); int c = 0;
#pragma unroll
                for (int i = 0; i < 64; ++i) c += (key[i] >= cand) ? 1 : 0;
                c += __shfl_xor(c, 32);
                if (c >= PE_TOPK) thr = cand; }
            int ngt = 0, neq = 0;
            const unsigned thr_hi = thr + 0x10000u;
#pragma unroll
            for (int i = 0; i < 64; ++i) { ngt += (key[i] >= thr_hi) ? 1 : 0; neq += (key[i] >= thr && key[i] < thr_hi) ? 1 : 0; }
            const int pgt = __shfl_xor(ngt, 32), peq = __shfl_xor(neq, 32);
            int pg = hh ? pgt : 0, pe = ngt + pgt + (hh ? peq : 0);
            LAS float* ls = topS + ((r * 8 + h) * 2 + p) * 16; LAS int* li = topI + ((r * 8 + h) * 2 + p) * 16;
            unsigned thr2 = thr; asm volatile("" : "+v"(thr2)); const unsigned thr2_hi = thr2 + 0x10000u;
#pragma unroll
            for (int kt = 0; kt < 4; ++kt)
#pragma unroll
                for (int e = 0; e < 16; ++e) { const unsigned k = key[kt * 16 + e]; const int kidx = kt * 32 + (e & 3) + 8 * (e >> 2) + 4 * hh;
                    if (k >= thr2_hi) { ls[pg] = unsortable(k); li[pg] = kidx; ++pg; }
                    else if (k >= thr2) { if (pe < PE_TOPK) { ls[pe] = unsortable(k); li[pe] = kidx; } ++pe; } }
        }
    }
#endif
    __syncthreads();
#ifndef NO_B
    if (F.wave < 4) {
        int lnB = F.lane; asm volatile("" : "+v"(lnB));
        const int L = F.wave * 64 + lnB, tk = L >> 3, hd = L & 7;
        unsigned k0[16], k1[16];
#pragma unroll
        for (int a = 0; a < 16; ++a) { k0[a] = (sortable(topS[((tk * 8 + hd) * 2 + 0) * 16 + a]) & 0xFFFFFF80u) | (unsigned)topI[((tk * 8 + hd) * 2 + 0) * 16 + a];
                                       k1[a] = (sortable(topS[((tk * 8 + hd) * 2 + 1) * 16 + a]) & 0xFFFFFF80u) | (unsigned)topI[((tk * 8 + hd) * 2 + 1) * 16 + a]; }
        bitonic_desc<16>(k0); bitonic_desc<16>(k1);
        float s0[16], s1[16];
#pragma unroll
        for (int a = 0; a < 16; ++a) { s0[a] = unsortable(k0[a] & 0xFFFFFF80u); s1[a] = unsortable(k1[a] & 0xFFFFFF80u); }
        unsigned cs[64];
        { int q = 0;
#pragma unroll
          for (int a = 0; a < 16; ++a)
#pragma unroll
              for (int b = 0; b < 16; ++b) if ((a + 1) * (b + 1) <= 16) { cs[q] = (sortable(s0[a] + s1[b]) & 0xFFFFC000u) | ((k0[a] & 127u) << 7) | (k1[b] & 127u); ++q; }
#pragma unroll
          for (int z = 50; z < 64; ++z) cs[z] = 0u; }
        bitonic_desc<64>(cs);
        const float top = unsortable(cs[0] & 0xFFFFC000u);
        float den = 0.f, wv[16]; const int ob = tk * 128 + hd * 16;
#pragma unroll
        for (int n = 0; n < 16; ++n) { wv[n] = __expf(unsortable(cs[n] & 0xFFFFC000u) - top); den += wv[n]; esel[ob + n] = (int)(cs[n] & 0x3FFFu); }
        const float inv = 1.f / den;
        const float* psc = (const float*)(F.ws + WS_PSC);
#pragma unroll
        for (int n = 0; n < 16; ++n) { const int e = (int)(cs[n] & 0x3FFFu); ew[ob + n] = wv[n] * inv * psc[PE_NE + e]; eu[ob + n] = psc[e]; }
    }
#endif
    __syncthreads();
    }
#ifndef NO_C
    {
        int lnC = F.lane; asm volatile("" : "+v"(lnC));
        const float* h1f = (const float*)(F.ws + WS_H1F);
        const unsigned char* PU = (const unsigned char*)(F.ws + WS_PU); const unsigned char* PV = (const unsigned char*)(F.ws + WS_PV);
        float* rf = (float*)(F.ws + WS_RF); bf16* rb = (bf16*)(F.ws + WS_RB);
#pragma unroll 1
        for (int tt = 0; tt < 4; ++tt) {
            const int tl = F.wave * 4 + tt, tok = tok0 + tl;
            f32x2 xv[16], o[16];
#pragma unroll
            for (int i = 0; i < 2; ++i)
#pragma unroll
                for (int c = 0; c < 4; ++c) { const f32x4 hv = *(const GAS f32x4*)(h1f + (size_t)tok * DM + i * 1024 + lnC * 16 + c * 4);
                    xv[i * 8 + c * 2] = (f32x2){hv.x, hv.y}; xv[i * 8 + c * 2 + 1] = (f32x2){hv.z, hv.w}; }
#pragma unroll
            for (int e = 0; e < 16; ++e) o[e] = (f32x2){0.f, 0.f};
#pragma unroll 1
            for (int e0 = 0; e0 < DBG_PEER_NEXP; e0 += 4) {
                v4u uq[4][2], vq[4][2]; float gv[4], su[4];
#pragma unroll
                for (int k = 0; k < 4; ++k) { const int id = __builtin_amdgcn_readfirstlane(esel[tl * 128 + e0 + k]); gv[k] = ew[tl * 128 + e0 + k]; su[k] = eu[tl * 128 + e0 + k];
                    const GAS v4u* up = (const GAS v4u*)(PU + (size_t)id * DM) + lnC; const GAS v4u* vp = (const GAS v4u*)(PV + (size_t)id * DM) + lnC;
                    uq[k][0] = up[0]; uq[k][1] = up[64]; vq[k][0] = vp[0]; vq[k][1] = vp[64]; }
                float av[4];
#pragma unroll
                for (int k = 0; k < 4; ++k) { f32x2 acc = (f32x2){0.f, 0.f};
#pragma unroll
                    for (int i = 0; i < 2; ++i)
#pragma unroll
                        for (int c = 0; c < 4; ++c) { const int w = (int)uq[k][i][c];
                            acc = __builtin_amdgcn_cvt_pk_f32_fp8(w, false) * xv[i * 8 + c * 2] + acc; acc = __builtin_amdgcn_cvt_pk_f32_fp8(w, true) * xv[i * 8 + c * 2 + 1] + acc; }
                    av[k] = acc.x + acc.y; }
#pragma unroll
                for (int k = 0; k < 4; ++k) av[k] = wave_sum(av[k]);
#pragma unroll
                for (int k = 0; k < 4; ++k) { const float a = gv[k] * gelu_tanh(av[k] * su[k]); const f32x2 a2 = (f32x2){a, a};
#pragma unroll
                    for (int i = 0; i < 2; ++i)
#pragma unroll
                        for (int c = 0; c < 4; ++c) { const int w = (int)vq[k][i][c];
                            o[i * 8 + c * 2] = __builtin_amdgcn_cvt_pk_f32_fp8(w, false) * a2 + o[i * 8 + c * 2]; o[i * 8 + c * 2 + 1] = __builtin_amdgcn_cvt_pk_f32_fp8(w, true) * a2 + o[i * 8 + c * 2 + 1]; } }
            }
#pragma unroll
            for (int i = 0; i < 2; ++i)
#pragma unroll
                for (int c = 0; c < 4; ++c) { const size_t off = (size_t)tok * DM + i * 1024 + lnC * 16 + c * 4;
                    f32x2 ra = xv[i * 8 + c * 2] * ALPHA + o[i * 8 + c * 2], rbv = xv[i * 8 + c * 2 + 1] * ALPHA + o[i * 8 + c * 2 + 1];
#if DBG_NO_PEER
                    ra = xv[i * 8 + c * 2] * ALPHA; rbv = xv[i * 8 + c * 2 + 1] * ALPHA;
#endif
                    *(GAS f32x4*)(rf + off) = (f32x4){ra.x, ra.y, rbv.x, rbv.y};
                    v2u w; w.x = pk2(ra.x, ra.y); w.y = pk2(rbv.x, rbv.y); *(GAS v2u*)(rb + off) = w; }
        }
    }
#endif
    __syncthreads();
}

struct Args { const float* in[24]; float* out; unsigned char* ws; int ph_lo, ph_hi; };
constexpr int N_PHASES = 11;

__global__ void __launch_bounds__(NTHREADS, 2) mega_fwd(Args args) {
    extern __shared__ __attribute__((aligned(16))) unsigned char lds_raw[];
    const int lo = args.ph_lo, hi = args.ph_hi;
#if MK_COOP
    cg::grid_group grid = cg::this_grid();
    if (threadIdx.x < 2) ((LAS unsigned*)(lds_raw + LDS_BARST))[threadIdx.x] = 0u;
    __syncthreads();
    XcdBarrier xbar = xcd_barrier_post((unsigned*)(args.ws + WS_CTL) + 1024, (volatile LAS unsigned*)((LAS unsigned char*)lds_raw + LDS_BARST));
    int nbar_ = 0;
#if DBG_ALL_CG
#define GRID_BAR() grid.sync()
#else
#define GRID_BAR() do { if (nbar_++ == 0) grid.sync(); else xcd_barrier(xbar); } while (0)
#endif
#else
#define GRID_BAR() do {} while (0)
#endif
#define IN(k) (lo <= (k) && (k) < hi)
#define NREP(k) ((k) == DBG_REP_PHASE ? 2 : 1)
#define BOTH(k) (IN(k) && IN((k) + 1))

    if (IN(0)) for (int rep_ = 0; rep_ < NREP(0); ++rep_) { if (rep_) GRID_BAR(); MAKE_FRAME(F); p0_prologue(F); if (BOTH(0) && rep_ + 1 == NREP(0)) GRID_BAR(); }

    if (IN(1)) for (int rep_ = 0; rep_ < NREP(1); ++rep_) {
        if (rep_) GRID_BAR();
        MAKE_FRAME(F); unsigned char* ws = F.ws; LAS unsigned char* glds = F.lds;
        pg8::Gemm g{(const bf16*)(ws + WS_HB), (const bf16*)(ws + WS_WIN), SEQ, INW_PAD, DM}; asm volatile("" : "+s"(g.K), "+s"(g.N), "+s"(g.M)); pg8::StaticOrder S; S.init(SEQ, INW_PAD, F.G, F.bid);
        pg8::EpiWin E{(bf16*)(ws + WS_Q), (bf16*)(ws + WS_KV), (bf16*)(ws + WS_QI), (bf16*)(ws + WS_GU), (bf16*)(ws + WS_GV), (bf16*)(ws + WS_GA), (bf16*)(ws + WS_GG), (bf16*)(ws + WS_KIWI)};
        pg8::gemm_phase<pg8::EpiWin, pg8::StaticOrder, true, true>(glds, g, S, E);
        if (BOTH(1) && rep_ + 1 == NREP(1)) GRID_BAR();
    }

    if (IN(2)) for (int rep_ = 0; rep_ < NREP(2); ++rep_) {
        if (rep_) GRID_BAR();
        MAKE_FRAME(F); unsigned char* ws = F.ws; LAS unsigned char* glds = F.lds;
        for (int u = F.bid; u < 512; u += F.G) gmlp_unit(F, u);
#pragma unroll 1
        for (int k = F.bid, i = 0; k < 512; k += F.G, ++i) idx_unit(F, (F.G == 256 && i == 1) ? 511 - F.bid : k);
        if (BOTH(2) && rep_ + 1 == NREP(2)) GRID_BAR();
    }

    if (IN(3)) for (int rep_ = 0; rep_ < NREP(3); ++rep_) {
        if (rep_) GRID_BAR();
        MAKE_FRAME(F);
#pragma unroll 1
        for (int u = F.bid; u < 256; u += F.G) { const int head = u & 7, pair = u >> 3;
#pragma unroll 1
            for (int i = 0; i < 2; ++i) attn_unit(F, i ? 63 - pair : pair, head); }
        if (BOTH(3) && rep_ + 1 == NREP(3)) GRID_BAR();
    }

    if (IN(4)) for (int rep_ = 0; rep_ < NREP(4); ++rep_) {
        if (rep_) GRID_BAR();
        MAKE_FRAME(F); unsigned char* ws = F.ws; LAS unsigned char* glds = F.lds;
        { pg8::Gemm g{(const bf16*)(ws + WS_ATT), (const bf16*)(ws + WS_WA), SEQ, DM, AW}; asm volatile("" : "+s"(g.K), "+s"(g.N), "+s"(g.M)); pg8::StaticOrder S; S.init(SEQ, DM, F.G, F.bid);
          pg8::EpiGateF32 E{(const bf16*)(ws + WS_GA), (float*)(ws + WS_T), DM};
          pg8::gemm_phase<pg8::EpiGateF32, pg8::StaticOrder, true, true>(glds, g, S, E); }
        __syncthreads();
        { pg8::Gemm g{(const bf16*)(ws + WS_GM), (const bf16*)(ws + WS_WG), SEQ, DM, GW}; asm volatile("" : "+s"(g.K), "+s"(g.N), "+s"(g.M)); pg8::StaticOrder S; S.init(SEQ, DM, F.G, F.bid);
          pg8::EpiMerge E{(const bf16*)(ws + WS_GG), (const float*)(ws + WS_T), (bf16*)(ws + WS_MERGED), DM};
          pg8::gemm_phase<pg8::EpiMerge, pg8::StaticOrder, true, true>(glds, g, S, E); }
        if (BOTH(4) && rep_ + 1 == NREP(4)) GRID_BAR();
    }

    if (IN(5)) for (int rep_ = 0; rep_ < NREP(5); ++rep_) {
        if (rep_) GRID_BAR();
        MAKE_FRAME(F); unsigned char* ws = F.ws; LAS unsigned char* glds = F.lds;
        pg8::Gemm g{(const bf16*)(ws + WS_MERGED), (const bf16*)(ws + WS_WMIX), SEQ, DM, DM}; asm volatile("" : "+s"(g.K), "+s"(g.N), "+s"(g.M)); pg8::StaticOrder S; S.init(SEQ, DM, F.G, F.bid);
        pg8::EpiMix E{F.in(0), (const float*)(ws + WS_STATS), F.in(3), F.in(4), F.out, DM};
        pg8::gemm_phase<pg8::EpiMix, pg8::StaticOrder, true, true>(glds, g, S, E);
        if (BOTH(5) && rep_ + 1 == NREP(5)) GRID_BAR();
    }

    if (IN(6)) for (int rep_ = 0; rep_ < NREP(6); ++rep_) {
        if (rep_) GRID_BAR();
        MAKE_FRAME(F); unsigned char* ws = F.ws; LAS unsigned char* glds = F.lds;
        const int gw = F.bid * NWAVES + F.wave, NGW = F.G * NWAVES;
        for (int m = gw; m < SEQ; m += NGW) ln_row(F, F.out + (size_t)m * DM, F.in(14), F.in(15), (bf16*)(ws + WS_H1B) + (size_t)m * DM, (float*)(ws + WS_H1F) + (size_t)m * DM, nullptr);
        if (BOTH(6) && rep_ + 1 == NREP(6)) GRID_BAR();
    }

    if (IN(7)) for (int rep_ = 0; rep_ < NREP(7); ++rep_) {
        if (rep_) GRID_BAR();
        MAKE_FRAME(F); unsigned char* ws = F.ws; LAS unsigned char* glds = F.lds;
        pg8::Gemm g{(const bf16*)(ws + WS_H1B), (const bf16*)(ws + WS_WQ), SEQ, DM, DM}; asm volatile("" : "+s"(g.K), "+s"(g.N), "+s"(g.M)); pg8::StaticOrder S; S.init(SEQ, DM, F.G, F.bid);
        pg8::EpiBf16<0> E{(bf16*)(ws + WS_PQ), DM, nullptr, 0, 0, 1.f};
        pg8::gemm_phase<pg8::EpiBf16<0>, pg8::StaticOrder, true, true>(glds, g, S, E);
        if (BOTH(7) && rep_ + 1 == NREP(7)) GRID_BAR();
    }

    if (IN(8)) for (int rep_ = 0; rep_ < NREP(8); ++rep_) {
        if (rep_) GRID_BAR();
        MAKE_FRAME(F); unsigned char* ws = F.ws; LAS unsigned char* glds = F.lds;
        for (int u = F.bid; u < SEQ / 32; u += F.G) peer_unit(F, u);
        if (BOTH(8) && rep_ + 1 == NREP(8)) GRID_BAR();
    }

    if (IN(9)) for (int rep_ = 0; rep_ < NREP(9); ++rep_) {
        if (rep_) GRID_BAR();
        MAKE_FRAME(F); unsigned char* ws = F.ws; LAS unsigned char* glds = F.lds;
        { pg8::Gemm g{(const bf16*)(ws + WS_PB), (const bf16*)(ws + WS_WPP), SEQ, DM, PLE}; asm volatile("" : "+s"(g.K), "+s"(g.N), "+s"(g.M)); pg8::StaticOrder S; S.init(SEQ, DM, F.G, F.bid);
          pg8::EpiF32 E{(float*)(ws + WS_T2), DM};
          pg8::gemm_phase<pg8::EpiF32, pg8::StaticOrder, true, true>(glds, g, S, E); }
        __syncthreads();
        { pg8::Gemm g{(const bf16*)(ws + WS_RB), (const bf16*)(ws + WS_WPG), SEQ, DM, DM}; asm volatile("" : "+s"(g.K), "+s"(g.N), "+s"(g.M)); pg8::StaticOrder S; S.init(SEQ, DM, F.G, F.bid);
          pg8::EpiPle E{(const float*)(ws + WS_RF), (const float*)(ws + WS_T2), F.out, DM};
          pg8::gemm_phase<pg8::EpiPle, pg8::StaticOrder, true, true>(glds, g, S, E); }
        if (BOTH(9) && rep_ + 1 == NREP(9)) GRID_BAR();
    }

    if (IN(10)) for (int rep_ = 0; rep_ < NREP(10); ++rep_) {
        if (rep_) GRID_BAR();
        MAKE_FRAME(F); unsigned char* ws = F.ws; LAS unsigned char* glds = F.lds;
        const int gw = F.bid * NWAVES + F.wave, NGW = F.G * NWAVES;
        for (int m = gw; m < SEQ; m += NGW) ln_row(F, F.out + (size_t)m * DM, F.in(22), F.in(23), nullptr, F.out + (size_t)m * DM, nullptr);
    }
}

extern "C" void kernel_launch(void* const* d_in, const int* in_sizes, int n_in, void* d_out, int out_size, void* d_ws, size_t ws_size, hipStream_t stream) {
    static int grid = 0;
    if (grid == 0) {
        if (n_in != 24 || out_size != SEQ * DM || ws_size < WS_END) { fprintf(stderr, "kernel_launch: unexpected problem: n_in %d out %d ws %zu (need %zu)\n", n_in, out_size, ws_size, (size_t)WS_END); grid = -1; return; }
        int dev = 0, cus = 0, per_cu = 0;
        if (hipGetDevice(&dev) != hipSuccess || hipDeviceGetAttribute(&cus, hipDeviceAttributeMultiprocessorCount, dev) != hipSuccess) { grid = -1; return; }
        if (hipFuncSetAttribute((const void*)mega_fwd, hipFuncAttributeMaxDynamicSharedMemorySize, LDS_BYTES) != hipSuccess) { fprintf(stderr, "kernel_launch: hipFuncSetAttribute failed\n"); grid = -1; return; }
        if (hipOccupancyMaxActiveBlocksPerMultiprocessor(&per_cu, (const void*)mega_fwd, NTHREADS, LDS_BYTES) != hipSuccess || per_cu < 1) { fprintf(stderr, "kernel_launch: occupancy query says %d blocks per CU\n", per_cu); (void)hipGetLastError(); grid = -1; return; }
        grid = cus;
        fprintf(stderr, "kernel_launch: grid %d (per_cu %d), ws %zu\n", grid, per_cu, ws_size);
    }
    if (grid < 0) return;
    if (hipMemsetAsync((char*)d_ws + WS_CTL, 0, CTL_ZERO_BYTES, stream) != hipSuccess) { fprintf(stderr, "kernel_launch: memset of the barrier words failed\n"); return; }
    Args a{};
    for (int i = 0; i < 24; ++i) a.in[i] = (const float*)d_in[i];
    a.out = (float*)d_out; a.ws = (unsigned char*)d_ws;
#if MK_COOP
    a.ph_lo = 0; a.ph_hi = N_PHASES;
    void* kargs[] = {&a};
    hipError_t e = hipLaunchCooperativeKernel((const void*)mega_fwd, dim3(grid), dim3(NTHREADS), kargs, LDS_BYTES, stream);
    if (e != hipSuccess) fprintf(stderr, "kernel_launch: cooperative launch failed: %s\n", hipGetErrorString(e));
#else
    for (int ph = 0; ph < N_PHASES; ++ph) { a.ph_lo = ph; a.ph_hi = ph + 1; hipLaunchKernelGGL(mega_fwd, dim3(grid), dim3(NTHREADS), LDS_BYTES, stream, a); }
#endif
}
```
